# Optimizing an MI355X kernel written in HIP

```python
import math
import jax, jax.numpy as jnp
from jax import lax
import numpy as np

D_MODEL = 1024
BATCH = 16
SEQ = 4096
DEPTH = 1
DEC_BATCH = 16
DEC_SEQ = 2048
PAST_LEN = 128

DA_HEADS = 8
DA_HEAD_DIM = 64
DA_V_DIM = 2 * DA_HEAD_DIM
DA_QK = DA_HEADS * 2 * DA_HEAD_DIM
DA_V = DA_HEADS * DA_V_DIM
Q_BLOCK = 128
DL_PAIRS = ((128, 1), (512, 4), (2048, 16))
N_GROUPS = len(DL_PAIRS)
DL_HEADS = 8
DL_HEAD_DIM = 64
DL_W = DL_HEADS * DL_HEAD_DIM
DL_BLOCK = 64
ROPE_THETA = 500000.0
ROPE_FRACTION = 4
FFN_HIDDEN = -(-8 * D_MODEL // (3 * 256)) * 256
EPS = 1e-6
NEG = -1e30
N_IN = 2 * DA_QK + DA_V + 3 * N_GROUPS * DL_W + 2 * D_MODEL

kernel_name = "hybrid_diff_dilated_encoder"


def _rmsnorm(x, g):
    xf = x.astype(jnp.float32)
    y = xf * lax.rsqrt(jnp.mean(xf * xf, axis=-1, keepdims=True) + EPS)
    return (y * g.astype(jnp.float32)).astype(x.dtype)


def _rope_tables(seq, head_dim):
    rot = head_dim // ROPE_FRACTION
    inv = 1.0 / (ROPE_THETA ** (jnp.arange(0, rot, 2, dtype=jnp.float32) / rot))
    ang = jnp.arange(seq, dtype=jnp.float32)[:, None] * inv[None, :]
    return jnp.cos(ang), jnp.sin(ang)


def _rope(t, cos, sin):
    half = cos.shape[-1]
    tf = t.astype(jnp.float32)
    t1, t2, tp = tf[..., :half], tf[..., half:2 * half], tf[..., 2 * half:]
    c = cos[None, :, None, :]
    s = sin[None, :, None, :]
    return jnp.concatenate([t1 * c - t2 * s, t2 * c + t1 * s, tp], axis=-1).astype(t.dtype)


def _diff_attention(q, k, v, lam):
    B, S, H, _, E = q.shape
    nq = S // Q_BLOCK
    qb = q.reshape(B, nq, Q_BLOCK, H, 2, E).transpose(1, 0, 2, 3, 4, 5)
    scale = E ** -0.5

    def one_block(qblk):
        s = jnp.einsum('bqhce,bkhce->bhcqk', qblk, k).astype(jnp.float32) * scale
        p = jax.nn.softmax(s, axis=-1)
        a = p[:, :, 0] - lam * p[:, :, 1]
        return jnp.einsum('bhqk,bkhe->bqhe', a.astype(v.dtype), v)

    o = lax.map(one_block, qb)
    return o.transpose(1, 0, 2, 3, 4).reshape(B, S, H, v.shape[-1])


def _neighbour_blocks(t, blk):
    nb = t.shape[2] // blk
    pad = [(0, 0), (0, 0), (blk, blk)] + [(0, 0)] * (t.ndim - 3)
    tb = jnp.pad(t, pad).reshape(t.shape[:2] + (nb + 2, blk) + t.shape[3:])
    return jnp.concatenate([tb[:, :, :-2], tb[:, :, 1:-1], tb[:, :, 2:]], axis=3)


def _dilated_group(q, k, v, dil, radius):
    B, S, H, E = q.shape
    blk = DL_BLOCK
    span = dil * blk
    Sp = -(-S // span) * span
    T = Sp // dil
    nb = T // blk
    padw = [(0, 0), (0, Sp - S), (0, 0), (0, 0)]

    def strided(t):
        return jnp.pad(t, padw).reshape(B, T, dil, H, E).transpose(0, 2, 1, 3, 4)

    qs, ks, vs = strided(q), strided(k), strided(v)
    qb = qs.reshape(B, dil, nb, blk, H, E)
    kn = _neighbour_blocks(ks, blk)
    vn = _neighbour_blocks(vs, blk)
    valid = (jnp.arange(Sp) < S).reshape(T, dil).T[None]
    kmask = _neighbour_blocks(valid, blk)
    qi = jnp.arange(blk)[:, None]
    kj = jnp.arange(3 * blk)[None, :]
    band = jnp.abs(kj - blk - qi) <= radius
    mask = band[None, None, None, None] & kmask[:, :, :, None, None, :]

    s = jnp.einsum('brnqhe,brnkhe->brnhqk', qb, kn).astype(jnp.float32) * (E ** -0.5)
    s = jnp.where(mask, s, NEG)
    m = jnp.max(s, axis=-1, keepdims=True)
    p = jnp.exp(s - m)
    den = jnp.sum(p, axis=-1)
    o = jnp.einsum('brnhqk,brnkhe->brnqhe', (p / den[..., None]).astype(v.dtype), vn)
    lse = m[..., 0] + jnp.log(den)
    o = o.reshape(B, dil, T, H, E).transpose(0, 2, 1, 3, 4).reshape(B, Sp, H, E)[:, :S]
    lse = lse.transpose(0, 1, 2, 4, 3).reshape(B, dil, T, H).transpose(0, 2, 1, 3).reshape(B, Sp, H)[:, :S]
    return o, lse


def _mixer(h, lambda_init, w_in, lam_q1, lam_k1, lam_q2, lam_k2, g_subln, w_a, w_b, w_out, cos, sin):
    B, S, _ = h.shape
    z = h @ w_in
    sizes = [DA_QK, DA_QK, DA_V] + [DL_W] * (3 * N_GROUPS) + [D_MODEL, D_MODEL]
    parts = jnp.split(z, np.cumsum(sizes)[:-1].tolist(), axis=-1)

    qa = _rope(parts[0].reshape(B, S, DA_HEADS * 2, DA_HEAD_DIM), cos, sin).reshape(B, S, DA_HEADS, 2, DA_HEAD_DIM)
    ka = _rope(parts[1].reshape(B, S, DA_HEADS * 2, DA_HEAD_DIM), cos, sin).reshape(B, S, DA_HEADS, 2, DA_HEAD_DIM)
    va = parts[2].reshape(B, S, DA_HEADS, DA_V_DIM)
    lam = (jnp.exp(jnp.sum(lam_q1.astype(jnp.float32) * lam_k1.astype(jnp.float32)))
           - jnp.exp(jnp.sum(lam_q2.astype(jnp.float32) * lam_k2.astype(jnp.float32))) + lambda_init)
    oa = _diff_attention(qa, ka, va, lam)
    oa = (_rmsnorm(oa, g_subln) * (1.0 - lambda_init)).reshape(B, S, DA_V)

    outs, lses = [], []
    for g, (window, dil) in enumerate(DL_PAIRS):
        base = 3 + 3 * g
        qg = _rope(parts[base].reshape(B, S, DL_HEADS, DL_HEAD_DIM), cos, sin)
        kg = _rope(parts[base + 1].reshape(B, S, DL_HEADS, DL_HEAD_DIM), cos, sin)
        vg = parts[base + 2].reshape(B, S, DL_HEADS, DL_HEAD_DIM)
        o, l = _dilated_group(qg, kg, vg, dil, window // (2 * dil))
        outs.append(o)
        lses.append(l)
    wgt = jax.nn.softmax(jnp.stack(lses), axis=0)
    ob = jnp.einsum('gbsh,gbshe->bshe', wgt, jnp.stack(outs).astype(jnp.float32)).astype(h.dtype).reshape(B, S, DL_W)

    merged = jax.nn.sigmoid(parts[-2]) * (oa @ w_a) + jax.nn.sigmoid(parts[-1]) * (ob @ w_b)
    return merged @ w_out


def _trunk(x, c, w_ada, b_ada, g_mix, w_in, lam_q1, lam_k1, lam_q2, lam_k2, g_subln,
           w_a, w_b, w_out, g_ffn, w_gu, w_down, g_final):
    cos, sin = _rope_tables(x.shape[1], DL_HEAD_DIM)
    for l in range(DEPTH):
        lambda_init = 0.8 - 0.6 * math.exp(-0.3 * l)
        mod = (jax.nn.silu(c) @ w_ada[l] + b_ada[l])[:, None, :]
        sh1, sc1, gt1, sh2, sc2, gt2 = jnp.split(mod, 6, axis=-1)
        h = _rmsnorm(x, g_mix[l]) * (1 + sc1) + sh1
        x = x + gt1 * _mixer(h, lambda_init, w_in[l], lam_q1[l], lam_k1[l], lam_q2[l], lam_k2[l],
                             g_subln[l], w_a[l], w_b[l], w_out[l], cos, sin)
        h = _rmsnorm(x, g_ffn[l]) * (1 + sc2) + sh2
        gate, up = jnp.split(h @ w_gu[l], 2, axis=-1)
        x = x + gt2 * ((jax.nn.silu(gate) * up) @ w_down[l])
    return _rmsnorm(x, g_final)


def setup_inputs(seed: int = 0) -> dict:
    key = jax.random.key(seed)
    ks = jax.random.split(key, 24)
    f32 = jnp.float32

    def nrm(k, shape, scale):
        return jax.random.normal(k, shape, f32) * scale

    def gain(k, shape):
        return 1.0 + 0.02 * jax.random.normal(k, shape, f32)

    return {
        'x_prompt': nrm(ks[0], (BATCH, SEQ, D_MODEL), 1.0),
        'x_sample': nrm(ks[1], (DEC_BATCH, DEC_SEQ, D_MODEL), 1.0),
        'c_prompt': nrm(ks[2], (BATCH, D_MODEL), 1.0),
        'c_sample': nrm(ks[3], (DEC_BATCH, D_MODEL), 1.0),
        'w_ada': nrm(ks[4], (DEPTH, D_MODEL, 6 * D_MODEL), D_MODEL ** -0.5),
        'b_ada': nrm(ks[5], (DEPTH, 6 * D_MODEL), 0.01),
        'g_mix': gain(ks[6], (DEPTH, D_MODEL)),
        'w_in': nrm(ks[7], (DEPTH, D_MODEL, N_IN), D_MODEL ** -0.5),
        'lam_q1': nrm(ks[8], (DEPTH, DA_HEAD_DIM), 0.1),
        'lam_k1': nrm(ks[9], (DEPTH, DA_HEAD_DIM), 0.1),
        'lam_q2': nrm(ks[10], (DEPTH, DA_HEAD_DIM), 0.1),
        'lam_k2': nrm(ks[11], (DEPTH, DA_HEAD_DIM), 0.1),
        'g_subln': gain(ks[12], (DEPTH, DA_V_DIM)),
        'w_a': nrm(ks[13], (DEPTH, DA_V, D_MODEL), DA_V ** -0.5),
        'w_b': nrm(ks[14], (DEPTH, DL_W, D_MODEL), DL_W ** -0.5),
        'w_out': nrm(ks[15], (DEPTH, D_MODEL, D_MODEL), D_MODEL ** -0.5),
        'g_ffn': gain(ks[16], (DEPTH, D_MODEL)),
        'w_gu': nrm(ks[17], (DEPTH, D_MODEL, 2 * FFN_HIDDEN), D_MODEL ** -0.5),
        'w_down': nrm(ks[18], (DEPTH, FFN_HIDDEN, D_MODEL), FFN_HIDDEN ** -0.5),
        'g_final': gain(ks[19], (D_MODEL,)),
    }


def reference(x_prompt, x_sample, c_prompt, c_sample, w_ada, b_ada, g_mix, w_in,
              lam_q1, lam_k1, lam_q2, lam_k2, g_subln, w_a, w_b, w_out,
              g_ffn, w_gu, w_down, g_final):
    y_prompt = _trunk(x_prompt, c_prompt, w_ada, b_ada, g_mix, w_in, lam_q1, lam_k1, lam_q2, lam_k2,
                      g_subln, w_a, w_b, w_out, g_ffn, w_gu, w_down, g_final)
    y_sample = _trunk(x_sample, c_sample, w_ada, b_ada, g_mix, w_in, lam_q1, lam_k1, lam_q2, lam_k2,
                      g_subln, w_a, w_b, w_out, g_ffn, w_gu, w_down, g_final)
    return (y_prompt, y_sample)
```

```cpp
#include <hip/hip_runtime.h>
#include <hip/hip_bf16.h>
#include <hip/hip_cooperative_groups.h>
#include <cstdio>
#include <cstdint>
namespace cg = cooperative_groups;
namespace pg8 {
#define PG8_LAS __attribute__((address_space(3)))
typedef unsigned short bf16_t;
typedef short bf16x8 __attribute__((ext_vector_type(8)));
typedef float f32x4 __attribute__((ext_vector_type(4)));
typedef unsigned u32x4 __attribute__((ext_vector_type(4)));
constexpr int BM = 256, BK = 64, HALF = 128, HTB = HALF * BK * 2  , STAGE_BYTES = 8 * HTB, NXCD = 8, WGM = 8;

__host__ __device__ __forceinline__ int lds_byte(int r, int c) { const int st = (r >> 4) * 2 + (c >> 5), rr = r & 15, cc = c & 31, ob = rr * 64 + cc * 2; return st * 1024 + (ob ^ (((ob >> 9) & 1) << 5)); }
__host__ __device__ __forceinline__ void stage_rc(int b, int& R, int& C) { const int st = b / 1024, sb = b % 1024, swz = sb ^ (((sb >> 9) & 1) << 5); R = (st >> 1) * 16 + swz / 64; C = (st & 1) * 32 + (swz % 64) / 2; }
__host__ __device__ __forceinline__ int perm32(int rho) { const int n = rho >> 4, i = rho & 15; return 8 * (i >> 2) + 4 * n + (i & 3); }

struct Unit { int pm, pn; };
struct Gemm { const bf16_t* A; const bf16_t* Bt; int M, N, K; };

struct StaticOrder {
    int nM, nN, nwg, G, c;
    __host__ __device__ void init(int M, int N, int G_, int c_) { nM = M / BM; nN = N / BM; nwg = nM * nN; G = G_; c = c_; }
    __host__ __device__ bool next(int i, Unit& u) const {
        const long L = (long)i * G + c; if (L >= nwg) return false;
        int wgid = (int)L; { const int q = nwg / NXCD, r = nwg % NXCD, xcd = wgid % NXCD, off = wgid / NXCD; wgid = (xcd < r ? xcd * (q + 1) : r * (q + 1) + (xcd - r) * q) + off; }
        const int nig = WGM * nN, gid = wgid / nig, fm = gid * WGM, gsz = (nM - fm) < WGM ? (nM - fm) : WGM;
        u.pm = fm + ((wgid % nig) % gsz); u.pn = (wgid % nig) / gsz; return true;
    }
    __device__ __forceinline__ void a_ready(const Unit&) const {}
    __device__ __forceinline__ void done(const Unit&) const {}
};

__device__ __forceinline__ unsigned cvt_pk_bf16(float lo, float hi) { unsigned r; asm volatile("v_cvt_pk_bf16_f32 %0, %1, %2" : "=v"(r) : "v"(lo), "v"(hi)); return r; }
typedef float f32x2 __attribute__((ext_vector_type(2)));
template <class Epi, class Sched, bool ALIGN_EPI = false, bool SP2 = false>
__device__ __forceinline__ void gemm_phase(PG8_LAS unsigned char* lds, const Gemm g, const Sched& S, const Epi& E) {
    int tid_ = threadIdx.x; asm volatile("" : "+v"(tid_));
    const int tid = tid_, wid = __builtin_amdgcn_readfirstlane(tid >> 6), lane = tid & 63, wr = wid >> 2, wc = wid & 3, fr = lane & 15, fq = lane >> 4;
    const int K = g.K, nt = K / BK;
    unsigned voffA[2], voffB[2];
#pragma unroll
    for (int i = 0; i < 2; ++i) { int R, C; stage_rc(tid * 16 + i * 8192, R, C); const int Rb = Epi::PERM ? ((R & ~31) + perm32(R & 31)) : R;
        voffA[i] = (unsigned)(R * K + C) * 2u; voffB[i] = (unsigned)(Rb * K + C) * 2u; }
    const size_t kstep = (size_t)(BK * 2);
    const size_t hstep = (size_t)HALF * K * 2;
    const size_t tstep = 2 * hstep;
    const unsigned ldsw = (unsigned)wid * 1024u;
    const int aoff = lds_byte(wr * 64 + fr, fq * 8), boff = lds_byte(wc * 32 + fr, fq * 8);
#define PG8_SA(b, h) (((b) * 2 + (h)) * HTB)
#define PG8_SB(b, h) ((4 + (b) * 2 + (h)) * HTB)
#define PG8_STAGE(bufoff, gbase, voff) do { _Pragma("unroll") for (int _i = 0; _i < 2; ++_i) \
        __builtin_amdgcn_global_load_lds((const unsigned*)((const char*)(gbase) + (voff)[_i]), (PG8_LAS unsigned*)(lds + (bufoff) + ldsw + _i * 8192), 16, 0, 0); } while (0)
#define PG8_LDA(dst, b, h) do { _Pragma("unroll") for (int m = 0; m < 4; ++m) _Pragma("unroll") for (int k = 0; k < 2; ++k) dst[m][k] = *(const PG8_LAS bf16x8*)(lds + PG8_SA(b, h) + aoff + m * 2048 + k * 1024); } while (0)
#define PG8_LDB(dst, b, h) do { _Pragma("unroll") for (int n = 0; n < 2; ++n) _Pragma("unroll") for (int k = 0; k < 2; ++k) dst[n][k] = *(const PG8_LAS bf16x8*)(lds + PG8_SB(b, h) + boff + n * 2048 + k * 1024); } while (0)
#define PG8_MMA(ai, bj, At, Bt) do { __builtin_amdgcn_s_setprio(1); _Pragma("unroll") for (int m = 0; m < 4; ++m) _Pragma("unroll") for (int n = 0; n < 2; ++n) _Pragma("unroll") for (int k = 0; k < 2; ++k) \
        acc[ai][bj][m][n] = __builtin_amdgcn_mfma_f32_16x16x32_bf16(Bt[n][k], At[m][k], acc[ai][bj][m][n], 0, 0, 0); __builtin_amdgcn_s_setprio(0); } while (0)
#define PG8_WAIT_V(n) asm volatile("s_waitcnt vmcnt(" #n ")" ::: "memory")
#define PG8_WAIT_L(n) asm volatile("s_waitcnt lgkmcnt(" #n ")" ::: "memory")
#define PG8_BAR __builtin_amdgcn_s_barrier()
#define PG8_SCHED __builtin_amdgcn_sched_barrier(0)
    Unit cur, nxt; int ui = 0;
    if (!S.next(0, cur)) return;
    f32x4 acc[2][2][4][2];
#pragma unroll
    for (int a = 0; a < 2; ++a)
#pragma unroll
        for (int b = 0; b < 2; ++b)
#pragma unroll
            for (int m = 0; m < 4; ++m)
#pragma unroll
                for (int n = 0; n < 2; ++n) acc[a][b][m][n] = (f32x4){0.f, 0.f, 0.f, 0.f};
    bf16x8 At[4][2], B0[2][2], B1[2][2];
    const char* cA = (const char*)g.A + (size_t)cur.pm * tstep; const char* cB = (const char*)g.Bt + (size_t)cur.pn * tstep;
    S.a_ready(cur);
    if constexpr (SP2) {
        PG8_STAGE(PG8_SB(0, 0), cB, voffB); PG8_STAGE(PG8_SB(0, 1), cB + hstep, voffB); PG8_STAGE(PG8_SA(0, 0), cA, voffA); PG8_STAGE(PG8_SA(0, 1), cA + hstep, voffA);
        if (wr == 1) PG8_BAR;
        PG8_WAIT_V(2); PG8_BAR;
        PG8_STAGE(PG8_SB(1, 0), cB + kstep, voffB); PG8_STAGE(PG8_SA(1, 0), cA + kstep, voffA); PG8_STAGE(PG8_SB(1, 1), cB + hstep + kstep, voffB);
        PG8_WAIT_V(6); PG8_BAR;
    } else {
        PG8_STAGE(PG8_SB(0, 0), cB, voffB); PG8_STAGE(PG8_SA(0, 0), cA, voffA); PG8_STAGE(PG8_SB(0, 1), cB + hstep, voffB); PG8_STAGE(PG8_SA(0, 1), cA + hstep, voffA);
        if (wr == 1) PG8_BAR;
        PG8_WAIT_V(4); PG8_BAR;
        PG8_STAGE(PG8_SB(1, 0), cB + kstep, voffB); PG8_STAGE(PG8_SA(1, 0), cA + kstep, voffA); PG8_STAGE(PG8_SB(1, 1), cB + hstep + kstep, voffB);
        PG8_WAIT_V(6); PG8_BAR;
    }
    for (;;) {
        const bool has_next = S.next(ui + 1, nxt);
        const char* nA = has_next ? (const char*)g.A + (size_t)nxt.pm * tstep : cA; const char* nB = has_next ? (const char*)g.Bt + (size_t)nxt.pn * tstep : cB;
        for (int t = 0; t < nt; t += 2) {
            const bool last = (t == nt - 2);
            const char* a1 = cA + (size_t)(t + 1) * kstep;
            const char* a2 = last ? nA : cA + (size_t)(t + 2) * kstep; const char* b2 = last ? nB : cB + (size_t)(t + 2) * kstep;
            const char* a3 = a2 + kstep; const char* b3 = b2 + kstep;
            if (last && has_next) S.a_ready(nxt);
            if constexpr (SP2) {
            PG8_LDB(B0, 0, 0); PG8_LDB(B1, 0, 1); PG8_SCHED; PG8_LDA(At, 0, 0); PG8_STAGE(PG8_SA(1, 1), a1 + hstep, voffA);
            PG8_WAIT_V(8); PG8_WAIT_L(0); PG8_BAR; PG8_MMA(0, 0, At, B0); PG8_MMA(0, 1, At, B1); PG8_BAR; PG8_SCHED;
            PG8_LDA(At, 0, 1); PG8_STAGE(PG8_SB(0, 0), b2, voffB); PG8_STAGE(PG8_SB(0, 1), b2 + hstep, voffB); PG8_STAGE(PG8_SA(0, 0), a2, voffA);
            PG8_WAIT_V(8); PG8_WAIT_L(0); PG8_BAR; PG8_MMA(1, 0, At, B0); PG8_MMA(1, 1, At, B1); PG8_BAR; PG8_SCHED;
            PG8_LDB(B0, 1, 0); PG8_LDB(B1, 1, 1); PG8_SCHED; PG8_LDA(At, 1, 0); PG8_STAGE(PG8_SA(0, 1), a2 + hstep, voffA);
            PG8_WAIT_V(8); PG8_WAIT_L(0); PG8_BAR; PG8_MMA(0, 0, At, B0); PG8_MMA(0, 1, At, B1); PG8_BAR; PG8_SCHED;
            PG8_LDA(At, 1, 1); PG8_STAGE(PG8_SB(1, 0), b3, voffB); PG8_STAGE(PG8_SB(1, 1), b3 + hstep, voffB); PG8_STAGE(PG8_SA(1, 0), a3, voffA);
            PG8_WAIT_V(8); PG8_WAIT_L(0); PG8_BAR; PG8_MMA(1, 0, At, B0); PG8_MMA(1, 1, At, B1); PG8_BAR; PG8_SCHED;
            } else {
            PG8_LDB(B0, 0, 0); PG8_SCHED; PG8_LDA(At, 0, 0); PG8_STAGE(PG8_SA(1, 1), a1 + hstep, voffA);
            PG8_WAIT_L(8); PG8_BAR; PG8_WAIT_L(0); PG8_MMA(0, 0, At, B0); PG8_BAR; PG8_SCHED;
            PG8_LDB(B1, 0, 1); PG8_STAGE(PG8_SB(0, 0), b2, voffB);
            PG8_BAR; PG8_WAIT_L(0); PG8_MMA(0, 1, At, B1); PG8_BAR;
            PG8_LDA(At, 0, 1); PG8_STAGE(PG8_SA(0, 0), a2, voffA);
            PG8_BAR; PG8_WAIT_L(0); PG8_MMA(1, 0, At, B0); PG8_BAR; PG8_SCHED;
            PG8_STAGE(PG8_SB(0, 1), b2 + hstep, voffB);
            PG8_WAIT_V(6); PG8_BAR; PG8_MMA(1, 1, At, B1); PG8_BAR;
            PG8_LDB(B0, 1, 0); PG8_SCHED; PG8_LDA(At, 1, 0); PG8_STAGE(PG8_SA(0, 1), a2 + hstep, voffA);
            PG8_WAIT_L(8); PG8_BAR; PG8_WAIT_L(0); PG8_MMA(0, 0, At, B0); PG8_BAR; PG8_SCHED;
            PG8_LDB(B1, 1, 1); PG8_STAGE(PG8_SB(1, 0), b3, voffB);
            PG8_BAR; PG8_WAIT_L(0); PG8_MMA(0, 1, At, B1); PG8_BAR;
            PG8_LDA(At, 1, 1); PG8_STAGE(PG8_SA(1, 0), a3, voffA);
            PG8_BAR; PG8_WAIT_L(0); PG8_MMA(1, 0, At, B0); PG8_BAR; PG8_SCHED;
            PG8_STAGE(PG8_SB(1, 1), b3 + hstep, voffB);
            PG8_WAIT_V(6); PG8_BAR; PG8_MMA(1, 1, At, B1); PG8_BAR;
            }
        }
        if constexpr (ALIGN_EPI) { if (wr == 0) PG8_BAR; }
        if constexpr (!Epi::AFTER_DRAIN) { E(acc, cur, wr, wc, fr, fq); S.done(cur); }
        if (!has_next) break;
#pragma unroll
        for (int a = 0; a < 2; ++a)
#pragma unroll
            for (int b = 0; b < 2; ++b)
#pragma unroll
                for (int m = 0; m < 4; ++m)
#pragma unroll
                    for (int n = 0; n < 2; ++n) acc[a][b][m][n] = (f32x4){0.f, 0.f, 0.f, 0.f};
        cur = nxt; cA = nA; cB = nB; ++ui;
        if constexpr (ALIGN_EPI) { if (wr == 1) PG8_BAR; }
    }
    PG8_WAIT_V(0);
    if constexpr (!ALIGN_EPI) { if (wr == 0) PG8_BAR; }
    PG8_BAR;
    if constexpr (Epi::AFTER_DRAIN) { E.fused(acc, cur, wr, wc, fr, fq, lds, wid, lane); S.done(cur); }
#undef PG8_SA
#undef PG8_SB
#undef PG8_STAGE
#undef PG8_LDA
#undef PG8_LDB
#undef PG8_MMA
#undef PG8_WAIT_V
#undef PG8_WAIT_L
#undef PG8_BAR
#undef PG8_SCHED
}
}
#ifndef PG8_SP2
#define PG8_SP2 true
#endif
#ifndef PG8_ALIGN
#define PG8_ALIGN true
#endif
#include <hip/hip_bf16.h>
#include <cmath>
namespace attn_body {
using bf16=__hip_bfloat16;
using bf16x8=__attribute__((ext_vector_type(8)))short;
using s16x4=__attribute__((ext_vector_type(4)))short;
using f32x16=__attribute__((ext_vector_type(16)))float;
using u32x4=__attribute__((ext_vector_type(4)))unsigned;
constexpr int D=64,DM=1024;
constexpr int NW=8,QBLK=32,QB=QBLK*NW,KVBLK=64;
__device__ __forceinline__ int crow(int r,int hi){return (r&3)+8*(r>>2)+4*hi;}
#define SBAR() __builtin_amdgcn_sched_barrier(0)
constexpr int NSLOT=3, SLOTB=8192;
constexpr int LDS_K=0, LDS_V=NSLOT*SLOTB, LDS_WS=2*NSLOT*SLOTB, LDS_OST=LDS_WS+NW*64*4, LDS_BYTES=LDS_OST+NW*4096;
constexpr float C2=0.125f*1.4426950408889634f;
__device__ __forceinline__ void glds16(const void*gsrc,unsigned lds_dst){unsigned keep;
  asm volatile("s_mov_b32 %0, m0\n\ts_mov_b32 m0, %2\n\ts_nop 0\n\tglobal_load_lds_dwordx4 %1, off\n\ts_mov_b32 m0, %0":"=&s"(keep):"v"(gsrc),"s"(lds_dst):"memory");}
__device__ __forceinline__ float max3f(float a,float b,float c){float r;asm("v_max3_f32 %0, %1, %2, %3":"=v"(r):"v"(a),"v"(b),"v"(c));return r;}
__device__ __forceinline__ float max2f(float a,float b){float r;asm("v_max_f32_e32 %0, %1, %2":"=v"(r):"v"(a),"v"(b));return r;}
__device__ __forceinline__ float fadd_s(float a,float b){float r;asm("v_add_f32_e32 %0, %1, %2":"=v"(r):"v"(a),"v"(b));return r;}
__device__ __forceinline__ float fsub_s(float a,float b){float r;asm("v_sub_f32_e32 %0, %1, %2":"=v"(r):"v"(a),"v"(b));return r;}
typedef float f32x2_t __attribute__((ext_vector_type(2))); typedef __bf16 bf16x2_t __attribute__((ext_vector_type(2)));
__device__ __forceinline__ unsigned cvtpk_s(float lo,float hi){f32x2_t v={lo,hi};bf16x2_t b=__builtin_convertvector(v,bf16x2_t);return __builtin_bit_cast(unsigned,b);}
#define WAIT_BAR(N) asm volatile("s_waitcnt vmcnt(" #N ") lgkmcnt(0)\n\ts_barrier":::"memory")

__device__ __forceinline__ void qkt(f32x16&p0,f32x16&p1,const char*Kslot,const bf16x8*qr,const f32x16&negm,int r32,int hi){
  const char*kb=Kslot+hi*1024+r32*16;
  #pragma unroll
  for(int d0=0;d0<4;++d0){
    const bf16x8 b0=*reinterpret_cast<const bf16x8*>(kb+d0*2048);
    const bf16x8 b1=*reinterpret_cast<const bf16x8*>(kb+d0*2048+512);
    if(d0==0){p0=__builtin_amdgcn_mfma_f32_32x32x16_bf16(b0,qr[0],negm,0,0,0);p1=__builtin_amdgcn_mfma_f32_32x32x16_bf16(b1,qr[0],negm,0,0,0);}
    else{p0=__builtin_amdgcn_mfma_f32_32x32x16_bf16(b0,qr[d0],p0,0,0,0);p1=__builtin_amdgcn_mfma_f32_32x32x16_bf16(b1,qr[d0],p1,0,0,0);}}
}
typedef __attribute__((address_space(3))) const char* lds_cptr;
typedef short v4i16_t __attribute__((ext_vector_type(4)));
__device__ __forceinline__ void kload8(bf16x8*kf,lds_cptr kp){
  kf[0]=*(const __attribute__((address_space(3))) bf16x8*)(kp);      kf[1]=*(const __attribute__((address_space(3))) bf16x8*)(kp+512);
  kf[2]=*(const __attribute__((address_space(3))) bf16x8*)(kp+2048); kf[3]=*(const __attribute__((address_space(3))) bf16x8*)(kp+2560);
  kf[4]=*(const __attribute__((address_space(3))) bf16x8*)(kp+4096); kf[5]=*(const __attribute__((address_space(3))) bf16x8*)(kp+4608);
  kf[6]=*(const __attribute__((address_space(3))) bf16x8*)(kp+6144); kf[7]=*(const __attribute__((address_space(3))) bf16x8*)(kp+6656);
}
__device__ __forceinline__ void kload2(bf16x8*kf,lds_cptr kp,int j){ kf[2*j]=*(const __attribute__((address_space(3))) bf16x8*)(kp+j*2048); kf[2*j+1]=*(const __attribute__((address_space(3))) bf16x8*)(kp+j*2048+512); }
__device__ __forceinline__ s16x4 vtr(lds_cptr p){ return __builtin_bit_cast(s16x4,__builtin_amdgcn_ds_read_tr16_b64_v4i16((__attribute__((address_space(3))) v4i16_t*)p)); }
__device__ __forceinline__ float rowmax(const f32x16&p0,const f32x16&p1){
  float a=max3f(p0[0],p0[1],p1[0]),b=max3f(p0[2],p0[3],p1[1]);a=max3f(a,p1[2],p1[3]);
  #pragma unroll
  for(int r=4;r<16;r+=4){a=max3f(a,p0[r],p0[r+1]);b=max3f(b,p0[r+2],p0[r+3]);a=max3f(a,p1[r],p1[r+1]);b=max3f(b,p1[r+2],p1[r+3]);}
  const float m=max2f(a,b);
  auto rr=__builtin_amdgcn_permlane32_swap(__float_as_uint(m),__float_as_uint(m),false,false);
  return max2f(__uint_as_float(rr[0]),__uint_as_float(rr[1]));
}
__device__ __forceinline__ void pv(f32x16*o,int vb,bf16x8 pa0,bf16x8 pa1,bf16x8 pa2,bf16x8 pa3){
  #pragma unroll
  for(int d0=0;d0<2;++d0){s16x4 lo[4],hi[4];
    #pragma unroll
    for(int ks=0;ks<4;++ks){
      asm volatile("ds_read_b64_tr_b16 %0,%1 offset:%c2":"=&v"(lo[ks]):"v"(vb),"i"(d0*4096+ks*1024):"memory");
      asm volatile("ds_read_b64_tr_b16 %0,%1 offset:%c2":"=&v"(hi[ks]):"v"(vb),"i"(d0*4096+ks*1024+512):"memory");}
    asm volatile("s_waitcnt lgkmcnt(0)":::"memory");SBAR();
    #define PK(k) (bf16x8){lo[k][0],lo[k][1],lo[k][2],lo[k][3],hi[k][0],hi[k][1],hi[k][2],hi[k][3]}
    o[d0]=__builtin_amdgcn_mfma_f32_32x32x16_bf16(pa0,PK(0),o[d0],0,0,0);
    o[d0]=__builtin_amdgcn_mfma_f32_32x32x16_bf16(pa1,PK(1),o[d0],0,0,0);
    o[d0]=__builtin_amdgcn_mfma_f32_32x32x16_bf16(pa2,PK(2),o[d0],0,0,0);
    o[d0]=__builtin_amdgcn_mfma_f32_32x32x16_bf16(pa3,PK(3),o[d0],0,0,0);
    #undef PK
  }
}

#ifndef ATTN_STORE16
#define ATTN_STORE16(p,v) (*(u32x4*)(p)=(v))
#endif
template<int THRL> __device__ __forceinline__ void attn_unit(const bf16*Qp,const bf16*__restrict__ Kh,const bf16*__restrict__ Vh,bf16*Op,const int q0,const int NT,char*shm){
  int tid_=threadIdx.x; asm volatile("":"+v"(tid_));
  const int tid=tid_,lane=tid&63,r32=lane&31,hi=lane>>5; const int wid=__builtin_amdgcn_readfirstlane(tid>>6);
  const bf16*Qw=Qp+(long)(q0+wid*QBLK)*DM;
  const unsigned lds0=(unsigned)(uintptr_t)shm;
  float*wsf=(float*)(shm+LDS_WS)+wid*64;
  const bf16*ksrc=Kh+(long)lane*DM+wid*8;
  const bf16*vsrc=Vh+(long)(16*(wid&3)+(lane>>2))*DM+(wid>>2)*32+(lane&3)*8;
  const unsigned kdst=lds0+LDS_K+wid*1024, vdst=lds0+LDS_V+wid*1024;
  #define DMA_K(t,slot) glds16(ksrc+(long)(t)*KVBLK*DM,(unsigned)__builtin_amdgcn_readfirstlane(kdst+(slot)))
  #define DMA_V(t,slot) glds16(vsrc+(long)(t)*KVBLK*DM,(unsigned)__builtin_amdgcn_readfirstlane(vdst+(slot)))
  const int vb0=(int)(lds0+LDS_V)+((lane>>4)&1)*32+(lane&3)*8+(4*hi+((lane&15)>>2))*64;
  const char*Kbase=shm+LDS_K; bf16x8 kf[8];
  const lds_cptr shm3=(lds_cptr)shm; const lds_cptr kp0=shm3+LDS_K+hi*1024+r32*16; const lds_cptr vp0=shm3+LDS_V+((lane>>4)&1)*32+(lane&3)*8+(4*hi+((lane&15)>>2))*64;
  DMA_K(0,0);DMA_V(0,0);DMA_K(1,SLOTB);
  bf16x8 qr[4];
  #pragma unroll
  for(int d0=0;d0<4;++d0)qr[d0]=*reinterpret_cast<const bf16x8*>(&Qw[(long)r32*DM+d0*16+hi*8]);
  float mhat=0.f,l_reg=0.f;f32x16 o[2];o[0]=f32x16{};o[1]=f32x16{};f32x16 negm=f32x16{};asm volatile("":"+v"(negm));
  #define CMASK(P0,P1,t) do{}while(0)
  bool resc=false;
  #define START(P0,P1) do{ const float rm=rowmax(P0,P1); resc=false; \
    { const float dl=rm; mhat=fadd_s(mhat,dl); \
      _Pragma("unroll") for(int r=0;r<16;++r){P0[r]=fsub_s(P0[r],dl);P1[r]=fsub_s(P1[r],dl);} \
      _Pragma("unroll") for(int r=0;r<16;++r)negm[r]=-mhat; asm volatile("":"+v"(negm)); } \
    _Pragma("unroll") for(int r=0;r<16;++r)P0[r]=__builtin_amdgcn_exp2f(P0[r]); }while(0)
  #define RESC() do{ if(resc){ asm volatile("s_waitcnt lgkmcnt(0)":::"memory"); \
      _Pragma("unroll") for(int d_=0;d_<2;++d_) _Pragma("unroll") for(int r=0;r<16;++r)o[d_][r]*=wsf[crow(r,hi)]; } }while(0)
  f32x16 pA0,pA1,pB0,pB1;
  int sl_prev=0,sl_cur=0,sl_next=SLOTB;
  #define ROT() do{sl_prev=sl_cur;sl_cur=sl_next;sl_next=(sl_next==(NSLOT-1)*SLOTB)?0:sl_next+SLOTB;}while(0)
  DMA_K(2,2*SLOTB);
  WAIT_BAR(3);
  qkt(pA0,pA1,Kbase,qr,negm,r32,hi);asm volatile("s_nop 15\n\ts_nop 7":"+v"(pA0),"+v"(pA1));CMASK(pA0,pA1,0);
  START(pA0,pA1);
  _Pragma("unroll") for(int r=0;r<16;++r)pA1[r]=__builtin_amdgcn_exp2f(pA1[r]);
  WAIT_BAR(0);
  DMA_K(3,0);DMA_V(1,SLOTB);
  ROT();
  kload8(kf,kp0+sl_cur);
  WAIT_BAR(2);
  s16x4 vlo[8],vhi[8]; u32x4 pw0,pw1,pw2,pw3;
  #define PKW(P,B) cvtpk_s(P[B],P[B+1])
  #define PAF(k) __builtin_bit_cast(bf16x8,pw##k)
  #define VFR(i) (bf16x8){vlo[i][0],vlo[i][1],vlo[i][2],vlo[i][3],vhi[i][0],vhi[i][1],vhi[i][2],vhi[i][3]}
  #define PIN(x) asm volatile("":"+v"(x))
  #define MX3(a,b,c) __builtin_fmaxf(__builtin_fmaxf((a),(b)),(c))
  #define GAPA(MF,A0,A1,A2,A3,W0,W1,PW) do{ MF; sacc+=A0; sacc+=A1; sacc+=A2; sacc+=A3; PIN(sacc); W0; W1; PIN(PW); SBAR(); }while(0)
  #define EX(v) __builtin_amdgcn_exp2f(v)
  #define GAPB(MF,X,B) do{ MF; X[B]=EX(X[B]); X[B+1]=EX(X[B+1]); X[B+2]=EX(X[B+2]); X[B+3]=EX(X[B+3]); PIN(X); SBAR(); }while(0)
  #define VRD(i) do{ vlo[i]=vtr(vp_+(((i)>>2)*4096+((i)&3)*1024)); vhi[i]=vtr(vp_+(((i)>>2)*4096+((i)&3)*1024+512)); }while(0)
  #define KRD(G,j) do{ if(G){ kload2(kf,kp0+sl_next,j); SBAR(); } }while(0)
  #define STEP(C0,C1,P0,P1,t,GK,GV,GL) do{ SBAR(); \
    const lds_cptr vp_=vp0+sl_prev; \
    VRD(0); SBAR(); float sacc=(P0[0]+P0[1]); \
    GAPA(C0=__builtin_amdgcn_mfma_f32_32x32x16_bf16(kf[0],qr[0],negm,0,0,0), P0[2],P0[3],P0[4],P0[5],     pw0[0]=PKW(P0,0), pw0[1]=PKW(P0,2), pw0); \
    VRD(4); SBAR(); GAPA(C1=__builtin_amdgcn_mfma_f32_32x32x16_bf16(kf[1],qr[0],negm,0,0,0), P0[6],P0[7],P0[8],P0[9],     pw0[2]=PKW(P0,4), pw0[3]=PKW(P0,6), pw0); \
    VRD(1); SBAR(); GAPA(C0=__builtin_amdgcn_mfma_f32_32x32x16_bf16(kf[2],qr[1],C0,0,0,0),   P0[10],P0[11],P0[12],P0[13], pw1[0]=PKW(P0,8), pw1[1]=PKW(P0,10), pw1); \
    VRD(5); SBAR(); GAPA(C1=__builtin_amdgcn_mfma_f32_32x32x16_bf16(kf[3],qr[1],C1,0,0,0),   P0[14],P0[15],P1[0],P1[1],   pw1[2]=PKW(P0,12),pw1[3]=PKW(P0,14), pw1); \
    VRD(2); SBAR(); GAPA(C0=__builtin_amdgcn_mfma_f32_32x32x16_bf16(kf[4],qr[2],C0,0,0,0),   P1[2],P1[3],P1[4],P1[5],     pw2[0]=PKW(P1,0), pw2[1]=PKW(P1,2), pw2); \
    VRD(6); SBAR(); GAPA(C1=__builtin_amdgcn_mfma_f32_32x32x16_bf16(kf[5],qr[2],C1,0,0,0),   P1[6],P1[7],P1[8],P1[9],     pw2[2]=PKW(P1,4), pw2[3]=PKW(P1,6), pw2); \
    VRD(3); SBAR(); GAPA(C0=__builtin_amdgcn_mfma_f32_32x32x16_bf16(kf[6],qr[3],C0,0,0,0),   P1[10],P1[11],P1[12],P1[13], pw3[0]=PKW(P1,8), pw3[1]=PKW(P1,10), pw3); \
    VRD(7); SBAR(); GAPA(C1=__builtin_amdgcn_mfma_f32_32x32x16_bf16(kf[7],qr[3],C1,0,0,0),   P1[14],P1[15],0.f,0.f,       pw3[2]=PKW(P1,12),pw3[3]=PKW(P1,14), pw3); \
    l_reg+=sacc; \
    if(GK){DMA_K((t)+3,sl_cur);} if(GV){DMA_V((t)+1,sl_next);} \
    CMASK(C0,C1,t); \
    { float a=MX3(C0[0],C0[1],C1[0]),b=MX3(C0[2],C0[3],C1[1]); a=MX3(a,C1[2],C1[3]); \
      _Pragma("unroll") for(int r=4;r<16;r+=4){a=MX3(a,C0[r],C0[r+1]);b=MX3(b,C0[r+2],C0[r+3]);a=MX3(a,C1[r],C1[r+1]);b=MX3(b,C1[r+2],C1[r+3]);} \
      float rm=__builtin_fmaxf(a,b); { auto rr=__builtin_amdgcn_permlane32_swap(__float_as_uint(rm),__float_as_uint(rm),false,false); rm=__builtin_fmaxf(__uint_as_float(rr[0]),__uint_as_float(rr[1])); } \
      resc=false; \
      if(__builtin_expect(__any(rm>(float)THRL),0)){ const float dl=__builtin_fmaxf(rm,0.f); mhat+=dl; \
        _Pragma("unroll") for(int r=0;r<16;++r){C0[r]-=dl;C1[r]-=dl;} \
        _Pragma("unroll") for(int r=0;r<16;++r)negm[r]=-mhat; asm volatile("":"+v"(negm)); \
        const float f=__builtin_amdgcn_exp2f(-dl); l_reg*=f; if(hi==0)wsf[r32]=f; resc=true; } } \
    SBAR(); \
    GAPB(o[0]=__builtin_amdgcn_mfma_f32_32x32x16_bf16(PAF(0),VFR(0),o[0],0,0,0), C0,0); \
    GAPB(o[1]=__builtin_amdgcn_mfma_f32_32x32x16_bf16(PAF(0),VFR(4),o[1],0,0,0), C0,4); \
    KRD(GL,0); GAPB(o[0]=__builtin_amdgcn_mfma_f32_32x32x16_bf16(PAF(1),VFR(1),o[0],0,0,0), C0,8); \
    KRD(GL,1); GAPB(o[1]=__builtin_amdgcn_mfma_f32_32x32x16_bf16(PAF(1),VFR(5),o[1],0,0,0), C0,12); \
    KRD(GL,2); GAPB(o[0]=__builtin_amdgcn_mfma_f32_32x32x16_bf16(PAF(2),VFR(2),o[0],0,0,0), C1,0); \
    KRD(GL,3); GAPB(o[1]=__builtin_amdgcn_mfma_f32_32x32x16_bf16(PAF(2),VFR(6),o[1],0,0,0), C1,4); \
    GAPB(o[0]=__builtin_amdgcn_mfma_f32_32x32x16_bf16(PAF(3),VFR(3),o[0],0,0,0), C1,8); \
    GAPB(o[1]=__builtin_amdgcn_mfma_f32_32x32x16_bf16(PAF(3),VFR(7),o[1],0,0,0), C1,12); \
    }while(0)
  int t=1;
  #undef CMASK
  #define CMASK(P0,P1,t) do{}while(0)
  for(;t+5<NT;t+=2){
    STEP(pB0,pB1,pA0,pA1,t,true,true,true);     WAIT_BAR(2); RESC(); ROT();
    STEP(pA0,pA1,pB0,pB1,t+1,true,true,true);   WAIT_BAR(2); RESC(); ROT();
  }
  #undef CMASK
  #define CMASK(P0,P1,t) do{}while(0)
  #define ENDW(tt) do{ if((tt)+3<NT){WAIT_BAR(2);} else if((tt)+2<NT){WAIT_BAR(1);} else {WAIT_BAR(0);} }while(0)
  for(;t+1<NT;t+=2){
    STEP(pB0,pB1,pA0,pA1,t,(t+3<NT),(t+1<NT),(t+1<NT));       ENDW(t);   RESC(); ROT();
    STEP(pA0,pA1,pB0,pB1,t+1,(t+4<NT),(t+2<NT),(t+2<NT));     ENDW(t+1); RESC(); ROT();
  }
  STEP(pB0,pB1,pA0,pA1,NT-1,false,false,false); RESC();
  { float sacc=pB0[0]+pB0[1]; _Pragma("unroll") for(int r=2;r<16;++r)sacc+=pB0[r]; _Pragma("unroll") for(int r=0;r<16;++r)sacc+=pB1[r]; l_reg+=sacc;
    pw0=(u32x4){PKW(pB0,0),PKW(pB0,2),PKW(pB0,4),PKW(pB0,6)};pw1=(u32x4){PKW(pB0,8),PKW(pB0,10),PKW(pB0,12),PKW(pB0,14)};pw2=(u32x4){PKW(pB1,0),PKW(pB1,2),PKW(pB1,4),PKW(pB1,6)};pw3=(u32x4){PKW(pB1,8),PKW(pB1,10),PKW(pB1,12),PKW(pB1,14)};
    SBAR(); pv(o,vb0+sl_cur,PAF(0),PAF(1),PAF(2),PAF(3)); }
  #undef PKW
  #undef PAF
  #undef VFR
  #undef PIN
  #undef MX3
  #undef GAPA
  #undef GAPB
  #undef EX
  #undef VRD
  #undef KRD
  #undef STEP
  #undef ENDW
  {auto rr=__builtin_amdgcn_permlane32_swap(__float_as_uint(l_reg),__float_as_uint(l_reg),false,false);l_reg=__uint_as_float(rr[0])+__uint_as_float(rr[1]);}
  if(hi==0)wsf[32+r32]=l_reg;asm volatile("s_waitcnt lgkmcnt(0)":::"memory");
  float rli[16];
  #pragma unroll
  for(int r=0;r<16;++r)rli[r]=__builtin_amdgcn_rcpf(wsf[32+crow(r,hi)]);
  bf16*Ow=Op+(long)(q0+wid*QBLK)*DM;
  { bf16*stg=(bf16*)(shm+LDS_OST)+wid*2048;
    #pragma unroll
    for(int r=0;r<16;++r){const int orow=crow(r,hi);
      #pragma unroll
      for(int d0=0;d0<2;++d0)stg[orow*64+d0*32+r32]=__float2bfloat16(o[d0][r]*rli[r]);}
    asm volatile("s_waitcnt lgkmcnt(0)":::"memory");
    #pragma unroll
    for(int i=0;i<4;++i){const int row=i*8+(lane>>3),ch=lane&7; const u32x4 v=*(const u32x4*)(stg+row*64+ch*8); ATTN_STORE16(Ow+(long)row*DM+ch*8,v);} }
  asm volatile("s_waitcnt lgkmcnt(0)\n\ts_barrier":::"memory");
  #undef DMA_K
  #undef DMA_V
  #undef CMASK
  #undef START
  #undef RESC
  #undef ROT
}
constexpr int ATTN_LDS_BYTES=LDS_BYTES;
#undef SBAR
#undef WAIT_BAR
}

#define GAS __attribute__((address_space(1)))
#define LAS __attribute__((address_space(3)))
typedef unsigned short bf16;
typedef unsigned v4u __attribute__((ext_vector_type(4)));
typedef unsigned v2u __attribute__((ext_vector_type(2)));
typedef float f32x4 __attribute__((ext_vector_type(4)));
typedef float f32x16 __attribute__((ext_vector_type(16)));
typedef short bf16x8 __attribute__((ext_vector_type(8)));
typedef short s16x4 __attribute__((ext_vector_type(4)));
#define LDS_WAIT() asm volatile("s_waitcnt lgkmcnt(0)" ::: "memory")

constexpr int DMODEL = 1024, NIN = 9728, FFH = 2816;
constexpr int S_P = 4096, S_S = 2048;
constexpr int CT = 32768, NCHUNK = 3;
constexpr float EPS = 1e-6f;
constexpr float C2 = 0.18033688011112042f;
constexpr int LDS_BYTES = 147456;
constexpr int NWAVES = 8;

constexpr size_t MiB = 1u << 20;
constexpr size_t WS_MOD = 1 * MiB, WS_ROPE = 2 * MiB;
constexpr size_t WS_WIN = 4 * MiB, WS_WA = 23 * MiB, WS_WB = 25 * MiB, WS_WOUT = 26 * MiB, WS_WGU = 28 * MiB, WS_WDN = 39 * MiB;
constexpr size_t WS_H = 48 * MiB;
constexpr size_t WS_QA = 112 * MiB, WS_KA = 176 * MiB, WS_VA = 240 * MiB, WS_G0 = 304 * MiB  , WS_G1 = 592 * MiB, WS_G2 = 656 * MiB;
constexpr size_t WS_O1 = 720 * MiB, WS_O2 = 784 * MiB, WS_OG = 848 * MiB  , WS_LSE = 944 * MiB  , WS_END = 948 * MiB;
constexpr size_t WS_OA = WS_QA, WS_OB = WS_G0, WS_MRG = WS_KA, WS_ACT = WS_VA;

struct Args {
    const float *x_prompt, *x_sample, *c_prompt, *c_sample, *w_ada, *b_ada, *g_mix, *w_in, *lq1, *lk1, *lq2, *lk2, *g_subln, *w_a, *w_b, *w_out, *g_ffn, *w_gu, *w_down, *g_final;
    float* out; unsigned char* ws;
};

typedef const __attribute__((address_space(4))) Args* CArgs;
__device__ __forceinline__ CArgs argp() { CArgs p = (CArgs)__builtin_amdgcn_kernarg_segment_ptr(); asm volatile("" : "+s"(p)); return p; }

__device__ __forceinline__ float wave_sum(float v) {
#pragma unroll
    for (int o = 1; o < 64; o <<= 1) v += __shfl_xor(v, o);
    return v;
}
__device__ __forceinline__ unsigned f2bf(float f) { unsigned u = __builtin_bit_cast(unsigned, f); return (u + 0x7fffu + ((u >> 16) & 1u)) >> 16; }
__device__ __forceinline__ unsigned pk2(float lo, float hi) { return f2bf(lo) | (f2bf(hi) << 16); }
__device__ __forceinline__ float bflo(unsigned w) { return __builtin_bit_cast(float, w << 16); }
__device__ __forceinline__ float bfhi(unsigned w) { return __builtin_bit_cast(float, w & 0xffff0000u); }

__device__ __forceinline__ int maprow(int mode, int n) {
    if (mode == 1) {
        const bool qk = (n < 2048) || (n >= 3072 && n < 7680 && ((n - 3072) % 1536) < 1024);
        const int i = n & 63;
        if (qk && i < 16) return n - i + ((i < 8) ? 2 * i : 2 * (i - 8) + 1);
        return n;
    }
    if (mode == 2) {
        const bool up = n >= FFH; const int j = up ? n - FFH : n;
        return 8 * (j >> 2) + (j & 3) + (up ? 4 : 0);
    }
    return n;
}
__device__ __forceinline__ void p0_transpose_item(const float* W, int K, int N, bf16* WT, int mode, LAS float* scr, int item, int lane) {
    const int nblk = N / 32, kb = item / nblk, nb = item % nblk, k0 = 64 * kb, n0 = 32 * nb;
#pragma unroll 8
    for (int i = 0; i < 32; ++i) { const int kk = 2 * i + (lane >> 5); scr[kk * 33 + (lane & 31)] = W[(size_t)(k0 + kk) * N + n0 + (lane & 31)]; }
    LDS_WAIT(); asm volatile("" ::: "memory");
    const int c = lane & 7;
#pragma unroll
    for (int j = 0; j < 4; ++j) { const int n = (lane >> 3) + 8 * j; const LAS float* s = scr + (8 * c) * 33 + n;
        v4u o; o.x = pk2(s[0 * 33], s[1 * 33]); o.y = pk2(s[2 * 33], s[3 * 33]); o.z = pk2(s[4 * 33], s[5 * 33]); o.w = pk2(s[6 * 33], s[7 * 33]);
        *(GAS v4u*)(WT + (size_t)maprow(mode, n0 + n) * K + k0 + 8 * c) = o; }
    LDS_WAIT(); asm volatile("" ::: "memory");
}
__constant__ double ROPE_INVREV[8] = {0.15915494309189535, 0.03086376340470123, 0.005985185712713705, 0.001160663641240061,
                                      0.00022507907903927653, 4.364795279280289e-05, 8.464330808241401e-06, 1.6414262627950345e-06};

__device__ __forceinline__ void p0_prologue(LAS unsigned char* lds, int tid, int lane, int wave, int vcu, int G) {
    CArgs ap = argp(); unsigned char* ws = ap->ws;
    LAS float* scr = (LAS float*)(lds + wave * 16384);
    const int gw = vcu * NWAVES + wave, NGW = G * NWAVES;
    constexpr int I_IN = 16 * (NIN / 32), I_A = 16 * 32, I_B = 8 * 32, I_O = 16 * 32, I_GU = 16 * (2 * FFH / 32), I_DN = (FFH / 64) * 32;
    constexpr int NITEMS = I_IN + I_A + I_B + I_O + I_GU + I_DN;
    for (int it = gw; it < NITEMS; it += NGW) {
        int r = it;
        if (r < I_IN) { p0_transpose_item(ap->w_in, 1024, NIN, (bf16*)(ws + WS_WIN), 1, scr, r, lane); continue; } r -= I_IN;
        if (r < I_A) { p0_transpose_item(ap->w_a, 1024, 1024, (bf16*)(ws + WS_WA), 0, scr, r, lane); continue; } r -= I_A;
        if (r < I_B) { p0_transpose_item(ap->w_b, 512, 1024, (bf16*)(ws + WS_WB), 0, scr, r, lane); continue; } r -= I_B;
        if (r < I_O) { p0_transpose_item(ap->w_out, 1024, 1024, (bf16*)(ws + WS_WOUT), 0, scr, r, lane); continue; } r -= I_O;
        if (r < I_GU) { p0_transpose_item(ap->w_gu, 1024, 2 * FFH, (bf16*)(ws + WS_WGU), 2, scr, r, lane); continue; } r -= I_GU;
        p0_transpose_item(ap->w_down, FFH, 1024, (bf16*)(ws + WS_WDN), 0, scr, r, lane);
    }
    for (int idx = blockIdx.x * 512 + tid; idx < 4096 * 8; idx += G * 512) {
        const int pos = idx >> 3, i = idx & 7;
        const double rev = (double)pos * ROPE_INVREV[i]; const float fr = (float)(rev - __builtin_floor(rev));
        float2 cs; cs.x = __builtin_amdgcn_cosf(fr); cs.y = __builtin_amdgcn_sinf(fr);
        ((float2*)(ws + WS_ROPE))[idx] = cs;
    }
    __syncthreads();
    const int bx = blockIdx.x;
    if (bx < 192) {
        const int n0 = bx * 32, b = lane & 31, h = lane >> 5;
        const float* crow_ = (b < 16) ? ap->c_prompt + (size_t)b * 1024 : ap->c_sample + (size_t)(b - 16) * 1024;
        f32x16 acc = {};
#pragma unroll 4
        for (int i = 0; i < 16; ++i) {
            const int k = 128 * wave + 8 * i + 4 * h;
            const f32x4 c4 = *(const f32x4*)(crow_ + k);
#pragma unroll
            for (int e = 0; e < 4; ++e) {
                const float cv = c4[e], sv = cv / (1.f + __expf(-cv));
                const float wv = ap->w_ada[(size_t)(k + e) * 6144 + n0 + (lane & 31)];
                acc = __builtin_amdgcn_mfma_f32_32x32x2f32(sv, wv, acc, 0, 0, 0);
            }
        }
        LAS float* red = (LAS float*)lds;
#pragma unroll
        for (int r = 0; r < 16; ++r) red[(wave * 16 + r) * 64 + lane] = acc[r];
        __syncthreads();
#pragma unroll
        for (int j = 0; j < 2; ++j) {
            const int o = tid + 512 * j, nn = o & 31, bb = o >> 5;
            const int hh = (bb >> 2) & 1, r = (bb & 3) + 4 * (bb >> 3), ln = nn + 32 * hh;
            float s = ap->b_ada[n0 + nn];
#pragma unroll
            for (int w = 0; w < 8; ++w) s += red[(w * 16 + r) * 64 + ln];
            ((float*)(ws + WS_MOD))[(size_t)bb * 6144 + n0 + nn] = s;
        }
    }
    __syncthreads();
}

__device__ __forceinline__ void rows_norm_mod(const float* xsrc, bf16* dst, const float* gain, const float* mod, int sh_idx, int sc_idx, int S, int b0, int gw, int NGW, int lane) {
    f32x4 g[4];
#pragma unroll
    for (int j = 0; j < 4; ++j) g[j] = *(const f32x4*)(gain + 4 * lane + 256 * j);
    for (int row = gw; row < CT; row += NGW) {
        const int b = b0 + row / S;
        const GAS f32x4* xr = (const GAS f32x4*)(xsrc + (size_t)row * 1024) + lane;
        f32x4 v[4]; float ss = 0.f;
#pragma unroll
        for (int j = 0; j < 4; ++j) { v[j] = xr[64 * j]; ss += (v[j].x * v[j].x + v[j].y * v[j].y) + (v[j].z * v[j].z + v[j].w * v[j].w); }
        const float rstd = 1.f / sqrtf(wave_sum(ss) * (1.f / 1024.f) + EPS);
        const float* mb = mod + (size_t)b * 6144;
        GAS unsigned long long* o8 = (GAS unsigned long long*)(dst + (size_t)row * 1024) + lane;
#pragma unroll
        for (int j = 0; j < 4; ++j) {
            const f32x4 sc = *(const f32x4*)(mb + sc_idx * 1024 + 4 * lane + 256 * j), sh = *(const f32x4*)(mb + sh_idx * 1024 + 4 * lane + 256 * j);
            const f32x4 h = v[j] * rstd * g[j] * (1.f + sc) + sh;
            o8[64 * j] = (unsigned long long)pk2(h.x, h.y) | ((unsigned long long)pk2(h.z, h.w) << 32);
        }
    }
}
__device__ __forceinline__ void rows_final_norm(float* x, const float* gain, int gw, int NGW, int lane) {
    f32x4 g[4];
#pragma unroll
    for (int j = 0; j < 4; ++j) g[j] = *(const f32x4*)(gain + 4 * lane + 256 * j);
    for (int row = gw; row < CT; row += NGW) {
        GAS f32x4* xr = (GAS f32x4*)(x + (size_t)row * 1024) + lane;
        f32x4 v[4]; float ss = 0.f;
#pragma unroll
        for (int j = 0; j < 4; ++j) { v[j] = xr[64 * j]; ss += (v[j].x * v[j].x + v[j].y * v[j].y) + (v[j].z * v[j].z + v[j].w * v[j].w); }
        const float rstd = 1.f / sqrtf(wave_sum(ss) * (1.f / 1024.f) + EPS);
#pragma unroll
        for (int j = 0; j < 4; ++j) xr[64 * j] = v[j] * rstd * g[j];
    }
}
__device__ __forceinline__ void rows_combine(int gw, int NGW, int lane) {
    CArgs ap = argp(); unsigned char* ws = ap->ws;
    const float e1 = __expf(wave_sum(ap->lq1[lane] * ap->lk1[lane])), e2 = __expf(wave_sum(ap->lq2[lane] * ap->lk2[lane]));
    const float lam = e1 - e2 + 0.2f;
    f32x4 gs[4];
#pragma unroll
    for (int j = 0; j < 4; ++j) gs[j] = *(const f32x4*)(ap->g_subln + ((16 * lane) & 127) + 4 * j) * 0.8f;
    const bf16* O1 = (const bf16*)(ws + WS_O1); const bf16* O2 = (const bf16*)(ws + WS_O2); bf16* OA = (bf16*)(ws + WS_OA);
    const bf16* OG = (const bf16*)(ws + WS_OG); const float* LSE = (const float*)(ws + WS_LSE); bf16* OB = (bf16*)(ws + WS_OB);
    for (int row = gw; row < CT; row += NGW) {
        const v4u* p1 = (const v4u*)(O1 + (size_t)row * 1024 + 16 * lane); const v4u* p2 = (const v4u*)(O2 + (size_t)row * 1024 + 16 * lane);
        const v4u a0 = p1[0], a1 = p1[1], b0 = p2[0], b1 = p2[1];
        float d[16];
#pragma unroll
        for (int i = 0; i < 4; ++i) { d[2 * i] = bflo(a0[i]) - lam * bflo(b0[i]); d[2 * i + 1] = bfhi(a0[i]) - lam * bfhi(b0[i]);
                                      d[8 + 2 * i] = bflo(a1[i]) - lam * bflo(b1[i]); d[8 + 2 * i + 1] = bfhi(a1[i]) - lam * bfhi(b1[i]); }
        float ss = 0.f;
#pragma unroll
        for (int i = 0; i < 16; ++i) ss += d[i] * d[i];
        ss += __shfl_xor(ss, 1); ss += __shfl_xor(ss, 2); ss += __shfl_xor(ss, 4);
        const float rs = 1.f / sqrtf(ss * (1.f / 128.f) + EPS);
        v4u o0, o1;
#pragma unroll
        for (int i = 0; i < 4; ++i) { o0[i] = pk2(d[2 * i] * rs * gs[i >> 1][(2 * i) & 3], d[2 * i + 1] * rs * gs[i >> 1][(2 * i + 1) & 3]);
                                      o1[i] = pk2(d[8 + 2 * i] * rs * gs[2 + (i >> 1)][(2 * i) & 3], d[8 + 2 * i + 1] * rs * gs[2 + (i >> 1)][(2 * i + 1) & 3]); }
        v4u* po = (v4u*)(OA + (size_t)row * 1024 + 16 * lane); po[0] = o0; po[1] = o1;
        const int hd = lane >> 3;
        const float l0 = LSE[((size_t)0 * CT + row) * 8 + hd], l1 = LSE[((size_t)1 * CT + row) * 8 + hd], l2 = LSE[((size_t)2 * CT + row) * 8 + hd];
        const float mx = fmaxf(l0, fmaxf(l1, l2));
        float w0 = __builtin_amdgcn_exp2f(l0 - mx), w1 = __builtin_amdgcn_exp2f(l1 - mx), w2 = __builtin_amdgcn_exp2f(l2 - mx);
        const float inv = 1.f / (w0 + w1 + w2); w0 *= inv; w1 *= inv; w2 *= inv;
        const v4u g0 = *(const v4u*)(OG + ((size_t)0 * CT + row) * 512 + 8 * lane), g1 = *(const v4u*)(OG + ((size_t)1 * CT + row) * 512 + 8 * lane), g2 = *(const v4u*)(OG + ((size_t)2 * CT + row) * 512 + 8 * lane);
        v4u ob;
#pragma unroll
        for (int i = 0; i < 4; ++i) ob[i] = pk2(w0 * bflo(g0[i]) + w1 * bflo(g1[i]) + w2 * bflo(g2[i]), w0 * bfhi(g0[i]) + w1 * bfhi(g1[i]) + w2 * bfhi(g2[i]));
        *(v4u*)(OB + (size_t)row * 512 + 8 * lane) = ob;
    }
}

using pg8::Unit;
typedef pg8::f32x4 pf4;
__device__ __forceinline__ v4u pack8(const pf4 v0, const pf4 v1) { v4u w; w.x = pg8::cvt_pk_bf16(v0[0], v0[1]); w.y = pg8::cvt_pk_bf16(v0[2], v0[3]); w.z = pg8::cvt_pk_bf16(v1[0], v1[1]); w.w = pg8::cvt_pk_bf16(v1[2], v1[3]); return w; }
__device__ __forceinline__ float sigm(float x) { return __builtin_amdgcn_rcpf(1.f + __expf(-x)); }

struct EpiIn {
    static constexpr bool PERM = true, AFTER_DRAIN = false;
    unsigned char* ws; int S;
    __device__ __forceinline__ void operator()(const pf4 (&acc)[2][2][4][2], const Unit& u, int wr, int wc, int fr, int fq) const {
        int pm_ = u.pm, pn_ = u.pn; asm volatile("" : "+s"(pm_), "+s"(pn_)); const Unit uu{pm_, pn_};
        const int pn = uu.pn; int kind, ldc = 1024, ct; size_t base;
        if (pn < 4) { kind = 1; base = WS_QA; ct = pn; }
        else if (pn < 8) { kind = 2; base = WS_KA; ct = pn - 4; }
        else if (pn < 12) { kind = 0; base = WS_VA; ct = pn - 8; }
        else if (pn < 30) { const int q = pn - 12, g = q / 6, r = q % 6, part = r >> 1; ct = r & 1; ldc = 512; base = WS_G0 + (size_t)(g * 3 + part) * 32 * MiB; kind = part == 0 ? 1 : (part == 1 ? 2 : 0); }
        else if (pn < 34) { kind = 3; base = WS_G1; ct = pn - 30; }
        else { kind = 3; base = WS_G2; ct = pn - 34; }
        bf16* O = (bf16*)(ws + base);
        const int row0 = uu.pm * 256 + wr * 64 + fr, col0 = ct * 256 + wc * 32 + 8 * fq;
        const bool ropew = (kind == 1 || kind == 2) && ((wc & 1) == 0); const bool ropel = fq < 2;
        const float sc = kind == 1 ? C2 : 1.f;
        const float* rope = (const float*)(ws + WS_ROPE);
#pragma unroll
        for (int ai = 0; ai < 2; ++ai)
#pragma unroll
            for (int m = 0; m < 4; ++m) {
                const int row = row0 + ai * 128 + m * 16;
                pf4 cs0 = {1.f, 0.f, 1.f, 0.f}, cs1 = {1.f, 0.f, 1.f, 0.f};
                if (ropew) { const float* rp = rope + ((size_t)(row % S) * 8 + 4 * (fq & 1)) * 2; cs0 = *(const pf4*)rp; cs1 = *(const pf4*)(rp + 4); }
                bf16* rowp = O + (size_t)row * ldc + col0;
#pragma unroll
                for (int bj = 0; bj < 2; ++bj) {
                    pf4 v0 = acc[ai][bj][m][0], v1 = acc[ai][bj][m][1];
                    if (ropew) {
                        pf4 r0, r1;
                        r0[0] = v0[0] * cs0[0] - v0[1] * cs0[1]; r0[1] = v0[1] * cs0[0] + v0[0] * cs0[1];
                        r0[2] = v0[2] * cs0[2] - v0[3] * cs0[3]; r0[3] = v0[3] * cs0[2] + v0[2] * cs0[3];
                        r1[0] = v1[0] * cs1[0] - v1[1] * cs1[1]; r1[1] = v1[1] * cs1[0] + v1[0] * cs1[1];
                        r1[2] = v1[2] * cs1[2] - v1[3] * cs1[3]; r1[3] = v1[3] * cs1[2] + v1[2] * cs1[3];
                        if (ropel) { v0 = r0; v1 = r1; }
                    }
                    if (kind == 3) {
#pragma unroll
                        for (int e = 0; e < 4; ++e) { v0[e] = sigm(v0[e]); v1[e] = sigm(v1[e]); }
                    }
                    v0 = v0 * sc; v1 = v1 * sc;
                    *(v4u*)(rowp + bj * 128) = pack8(v0, v1);
                }
                asm volatile("" ::: "memory");
            }
    }
};
struct EpiGate {
    static constexpr bool PERM = true, AFTER_DRAIN = false;
    const bf16* gate; bf16* O; int mode;
    __device__ __forceinline__ void operator()(const pf4 (&acc)[2][2][4][2], const Unit& u, int wr, int wc, int fr, int fq) const {
        int pm_ = u.pm, pn_ = u.pn; asm volatile("" : "+s"(pm_), "+s"(pn_)); const Unit uu{pm_, pn_};
        const int row0 = uu.pm * 256 + wr * 64 + fr, col0 = uu.pn * 256 + wc * 32 + 8 * fq;
#pragma unroll
        for (int ai = 0; ai < 2; ++ai)
#pragma unroll
            for (int m = 0; m < 4; ++m) {
                const size_t off = (size_t)(row0 + ai * 128 + m * 16) * 1024 + col0;
#pragma unroll
                for (int bj = 0; bj < 2; ++bj) {
                    const v4u gv = *(const v4u*)(gate + off + bj * 128);
                    pf4 v0 = acc[ai][bj][m][0], v1 = acc[ai][bj][m][1];
                    v0[0] *= bflo(gv.x); v0[1] *= bfhi(gv.x); v0[2] *= bflo(gv.y); v0[3] *= bfhi(gv.y);
                    v1[0] *= bflo(gv.z); v1[1] *= bfhi(gv.z); v1[2] *= bflo(gv.w); v1[3] *= bfhi(gv.w);
                    if (mode) { const v4u pv = *(const v4u*)(O + off + bj * 128);
                        v0[0] += bflo(pv.x); v0[1] += bfhi(pv.x); v0[2] += bflo(pv.y); v0[3] += bfhi(pv.y);
                        v1[0] += bflo(pv.z); v1[1] += bfhi(pv.z); v1[2] += bflo(pv.w); v1[3] += bfhi(pv.w); }
                    *(v4u*)(O + off + bj * 128) = pack8(v0, v1);
                }
                asm volatile("" ::: "memory");
            }
    }
};
struct EpiRes {
    static constexpr bool PERM = true, AFTER_DRAIN = false;
    const float* base; float* out; const float* mod; int gidx, S, b0;
    __device__ __forceinline__ void operator()(const pf4 (&acc)[2][2][4][2], const Unit& u, int wr, int wc, int fr, int fq) const {
        int pm_ = u.pm, pn_ = u.pn; asm volatile("" : "+s"(pm_), "+s"(pn_)); const Unit uu{pm_, pn_};
        const int row0 = uu.pm * 256 + wr * 64 + fr, col0 = uu.pn * 256 + wc * 32 + 8 * fq;
        const float* gp = mod + (size_t)(b0 + (uu.pm * 256) / S) * 6144 + gidx * 1024 + col0;
        pf4 gt[2][2];
#pragma unroll
        for (int bj = 0; bj < 2; ++bj) { gt[bj][0] = *(const pf4*)(gp + bj * 128); gt[bj][1] = *(const pf4*)(gp + bj * 128 + 4); }
#pragma unroll
        for (int ai = 0; ai < 2; ++ai)
#pragma unroll
            for (int m = 0; m < 4; ++m) {
                const size_t off = (size_t)(row0 + ai * 128 + m * 16) * 1024 + col0;
#pragma unroll
                for (int bj = 0; bj < 2; ++bj) {
                    const pf4 x0 = *(const pf4*)(base + off + bj * 128), x1 = *(const pf4*)(base + off + bj * 128 + 4);
                    *(pf4*)(out + off + bj * 128) = x0 + gt[bj][0] * acc[ai][bj][m][0];
                    *(pf4*)(out + off + bj * 128 + 4) = x1 + gt[bj][1] * acc[ai][bj][m][1];
                }
                asm volatile("" ::: "memory");
            }
    }
};
struct EpiGU {
    static constexpr bool PERM = true, AFTER_DRAIN = false;
    bf16* act;
    __device__ __forceinline__ void operator()(const pf4 (&acc)[2][2][4][2], const Unit& u, int wr, int wc, int fr, int fq) const {
        int pm_ = u.pm, pn_ = u.pn; asm volatile("" : "+s"(pm_), "+s"(pn_)); const Unit uu{pm_, pn_};
        const int row0 = uu.pm * 256 + wr * 64 + fr, col0 = uu.pn * 128 + wc * 16 + 4 * fq;
#pragma unroll
        for (int ai = 0; ai < 2; ++ai)
#pragma unroll
            for (int m = 0; m < 4; ++m) {
                bf16* rowp = act + (size_t)(row0 + ai * 128 + m * 16) * FFH + col0;
#pragma unroll
                for (int bj = 0; bj < 2; ++bj) {
                    const pf4 g = acc[ai][bj][m][0], up = acc[ai][bj][m][1]; pf4 r;
#pragma unroll
                    for (int e = 0; e < 4; ++e) r[e] = g[e] * sigm(g[e]) * up[e];
                    v2u w; w.x = pg8::cvt_pk_bf16(r[0], r[1]); w.y = pg8::cvt_pk_bf16(r[2], r[3]);
                    *(v2u*)(rowp + bj * 64) = w;
                }
                asm volatile("" ::: "memory");
            }
    }
};

__device__ __forceinline__ float halfmax(float m) { auto rr = __builtin_amdgcn_permlane32_swap(__float_as_uint(m), __float_as_uint(m), false, false); return fmaxf(__uint_as_float(rr[0]), __uint_as_float(rr[1])); }
__device__ __forceinline__ float halfsum(float m) { auto rr = __builtin_amdgcn_permlane32_swap(__float_as_uint(m), __float_as_uint(m), false, false); return __uint_as_float(rr[0]) + __uint_as_float(rr[1]); }
typedef short v4i16_t __attribute__((ext_vector_type(4)));
__device__ __forceinline__ s16x4 trrd(LAS unsigned char* p) { return __builtin_bit_cast(s16x4, __builtin_amdgcn_ds_read_tr16_b64_v4i16((LAS v4i16_t*)p)); }
__device__ __forceinline__ void dil_unit(const bf16* Qg, const bf16* Kg, const bf16* Vg, bf16* Og, float* Lg, int r, int n, int dil, int T, LAS unsigned char* wl, int lane) {
    const int r32 = lane & 31, hi = lane >> 5;
    LAS unsigned char* vimg = wl;
    LAS bf16* stg = (LAS bf16*)(wl + 4096);
    LAS float* wsf = (LAS float*)(wl + 8192);
    const int vwr = ((lane & 7) >> 2) * 2048 + (lane >> 3) * 64 + (lane & 3) * 16;
    const int vrd = ((lane >> 4) & 1) * 32 + (lane & 3) * 8 + (4 * hi + ((lane & 15) >> 2)) * 64;
    for (int qi = 0; qi < 2; ++qi) {
        const int tq0 = 64 * n + 32 * qi;
        const bf16* qp = Qg + (size_t)(r + dil * (tq0 + r32)) * 512 + 8 * hi;
        bf16x8 qf[4];
#pragma unroll
        for (int d0 = 0; d0 < 4; ++d0) qf[d0] = *(const bf16x8*)(qp + 16 * d0);
        f32x16 s[5];
#pragma unroll
        for (int kb = 0; kb < 5; ++kb) {
            const int tk0 = tq0 - 64 + 32 * kb; int tk = tk0 + r32; tk = tk < 0 ? 0 : (tk >= T ? T - 1 : tk);
            const bf16* kp = Kg + (size_t)(r + dil * tk) * 512 + 8 * hi;
            bf16x8 kf[4];
#pragma unroll
            for (int d0 = 0; d0 < 4; ++d0) kf[d0] = *(const bf16x8*)(kp + 16 * d0);
            f32x16 acc = {};
#pragma unroll
            for (int d0 = 0; d0 < 4; ++d0) acc = __builtin_amdgcn_mfma_f32_32x32x16_bf16(kf[d0], qf[d0], acc, 0, 0, 0);
#pragma unroll
            for (int rr = 0; rr < 16; ++rr) {
                const int cr = (rr & 3) + 8 * (rr >> 2) + 4 * hi; const int rel = -64 + 32 * kb + cr - r32; const int kt = tk0 + cr;
                const bool ok = (rel >= -64) && (rel <= 64) && (kt >= 0) && (kt < T);
                acc[rr] = ok ? acc[rr] : -INFINITY;
            }
            s[kb] = acc;
        }
        float mx = -INFINITY;
#pragma unroll
        for (int kb = 0; kb < 5; ++kb)
#pragma unroll
            for (int rr = 0; rr < 16; ++rr) mx = fmaxf(mx, s[kb][rr]);
        mx = halfmax(mx);
        float lsum = 0.f;
#pragma unroll
        for (int kb = 0; kb < 5; ++kb)
#pragma unroll
            for (int rr = 0; rr < 16; ++rr) { const float p = __builtin_amdgcn_exp2f(s[kb][rr] - mx); s[kb][rr] = p; lsum += p; }
        lsum = halfsum(lsum);
        f32x16 o[2]; o[0] = f32x16{}; o[1] = f32x16{};
#pragma unroll
        for (int kb = 0; kb < 5; ++kb) {
            const int tk0 = tq0 - 64 + 32 * kb;
            bf16x8 vv[4];
#pragma unroll
            for (int j = 0; j < 4; ++j) { int tk = tk0 + 8 * j + (lane >> 3); tk = tk < 0 ? 0 : (tk >= T ? T - 1 : tk);
                vv[j] = *(const bf16x8*)(Vg + (size_t)(r + dil * tk) * 512 + 8 * (lane & 7)); }
#pragma unroll
            for (int j = 0; j < 4; ++j) *(LAS bf16x8*)(vimg + vwr + j * 512) = vv[j];
#pragma unroll
            for (int ks = 0; ks < 2; ++ks) {
                v4u pw;
#pragma unroll
                for (int e = 0; e < 4; ++e) pw[e] = pg8::cvt_pk_bf16(s[kb][8 * ks + 2 * e], s[kb][8 * ks + 2 * e + 1]);
                const bf16x8 pa = __builtin_bit_cast(bf16x8, pw);
#pragma unroll
                for (int d0 = 0; d0 < 2; ++d0) {
                    const s16x4 lo = trrd(vimg + vrd + d0 * 2048 + ks * 1024), hh = trrd(vimg + vrd + d0 * 2048 + ks * 1024 + 512);
                    const bf16x8 vb = (bf16x8){lo[0], lo[1], lo[2], lo[3], hh[0], hh[1], hh[2], hh[3]};
                    o[d0] = __builtin_amdgcn_mfma_f32_32x32x16_bf16(pa, vb, o[d0], 0, 0, 0);
                }
            }
        }
        if (hi == 0) wsf[r32] = lsum;
#pragma unroll
        for (int rr = 0; rr < 16; ++rr) {
            const int orow = (rr & 3) + 8 * (rr >> 2) + 4 * hi; const float rl = __builtin_amdgcn_rcpf(wsf[orow]);
#pragma unroll
            for (int d0 = 0; d0 < 2; ++d0) stg[orow * 64 + d0 * 32 + r32] = (bf16)f2bf(o[d0][rr] * rl);
        }
#pragma unroll
        for (int i = 0; i < 4; ++i) { const int row = i * 8 + (lane >> 3), ch = lane & 7; const v4u v = *(const LAS v4u*)(stg + row * 64 + ch * 8);
            *(v4u*)(Og + (size_t)(r + dil * (tq0 + row)) * 512 + ch * 8) = v; }
        if (hi == 0) Lg[(size_t)(r + dil * (tq0 + r32)) * 8] = mx + __builtin_amdgcn_logf(lsum);
    }
}

__global__ void __launch_bounds__(NWAVES * 64, 2) fwd_megakernel(Args a) {
    extern __shared__ __attribute__((aligned(16))) unsigned char lds_raw[];
    cg::grid_group grid = cg::this_grid();
    LAS unsigned char* lds = (LAS unsigned char*)lds_raw;
    const int tid = threadIdx.x, lane = tid & 63, wave = __builtin_amdgcn_readfirstlane(tid >> 6);
    const int G = gridDim.x, bx = blockIdx.x;
    const int vcu = (G % 8 == 0) ? (bx % 8) * (G / 8) + bx / 8 : bx;
    const int gw = vcu * NWAVES + wave, NGW = G * NWAVES;

#ifndef NO_P0
    p0_prologue(lds, tid, lane, wave, vcu, G);
#endif
    grid.sync();

    const int lane0 = lane;
    for (int c = 0; c < NCHUNK; ++c) {
        int lane = lane0; asm volatile("" : "+v"(lane));
        const int S = (c < 2) ? S_P : S_S, nseq = CT / S, b0 = (c < 2) ? c * 8 : 16;
#define FETCH() CArgs ap = argp(); unsigned char* ws = ap->ws; const float* mod = (const float*)(ws + WS_MOD); (void)mod
#define XC() ((c < 2) ? ap->x_prompt + (size_t)c * CT * 1024 : ap->x_sample)
#define OUTC() (ap->out + (size_t)c * CT * 1024)
        { FETCH(); rows_norm_mod(XC(), (bf16*)(ws + WS_H), ap->g_mix, mod, 0, 1, S, b0, gw, NGW, lane); }
        grid.sync();
        {   FETCH();
            pg8::Gemm g{(const pg8::bf16_t*)(ws + WS_H), (const pg8::bf16_t*)(ws + WS_WIN), CT, NIN, 1024}; pg8::StaticOrder So; So.init(CT, NIN, G, bx);
            EpiIn E{ws, S};
#ifndef NO_GIN
            pg8::gemm_phase<EpiIn, pg8::StaticOrder, PG8_ALIGN, PG8_SP2>(lds, g, So, E);
#endif
        }
        grid.sync();
        {   FETCH();
            const int NQB = S / 256, NT = S / 64, nunits = nseq * 32 * NQB;
            for (int id = vcu; id < nunits; id += G) {
                const int qb = id % NQB; int t = id / NQB; const int combo = t & 3; t >>= 2; const int h8 = t & 7, seq = t >> 3;
                const int cmap = combo >> 1, vh = combo & 1;
                const size_t rb = (size_t)seq * S * 1024;
                const attn_body::bf16* Qp = (const attn_body::bf16*)(ws + WS_QA) + rb + (h8 * 2 + cmap) * 64;
                const attn_body::bf16* Kp = (const attn_body::bf16*)(ws + WS_KA) + rb + (h8 * 2 + cmap) * 64;
                const attn_body::bf16* Vp = (const attn_body::bf16*)(ws + WS_VA) + rb + (h8 * 2 + vh) * 64;
                attn_body::bf16* Op = (attn_body::bf16*)(ws + (cmap ? WS_O2 : WS_O1)) + rb + (h8 * 2 + vh) * 64;
#ifndef NO_ATT
                attn_body::attn_unit<8>(Qp, Kp, Vp, Op, qb * 256, NT, (char*)lds_raw);
#endif
            }
            __syncthreads();
            const int nb64 = S / 64, ndu = 3 * nseq * nb64;
            for (int id = vcu; id < ndu; id += G) {
                const int rn = id % nb64; int t = id / nb64; const int seq = t % nseq, g = t / nseq;
                const int dil = (g == 0) ? 1 : (g == 1 ? 4 : 16), T = S / dil, nb = T / 64, r = rn / nb, n = rn % nb;
                const size_t rb = (size_t)seq * S * 512 + wave * 64;
                const bf16* Qg = (const bf16*)(ws + WS_G0 + (size_t)(g * 3 + 0) * 32 * MiB) + rb;
                const bf16* Kg = (const bf16*)(ws + WS_G0 + (size_t)(g * 3 + 1) * 32 * MiB) + rb;
                const bf16* Vg = (const bf16*)(ws + WS_G0 + (size_t)(g * 3 + 2) * 32 * MiB) + rb;
                bf16* Og = (bf16*)(ws + WS_OG + (size_t)g * 32 * MiB) + rb;
                float* Lg = (float*)(ws + WS_LSE) + ((size_t)g * CT + (size_t)seq * S) * 8 + wave;
#ifndef NO_DIL
                dil_unit(Qg, Kg, Vg, Og, Lg, r, n, dil, T, lds + wave * 8704, lane);
#endif
            }
        }
        grid.sync();
#ifndef NO_COMB
        rows_combine(gw, NGW, lane);
#endif
        grid.sync();
        {   FETCH();
            pg8::StaticOrder So; So.init(CT, 1024, G, bx);
            pg8::Gemm ga{(const pg8::bf16_t*)(ws + WS_OA), (const pg8::bf16_t*)(ws + WS_WA), CT, 1024, 1024};
            EpiGate Ea{(const bf16*)(ws + WS_G1), (bf16*)(ws + WS_MRG), 0};
#ifndef NO_GG
            pg8::gemm_phase<EpiGate, pg8::StaticOrder, PG8_ALIGN, PG8_SP2>(lds, ga, So, Ea);
#endif
            pg8::Gemm gb{(const pg8::bf16_t*)(ws + WS_OB), (const pg8::bf16_t*)(ws + WS_WB), CT, 1024, 512};
            EpiGate Eb{(const bf16*)(ws + WS_G2), (bf16*)(ws + WS_MRG), 1};
#ifndef NO_GG
            pg8::gemm_phase<EpiGate, pg8::StaticOrder, PG8_ALIGN, PG8_SP2>(lds, gb, So, Eb);
#endif
        }
        grid.sync();
        {   FETCH();
            pg8::StaticOrder So; So.init(CT, 1024, G, bx);
            pg8::Gemm g{(const pg8::bf16_t*)(ws + WS_MRG), (const pg8::bf16_t*)(ws + WS_WOUT), CT, 1024, 1024};
            EpiRes E{XC(), OUTC(), mod, 2, S, b0};
#ifndef NO_GR
            pg8::gemm_phase<EpiRes, pg8::StaticOrder, PG8_ALIGN, PG8_SP2>(lds, g, So, E);
#endif
        }
        grid.sync();
        { FETCH(); rows_norm_mod(OUTC(), (bf16*)(ws + WS_H), ap->g_ffn, mod, 3, 4, S, b0, gw, NGW, lane); }
        grid.sync();
        {   FETCH();
            pg8::StaticOrder So; So.init(CT, 2 * FFH, G, bx);
            pg8::Gemm g{(const pg8::bf16_t*)(ws + WS_H), (const pg8::bf16_t*)(ws + WS_WGU), CT, 2 * FFH, 1024};
            EpiGU E{(bf16*)(ws + WS_ACT)};
#ifndef NO_GU
            pg8::gemm_phase<EpiGU, pg8::StaticOrder, PG8_ALIGN, PG8_SP2>(lds, g, So, E);
#endif
        }
        grid.sync();
        {   FETCH();
            pg8::StaticOrder So; So.init(CT, 1024, G, bx);
            pg8::Gemm g{(const pg8::bf16_t*)(ws + WS_ACT), (const pg8::bf16_t*)(ws + WS_WDN), CT, 1024, FFH};
            float* oc_ = OUTC(); EpiRes E{oc_, oc_, mod, 5, S, b0};
#ifndef NO_GR
            pg8::gemm_phase<EpiRes, pg8::StaticOrder, PG8_ALIGN, PG8_SP2>(lds, g, So, E);
#endif
        }
        grid.sync();
        { FETCH(); rows_final_norm(OUTC(), ap->g_final, gw, NGW, lane); }
    }
}

extern "C" void kernel_launch(void* const* d_in, const int* in_sizes, int n_in, void* d_out, int out_size, void* d_ws, size_t ws_size, hipStream_t stream) {
    static int grid = 0;
    if (grid == 0) {
        if (n_in != 20 || ws_size < WS_END) { fprintf(stderr, "kernel_launch: unexpected n_in %d / ws_size %zu (need %zu)\n", n_in, ws_size, (size_t)WS_END); grid = -1; return; }
        int dev = 0, cus = 0, per_cu = 0;
        hipGetDevice(&dev); hipDeviceGetAttribute(&cus, hipDeviceAttributeMultiprocessorCount, dev);
        if (hipFuncSetAttribute((const void*)fwd_megakernel, hipFuncAttributeMaxDynamicSharedMemorySize, LDS_BYTES) != hipSuccess) { fprintf(stderr, "kernel_launch: hipFuncSetAttribute failed\n"); grid = -1; return; }
        if (hipOccupancyMaxActiveBlocksPerMultiprocessor(&per_cu, (const void*)fwd_megakernel, NWAVES * 64, LDS_BYTES) != hipSuccess || per_cu < 1) { fprintf(stderr, "kernel_launch: occupancy query says %d\n", per_cu); per_cu = 1; }
        (void)hipGetLastError();
        grid = cus * 1;
        fprintf(stderr, "kernel_launch: grid %d (cus %d, per_cu %d)\n", grid, cus, per_cu);
    }
    if (grid < 0) return;
    Args a{};
    a.x_prompt = (const float*)d_in[0]; a.x_sample = (const float*)d_in[1]; a.c_prompt = (const float*)d_in[2]; a.c_sample = (const float*)d_in[3];
    a.w_ada = (const float*)d_in[4]; a.b_ada = (const float*)d_in[5]; a.g_mix = (const float*)d_in[6]; a.w_in = (const float*)d_in[7];
    a.lq1 = (const float*)d_in[8]; a.lk1 = (const float*)d_in[9]; a.lq2 = (const float*)d_in[10]; a.lk2 = (const float*)d_in[11]; a.g_subln = (const float*)d_in[12];
    a.w_a = (const float*)d_in[13]; a.w_b = (const float*)d_in[14]; a.w_out = (const float*)d_in[15]; a.g_ffn = (const float*)d_in[16]; a.w_gu = (const float*)d_in[17];
    a.w_down = (const float*)d_in[18]; a.g_final = (const float*)d_in[19];
    a.out = (float*)d_out; a.ws = (unsigned char*)d_ws;
    void* args[] = {&a};
    hipError_t e = hipLaunchCooperativeKernel((const void*)fwd_megakernel, dim3(grid), dim3(NWAVES * 64), args, LDS_BYTES, stream);
    if (e != hipSuccess) fprintf(stderr, "kernel_launch: cooperative launch failed: %s (grid %d)\n", hipGetErrorString(e), grid);
}
```

```cpp
#include <hip/hip_runtime.h>
#include <hip/hip_bf16.h>
#include <hip/hip_cooperative_groups.h>
#include <cstdio>
#include <cstdint>
namespace cg = cooperative_groups;
namespace pg8 {
#define PG8_LAS __attribute__((address_space(3)))
typedef unsigned short bf16_t;
typedef short bf16x8 __attribute__((ext_vector_type(8)));
typedef float f32x4 __attribute__((ext_vector_type(4)));
typedef unsigned u32x4 __attribute__((ext_vector_type(4)));
constexpr int BM = 256, BK = 64, HALF = 128, HTB = HALF * BK * 2  , STAGE_BYTES = 8 * HTB, NXCD = 8, WGM = 8;

__host__ __device__ __forceinline__ int lds_byte(int r, int c) { const int st = (r >> 4) * 2 + (c >> 5), rr = r & 15, cc = c & 31, ob = rr * 64 + cc * 2; return st * 1024 + (ob ^ (((ob >> 9) & 1) << 5)); }
__host__ __device__ __forceinline__ void stage_rc(int b, int& R, int& C) { const int st = b / 1024, sb = b % 1024, swz = sb ^ (((sb >> 9) & 1) << 5); R = (st >> 1) * 16 + swz / 64; C = (st & 1) * 32 + (swz % 64) / 2; }
__host__ __device__ __forceinline__ int perm32(int rho) { const int n = rho >> 4, i = rho & 15; return 8 * (i >> 2) + 4 * n + (i & 3); }

struct Unit { int pm, pn; };
struct Gemm { const bf16_t* A; const bf16_t* Bt; int M, N, K; };

struct StaticOrder {
    int nM, nN, nwg, G, c;
    __host__ __device__ void init(int M, int N, int G_, int c_) { nM = M / BM; nN = N / BM; nwg = nM * nN; G = G_; c = c_; }
    __host__ __device__ bool next(int i, Unit& u) const {
        const long L = (long)i * G + c; if (L >= nwg) return false;
        int wgid = (int)L; { const int q = nwg / NXCD, r = nwg % NXCD, xcd = wgid % NXCD, off = wgid / NXCD; wgid = (xcd < r ? xcd * (q + 1) : r * (q + 1) + (xcd - r) * q) + off; }
        const int nig = WGM * nN, gid = wgid / nig, fm = gid * WGM, gsz = (nM - fm) < WGM ? (nM - fm) : WGM;
        u.pm = fm + ((wgid % nig) % gsz); u.pn = (wgid % nig) / gsz; return true;
    }
    __device__ __forceinline__ void a_ready(const Unit&) const {}
    __device__ __forceinline__ void done(const Unit&) const {}
};

__device__ __forceinline__ unsigned cvt_pk_bf16(float lo, float hi) { unsigned r; asm volatile("v_cvt_pk_bf16_f32 %0, %1, %2" : "=v"(r) : "v"(lo), "v"(hi)); return r; }
typedef float f32x2 __attribute__((ext_vector_type(2)));
template <class Epi, class Sched, bool ALIGN_EPI = false, bool SP2 = false>
__device__ __forceinline__ void gemm_phase(PG8_LAS unsigned char* lds, const Gemm g, const Sched& S, const Epi& E) {
    int tid_ = threadIdx.x; asm volatile("" : "+v"(tid_));
    const int tid = tid_, wid = __builtin_amdgcn_readfirstlane(tid >> 6), lane = tid & 63, wr = wid >> 2, wc = wid & 3, fr = lane & 15, fq = lane >> 4;
    const int K = g.K, nt = K / BK;
    unsigned voffA[2], voffB[2];
#pragma unroll
    for (int i = 0; i < 2; ++i) { int R, C; stage_rc(tid * 16 + i * 8192, R, C); const int Rb = Epi::PERM ? ((R & ~31) + perm32(R & 31)) : R;
        voffA[i] = (unsigned)(R * K + C) * 2u; voffB[i] = (unsigned)(Rb * K + C) * 2u; }
    const size_t kstep = (size_t)(BK * 2);
    const size_t hstep = (size_t)HALF * K * 2;
    const size_t tstep = 2 * hstep;
    const unsigned ldsw = (unsigned)wid * 1024u;
    const int aoff = lds_byte(wr * 64 + fr, fq * 8), boff = lds_byte(wc * 32 + fr, fq * 8);
#define PG8_SA(b, h) (((b) * 2 + (h)) * HTB)
#define PG8_SB(b, h) ((4 + (b) * 2 + (h)) * HTB)
#define PG8_STAGE(bufoff, gbase, voff) do { _Pragma("unroll") for (int _i = 0; _i < 2; ++_i) \
        __builtin_amdgcn_global_load_lds((const unsigned*)((const char*)(gbase) + (voff)[_i]), (PG8_LAS unsigned*)(lds + (bufoff) + ldsw + _i * 8192), 16, 0, 0); } while (0)
#define PG8_LDA(dst, b, h) do { _Pragma("unroll") for (int m = 0; m < 4; ++m) _Pragma("unroll") for (int k = 0; k < 2; ++k) dst[m][k] = *(const PG8_LAS bf16x8*)(lds + PG8_SA(b, h) + aoff + m * 2048 + k * 1024); } while (0)
#define PG8_LDB(dst, b, h) do { _Pragma("unroll") for (int n = 0; n < 2; ++n) _Pragma("unroll") for (int k = 0; k < 2; ++k) dst[n][k] = *(const PG8_LAS bf16x8*)(lds + PG8_SB(b, h) + boff + n * 2048 + k * 1024); } while (0)
#define PG8_MMA(ai, bj, At, Bt) do { __builtin_amdgcn_s_setprio(1); _Pragma("unroll") for (int m = 0; m < 4; ++m) _Pragma("unroll") for (int n = 0; n < 2; ++n) _Pragma("unroll") for (int k = 0; k < 2; ++k) \
        acc[ai][bj][m][n] = __builtin_amdgcn_mfma_f32_16x16x32_bf16(Bt[n][k], At[m][k], acc[ai][bj][m][n], 0, 0, 0); __builtin_amdgcn_s_setprio(0); } while (0)
#define PG8_WAIT_V(n) asm volatile("s_waitcnt vmcnt(" #n ")" ::: "memory")
#define PG8_WAIT_L(n) asm volatile("s_waitcnt lgkmcnt(" #n ")" ::: "memory")
#define PG8_BAR __builtin_amdgcn_s_barrier()
#define PG8_SCHED __builtin_amdgcn_sched_barrier(0)
    Unit cur, nxt; int ui = 0;
    if (!S.next(0, cur)) return;
    f32x4 acc[2][2][4][2];
#pragma unroll
    for (int a = 0; a < 2; ++a)
#pragma unroll
        for (int b = 0; b < 2; ++b)
#pragma unroll
            for (int m = 0; m < 4; ++m)
#pragma unroll
                for (int n = 0; n < 2; ++n) acc[a][b][m][n] = (f32x4){0.f, 0.f, 0.f, 0.f};
    bf16x8 At[4][2], B0[2][2], B1[2][2];
    const char* cA = (const char*)g.A + (size_t)cur.pm * tstep; const char* cB = (const char*)g.Bt + (size_t)cur.pn * tstep;
    S.a_ready(cur);
    if constexpr (SP2) {
        PG8_STAGE(PG8_SB(0, 0), cB, voffB); PG8_STAGE(PG8_SB(0, 1), cB + hstep, voffB); PG8_STAGE(PG8_SA(0, 0), cA, voffA); PG8_STAGE(PG8_SA(0, 1), cA + hstep, voffA);
        if (wr == 1) PG8_BAR;
        PG8_WAIT_V(2); PG8_BAR;
        PG8_STAGE(PG8_SB(1, 0), cB + kstep, voffB); PG8_STAGE(PG8_SA(1, 0), cA + kstep, voffA); PG8_STAGE(PG8_SB(1, 1), cB + hstep + kstep, voffB);
        PG8_WAIT_V(6); PG8_BAR;
    } else {
        PG8_STAGE(PG8_SB(0, 0), cB, voffB); PG8_STAGE(PG8_SA(0, 0), cA, voffA); PG8_STAGE(PG8_SB(0, 1), cB + hstep, voffB); PG8_STAGE(PG8_SA(0, 1), cA + hstep, voffA);
        if (wr == 1) PG8_BAR;
        PG8_WAIT_V(4); PG8_BAR;
        PG8_STAGE(PG8_SB(1, 0), cB + kstep, voffB); PG8_STAGE(PG8_SA(1, 0), cA + kstep, voffA); PG8_STAGE(PG8_SB(1, 1), cB + hstep + kstep, voffB);
        PG8_WAIT_V(6); PG8_BAR;
    }
    for (;;) {
        const bool has_next = S.next(ui + 1, nxt);
        const char* nA = has_next ? (const char*)g.A + (size_t)nxt.pm * tstep : cA; const char* nB = has_next ? (const char*)g.Bt + (size_t)nxt.pn * tstep : cB;
        for (int t = 0; t < nt; t += 2) {
            const bool last = (t == nt - 2);
            const char* a1 = cA + (size_t)(t + 1) * kstep;
            const char* a2 = last ? nA : cA + (size_t)(t + 2) * kstep; const char* b2 = last ? nB : cB + (size_t)(t + 2) * kstep;
            const char* a3 = a2 + kstep; const char* b3 = b2 + kstep;
            if (last && has_next) S.a_ready(nxt);
            if constexpr (SP2) {
            PG8_LDB(B0, 0, 0); PG8_LDB(B1, 0, 1); PG8_SCHED; PG8_LDA(At, 0, 0); PG8_STAGE(PG8_SA(1, 1), a1 + hstep, voffA);
            PG8_WAIT_V(8); PG8_WAIT_L(0); PG8_BAR; PG8_MMA(0, 0, At, B0); PG8_MMA(0, 1, At, B1); PG8_BAR; PG8_SCHED;
            PG8_LDA(At, 0, 1); PG8_STAGE(PG8_SB(0, 0), b2, voffB); PG8_STAGE(PG8_SB(0, 1), b2 + hstep, voffB); PG8_STAGE(PG8_SA(0, 0), a2, voffA);
            PG8_WAIT_V(8); PG8_WAIT_L(0); PG8_BAR; PG8_MMA(1, 0, At, B0); PG8_MMA(1, 1, At, B1); PG8_BAR; PG8_SCHED;
            PG8_LDB(B0, 1, 0); PG8_LDB(B1, 1, 1); PG8_SCHED; PG8_LDA(At, 1, 0); PG8_STAGE(PG8_SA(0, 1), a2 + hstep, voffA);
            PG8_WAIT_V(8); PG8_WAIT_L(0); PG8_BAR; PG8_MMA(0, 0, At, B0); PG8_MMA(0, 1, At, B1); PG8_BAR; PG8_SCHED;
            PG8_LDA(At, 1, 1); PG8_STAGE(PG8_SB(1, 0), b3, voffB); PG8_STAGE(PG8_SB(1, 1), b3 + hstep, voffB); PG8_STAGE(PG8_SA(1, 0), a3, voffA);
            PG8_WAIT_V(8); PG8_WAIT_L(0); PG8_BAR; PG8_MMA(1, 0, At, B0); PG8_MMA(1, 1, At, B1); PG8_BAR; PG8_SCHED;
            } else {
            PG8_LDB(B0, 0, 0); PG8_SCHED; PG8_LDA(At, 0, 0); PG8_STAGE(PG8_SA(1, 1), a1 + hstep, voffA);
            PG8_WAIT_L(8); PG8_BAR; PG8_WAIT_L(0); PG8_MMA(0, 0, At, B0); PG8_BAR; PG8_SCHED;
            PG8_LDB(B1, 0, 1); PG8_STAGE(PG8_SB(0, 0), b2, voffB);
            PG8_BAR; PG8_WAIT_L(0); PG8_MMA(0, 1, At, B1); PG8_BAR;
            PG8_LDA(At, 0, 1); PG8_STAGE(PG8_SA(0, 0), a2, voffA);
            PG8_BAR; PG8_WAIT_L(0); PG8_MMA(1, 0, At, B0); PG8_BAR; PG8_SCHED;
            PG8_STAGE(PG8_SB(0, 1), b2 + hstep, voffB);
            PG8_WAIT_V(6); PG8_BAR; PG8_MMA(1, 1, At, B1); PG8_BAR;
            PG8_LDB(B0, 1, 0); PG8_SCHED; PG8_LDA(At, 1, 0); PG8_STAGE(PG8_SA(0, 1), a2 + hstep, voffA);
            PG8_WAIT_L(8); PG8_BAR; PG8_WAIT_L(0); PG8_MMA(0, 0, At, B0); PG8_BAR; PG8_SCHED;
            PG8_LDB(B1, 1, 1); PG8_STAGE(PG8_SB(1, 0), b3, voffB);
            PG8_BAR; PG8_WAIT_L(0); PG8_MMA(0, 1, At, B1); PG8_BAR;
            PG8_LDA(At, 1, 1); PG8_STAGE(PG8_SA(1, 0), a3, voffA);
            PG8_BAR; PG8_WAIT_L(0); PG8_MMA(1, 0, At, B0); PG8_BAR; PG8_SCHED;
            PG8_STAGE(PG8_SB(1, 1), b3 + hstep, voffB);
            PG8_WAIT_V(6); PG8_BAR; PG8_MMA(1, 1, At, B1); PG8_BAR;
            }
        }
        if constexpr (ALIGN_EPI) { if (wr == 0) PG8_BAR; }
        if constexpr (!Epi::AFTER_DRAIN) { E(acc, cur, wr, wc, fr, fq); S.done(cur); }
        if (!has_next) break;
#pragma unroll
        for (int a = 0; a < 2; ++a)
#pragma unroll
            for (int b = 0; b < 2; ++b)
#pragma unroll
                for (int m = 0; m < 4; ++m)
#pragma unroll
                    for (int n = 0; n < 2; ++n) acc[a][b][m][n] = (f32x4){0.f, 0.f, 0.f, 0.f};
        cur = nxt; cA = nA; cB = nB; ++ui;
        if constexpr (ALIGN_EPI) { if (wr == 1) PG8_BAR; }
    }
    PG8_WAIT_V(0);
    if constexpr (!ALIGN_EPI) { if (wr == 0) PG8_BAR; }
    PG8_BAR;
    if constexpr (Epi::AFTER_DRAIN) { E.fused(acc, cur, wr, wc, fr, fq, lds, wid, lane); S.done(cur); }
#undef PG8_SA
#undef PG8_SB
#undef PG8_STAGE
#undef PG8_LDA
#undef PG8_LDB
#undef PG8_MMA
#undef PG8_WAIT_V
#undef PG8_WAIT_L
#undef PG8_BAR
#undef PG8_SCHED
}
}
#ifndef PG8_SP2
#define PG8_SP2 true
#endif
#ifndef PG8_ALIGN
#define PG8_ALIGN true
#endif
#include <hip/hip_bf16.h>
#include <cmath>
namespace attn_body {
using bf16=__hip_bfloat16;
using bf16x8=__attribute__((ext_vector_type(8)))short;
using s16x4=__attribute__((ext_vector_type(4)))short;
using f32x16=__attribute__((ext_vector_type(16)))float;
using u32x4=__attribute__((ext_vector_type(4)))unsigned;
constexpr int D=64,DM=1024;
constexpr int NW=8,QBLK=32,QB=QBLK*NW,KVBLK=64;
__device__ __forceinline__ int crow(int r,int hi){return (r&3)+8*(r>>2)+4*hi;}
#define SBAR() __builtin_amdgcn_sched_barrier(0)
constexpr int NSLOT=3, SLOTB=8192;
constexpr int LDS_K=0, LDS_V=NSLOT*SLOTB, LDS_WS=2*NSLOT*SLOTB, LDS_OST=LDS_WS+NW*64*4, LDS_BYTES=LDS_OST+NW*4096;
constexpr float C2=0.125f*1.4426950408889634f;
__device__ __forceinline__ void glds16(const void*gsrc,unsigned lds_dst){unsigned keep;
  asm volatile("s_mov_b32 %0, m0\n\ts_mov_b32 m0, %2\n\ts_nop 0\n\tglobal_load_lds_dwordx4 %1, off\n\ts_mov_b32 m0, %0":"=&s"(keep):"v"(gsrc),"s"(lds_dst):"memory");}
__device__ __forceinline__ float max3f(float a,float b,float c){float r;asm("v_max3_f32 %0, %1, %2, %3":"=v"(r):"v"(a),"v"(b),"v"(c));return r;}
__device__ __forceinline__ float max2f(float a,float b){float r;asm("v_max_f32_e32 %0, %1, %2":"=v"(r):"v"(a),"v"(b));return r;}
__device__ __forceinline__ float fadd_s(float a,float b){float r;asm("v_add_f32_e32 %0, %1, %2":"=v"(r):"v"(a),"v"(b));return r;}
__device__ __forceinline__ float fsub_s(float a,float b){float r;asm("v_sub_f32_e32 %0, %1, %2":"=v"(r):"v"(a),"v"(b));return r;}
typedef float f32x2_t __attribute__((ext_vector_type(2))); typedef __bf16 bf16x2_t __attribute__((ext_vector_type(2)));
__device__ __forceinline__ unsigned cvtpk_s(float lo,float hi){f32x2_t v={lo,hi};bf16x2_t b=__builtin_convertvector(v,bf16x2_t);return __builtin_bit_cast(unsigned,b);}
#define WAIT_BAR(N) asm volatile("s_waitcnt vmcnt(" #N ") lgkmcnt(0)\n\ts_barrier":::"memory")

__device__ __forceinline__ void qkt(f32x16&p0,f32x16&p1,const char*Kslot,const bf16x8*qr,const f32x16&negm,int r32,int hi){
  const char*kb=Kslot+hi*1024+r32*16;
  #pragma unroll
  for(int d0=0;d0<4;++d0){
    const bf16x8 b0=*reinterpret_cast<const bf16x8*>(kb+d0*2048);
    const bf16x8 b1=*reinterpret_cast<const bf16x8*>(kb+d0*2048+512);
    if(d0==0){p0=__builtin_amdgcn_mfma_f32_32x32x16_bf16(b0,qr[0],negm,0,0,0);p1=__builtin_amdgcn_mfma_f32_32x32x16_bf16(b1,qr[0],negm,0,0,0);}
    else{p0=__builtin_amdgcn_mfma_f32_32x32x16_bf16(b0,qr[d0],p0,0,0,0);p1=__builtin_amdgcn_mfma_f32_32x32x16_bf16(b1,qr[d0],p1,0,0,0);}}
}
typedef __attribute__((address_space(3))) const char* lds_cptr;
typedef short v4i16_t __attribute__((ext_vector_type(4)));
__device__ __forceinline__ void kload8(bf16x8*kf,lds_cptr kp){
  kf[0]=*(const __attribute__((address_space(3))) bf16x8*)(kp);      kf[1]=*(const __attribute__((address_space(3))) bf16x8*)(kp+512);
  kf[2]=*(const __attribute__((address_space(3))) bf16x8*)(kp+2048); kf[3]=*(const __attribute__((address_space(3))) bf16x8*)(kp+2560);
  kf[4]=*(const __attribute__((address_space(3))) bf16x8*)(kp+4096); kf[5]=*(const __attribute__((address_space(3))) bf16x8*)(kp+4608);
  kf[6]=*(const __attribute__((address_space(3))) bf16x8*)(kp+6144); kf[7]=*(const __attribute__((address_space(3))) bf16x8*)(kp+6656);
}
__device__ __forceinline__ void kload2(bf16x8*kf,lds_cptr kp,int j){ kf[2*j]=*(const __attribute__((address_space(3))) bf16x8*)(kp+j*2048); kf[2*j+1]=*(const __attribute__((address_space(3))) bf16x8*)(kp+j*2048+512); }
__device__ __forceinline__ s16x4 vtr(lds_cptr p){ return __builtin_bit_cast(s16x4,__builtin_amdgcn_ds_read_tr16_b64_v4i16((__attribute__((address_space(3))) v4i16_t*)p)); }
__device__ __forceinline__ float rowmax(const f32x16&p0,const f32x16&p1){
  float a=max3f(p0[0],p0[1],p1[0]),b=max3f(p0[2],p0[3],p1[1]);a=max3f(a,p1[2],p1[3]);
  #pragma unroll
  for(int r=4;r<16;r+=4){a=max3f(a,p0[r],p0[r+1]);b=max3f(b,p0[r+2],p0[r+3]);a=max3f(a,p1[r],p1[r+1]);b=max3f(b,p1[r+2],p1[r+3]);}
  const float m=max2f(a,b);
  auto rr=__builtin_amdgcn_permlane32_swap(__float_as_uint(m),__float_as_uint(m),false,false);
  return max2f(__uint_as_float(rr[0]),__uint_as_float(rr[1]));
}
__device__ __forceinline__ void pv(f32x16*o,int vb,bf16x8 pa0,bf16x8 pa1,bf16x8 pa2,bf16x8 pa3){
  #pragma unroll
  for(int d0=0;d0<2;++d0){s16x4 lo[4],hi[4];
    #pragma unroll
    for(int ks=0;ks<4;++ks){
      asm volatile("ds_read_b64_tr_b16 %0,%1 offset:%c2":"=&v"(lo[ks]):"v"(vb),"i"(d0*4096+ks*1024):"memory");
      asm volatile("ds_read_b64_tr_b16 %0,%1 offset:%c2":"=&v"(hi[ks]):"v"(vb),"i"(d0*4096+ks*1024+512):"memory");}
    asm volatile("s_waitcnt lgkmcnt(0)":::"memory");SBAR();
    #define PK(k) (bf16x8){lo[k][0],lo[k][1],lo[k][2],lo[k][3],hi[k][0],hi[k][1],hi[k][2],hi[k][3]}
    o[d0]=__builtin_amdgcn_mfma_f32_32x32x16_bf16(pa0,PK(0),o[d0],0,0,0);
    o[d0]=__builtin_amdgcn_mfma_f32_32x32x16_bf16(pa1,PK(1),o[d0],0,0,0);
    o[d0]=__builtin_amdgcn_mfma_f32_32x32x16_bf16(pa2,PK(2),o[d0],0,0,0);
    o[d0]=__builtin_amdgcn_mfma_f32_32x32x16_bf16(pa3,PK(3),o[d0],0,0,0);
    #undef PK
  }
}

#ifndef ATTN_STORE16
#define ATTN_STORE16(p,v) (*(u32x4*)(p)=(v))
#endif
template<int THRL> __device__ __forceinline__ void attn_unit(const bf16*Qp,const bf16*__restrict__ Kh,const bf16*__restrict__ Vh,bf16*Op,const int q0,const int NT,char*shm){
  int tid_=threadIdx.x; asm volatile("":"+v"(tid_));
  const int tid=tid_,lane=tid&63,r32=lane&31,hi=lane>>5; const int wid=__builtin_amdgcn_readfirstlane(tid>>6);
  const bf16*Qw=Qp+(long)(q0+wid*QBLK)*DM;
  const unsigned lds0=(unsigned)(uintptr_t)shm;
  float*wsf=(float*)(shm+LDS_WS)+wid*64;
  const bf16*ksrc=Kh+(long)lane*DM+wid*8;
  const bf16*vsrc=Vh+(long)(16*(wid&3)+(lane>>2))*DM+(wid>>2)*32+(lane&3)*8;
  const unsigned kdst=lds0+LDS_K+wid*1024, vdst=lds0+LDS_V+wid*1024;
  #define DMA_K(t,slot) glds16(ksrc+(long)(t)*KVBLK*DM,(unsigned)__builtin_amdgcn_readfirstlane(kdst+(slot)))
  #define DMA_V(t,slot) glds16(vsrc+(long)(t)*KVBLK*DM,(unsigned)__builtin_amdgcn_readfirstlane(vdst+(slot)))
  const int vb0=(int)(lds0+LDS_V)+((lane>>4)&1)*32+(lane&3)*8+(4*hi+((lane&15)>>2))*64;
  const char*Kbase=shm+LDS_K; bf16x8 kf[8];
  const lds_cptr shm3=(lds_cptr)shm; const lds_cptr kp0=shm3+LDS_K+hi*1024+r32*16; const lds_cptr vp0=shm3+LDS_V+((lane>>4)&1)*32+(lane&3)*8+(4*hi+((lane&15)>>2))*64;
  DMA_K(0,0);DMA_V(0,0);DMA_K(1,SLOTB);
  bf16x8 qr[4];
  #pragma unroll
  for(int d0=0;d0<4;++d0)qr[d0]=*reinterpret_cast<const bf16x8*>(&Qw[(long)r32*DM+d0*16+hi*8]);
  float mhat=0.f,l_reg=0.f;f32x16 o[2];o[0]=f32x16{};o[1]=f32x16{};f32x16 negm=f32x16{};asm volatile("":"+v"(negm));
  #define CMASK(P0,P1,t) do{}while(0)
  bool resc=false;
  #define START(P0,P1) do{ const float rm=rowmax(P0,P1); resc=false; \
    { const float dl=rm; mhat=fadd_s(mhat,dl); \
      _Pragma("unroll") for(int r=0;r<16;++r){P0[r]=fsub_s(P0[r],dl);P1[r]=fsub_s(P1[r],dl);} \
      _Pragma("unroll") for(int r=0;r<16;++r)negm[r]=-mhat; asm volatile("":"+v"(negm)); } \
    _Pragma("unroll") for(int r=0;r<16;++r)P0[r]=__builtin_amdgcn_exp2f(P0[r]); }while(0)
  #define RESC() do{ if(resc){ asm volatile("s_waitcnt lgkmcnt(0)":::"memory"); \
      _Pragma("unroll") for(int d_=0;d_<2;++d_) _Pragma("unroll") for(int r=0;r<16;++r)o[d_][r]*=wsf[crow(r,hi)]; } }while(0)
  f32x16 pA0,pA1,pB0,pB1;
  int sl_prev=0,sl_cur=0,sl_next=SLOTB;
  #define ROT() do{sl_prev=sl_cur;sl_cur=sl_next;sl_next=(sl_next==(NSLOT-1)*SLOTB)?0:sl_next+SLOTB;}while(0)
  DMA_K(2,2*SLOTB);
  WAIT_BAR(3);
  qkt(pA0,pA1,Kbase,qr,negm,r32,hi);asm volatile("s_nop 15\n\ts_nop 7":"+v"(pA0),"+v"(pA1));CMASK(pA0,pA1,0);
  START(pA0,pA1);
  _Pragma("unroll") for(int r=0;r<16;++r)pA1[r]=__builtin_amdgcn_exp2f(pA1[r]);
  WAIT_BAR(0);
  DMA_K(3,0);DMA_V(1,SLOTB);
  ROT();
  kload8(kf,kp0+sl_cur);
  WAIT_BAR(2);
  s16x4 vlo[8],vhi[8]; u32x4 pw0,pw1,pw2,pw3;
  #define PKW(P,B) cvtpk_s(P[B],P[B+1])
  #define PAF(k) __builtin_bit_cast(bf16x8,pw##k)
  #define VFR(i) (bf16x8){vlo[i][0],vlo[i][1],vlo[i][2],vlo[i][3],vhi[i][0],vhi[i][1],vhi[i][2],vhi[i][3]}
  #define PIN(x) asm volatile("":"+v"(x))
  #define MX3(a,b,c) __builtin_fmaxf(__builtin_fmaxf((a),(b)),(c))
  #define GAPA(MF,A0,A1,A2,A3,W0,W1,PW) do{ MF; sacc+=A0; sacc+=A1; sacc+=A2; sacc+=A3; PIN(sacc); W0; W1; PIN(PW); SBAR(); }while(0)
  #define EX(v) __builtin_amdgcn_exp2f(v)
  #define GAPB(MF,X,B) do{ MF; X[B]=EX(X[B]); X[B+1]=EX(X[B+1]); X[B+2]=EX(X[B+2]); X[B+3]=EX(X[B+3]); PIN(X); SBAR(); }while(0)
  #define VRD(i) do{ vlo[i]=vtr(vp_+(((i)>>2)*4096+((i)&3)*1024)); vhi[i]=vtr(vp_+(((i)>>2)*4096+((i)&3)*1024+512)); }while(0)
  #define KRD(G,j) do{ if(G){ kload2(kf,kp0+sl_next,j); SBAR(); } }while(0)
  #define STEP(C0,C1,P0,P1,t,GK,GV,GL) do{ SBAR(); \
    const lds_cptr vp_=vp0+sl_prev; \
    VRD(0); SBAR(); float sacc=(P0[0]+P0[1]); \
    GAPA(C0=__builtin_amdgcn_mfma_f32_32x32x16_bf16(kf[0],qr[0],negm,0,0,0), P0[2],P0[3],P0[4],P0[5],     pw0[0]=PKW(P0,0), pw0[1]=PKW(P0,2), pw0); \
    VRD(4); SBAR(); GAPA(C1=__builtin_amdgcn_mfma_f32_32x32x16_bf16(kf[1],qr[0],negm,0,0,0), P0[6],P0[7],P0[8],P0[9],     pw0[2]=PKW(P0,4), pw0[3]=PKW(P0,6), pw0); \
    VRD(1); SBAR(); GAPA(C0=__builtin_amdgcn_mfma_f32_32x32x16_bf16(kf[2],qr[1],C0,0,0,0),   P0[10],P0[11],P0[12],P0[13], pw1[0]=PKW(P0,8), pw1[1]=PKW(P0,10), pw1); \
    VRD(5); SBAR(); GAPA(C1=__builtin_amdgcn_mfma_f32_32x32x16_bf16(kf[3],qr[1],C1,0,0,0),   P0[14],P0[15],P1[0],P1[1],   pw1[2]=PKW(P0,12),pw1[3]=PKW(P0,14), pw1); \
    VRD(2); SBAR(); GAPA(C0=__builtin_amdgcn_mfma_f32_32x32x16_bf16(kf[4],qr[2],C0,0,0,0),   P1[2],P1[3],P1[4],P1[5],     pw2[0]=PKW(P1,0), pw2[1]=PKW(P1,2), pw2); \
    VRD(6); SBAR(); GAPA(C1=__builtin_amdgcn_mfma_f32_32x32x16_bf16(kf[5],qr[2],C1,0,0,0),   P1[6],P1[7],P1[8],P1[9],     pw2[2]=PKW(P1,4), pw2[3]=PKW(P1,6), pw2); \
    VRD(3); SBAR(); GAPA(C0=__builtin_amdgcn_mfma_f32_32x32x16_bf16(kf[6],qr[3],C0,0,0,0),   P1[10],P1[11],P1[12],P1[13], pw3[0]=PKW(P1,8), pw3[1]=PKW(P1,10), pw3); \
    VRD(7); SBAR(); GAPA(C1=__builtin_amdgcn_mfma_f32_32x32x16_bf16(kf[7],qr[3],C1,0,0,0),   P1[14],P1[15],0.f,0.f,       pw3[2]=PKW(P1,12),pw3[3]=PKW(P1,14), pw3); \
    l_reg+=sacc; \
    if(GK){DMA_K((t)+3,sl_cur);} if(GV){DMA_V((t)+1,sl_next);} \
    CMASK(C0,C1,t); \
    { float a=MX3(C0[0],C0[1],C1[0]),b=MX3(C0[2],C0[3],C1[1]); a=MX3(a,C1[2],C1[3]); \
      _Pragma("unroll") for(int r=4;r<16;r+=4){a=MX3(a,C0[r],C0[r+1]);b=MX3(b,C0[r+2],C0[r+3]);a=MX3(a,C1[r],C1[r+1]);b=MX3(b,C1[r+2],C1[r+3]);} \
      float rm=__builtin_fmaxf(a,b); { auto rr=__builtin_amdgcn_permlane32_swap(__float_as_uint(rm),__float_as_uint(rm),false,false); rm=__builtin_fmaxf(__uint_as_float(rr[0]),__uint_as_float(rr[1])); } \
      resc=false; \
      if(__builtin_expect(__any(rm>(float)THRL),0)){ const float dl=__builtin_fmaxf(rm,0.f); mhat+=dl; \
        _Pragma("unroll") for(int r=0;r<16;++r){C0[r]-=dl;C1[r]-=dl;} \
        _Pragma("unroll") for(int r=0;r<16;++r)negm[r]=-mhat; asm volatile("":"+v"(negm)); \
        const float f=__builtin_amdgcn_exp2f(-dl); l_reg*=f; if(hi==0)wsf[r32]=f; resc=true; } } \
    SBAR(); \
    GAPB(o[0]=__builtin_amdgcn_mfma_f32_32x32x16_bf16(PAF(0),VFR(0),o[0],0,0,0), C0,0); \
    GAPB(o[1]=__builtin_amdgcn_mfma_f32_32x32x16_bf16(PAF(0),VFR(4),o[1],0,0,0), C0,4); \
    KRD(GL,0); GAPB(o[0]=__builtin_amdgcn_mfma_f32_32x32x16_bf16(PAF(1),VFR(1),o[0],0,0,0), C0,8); \
    KRD(GL,1); GAPB(o[1]=__builtin_amdgcn_mfma_f32_32x32x16_bf16(PAF(1),VFR(5),o[1],0,0,0), C0,12); \
    KRD(GL,2); GAPB(o[0]=__builtin_amdgcn_mfma_f32_32x32x16_bf16(PAF(2),VFR(2),o[0],0,0,0), C1,0); \
    KRD(GL,3); GAPB(o[1]=__builtin_amdgcn_mfma_f32_32x32x16_bf16(PAF(2),VFR(6),o[1],0,0,0), C1,4); \
    GAPB(o[0]=__builtin_amdgcn_mfma_f32_32x32x16_bf16(PAF(3),VFR(3),o[0],0,0,0), C1,8); \
    GAPB(o[1]=__builtin_amdgcn_mfma_f32_32x32x16_bf16(PAF(3),VFR(7),o[1],0,0,0), C1,12); \
    }while(0)
  int t=1;
  #undef CMASK
  #define CMASK(P0,P1,t) do{}while(0)
  for(;t+5<NT;t+=2){
    STEP(pB0,pB1,pA0,pA1,t,true,true,true);     WAIT_BAR(2); RESC(); ROT();
    STEP(pA0,pA1,pB0,pB1,t+1,true,true,true);   WAIT_BAR(2); RESC(); ROT();
  }
  #undef CMASK
  #define CMASK(P0,P1,t) do{}while(0)
  #define ENDW(tt) do{ if((tt)+3<NT){WAIT_BAR(2);} else if((tt)+2<NT){WAIT_BAR(1);} else {WAIT_BAR(0);} }while(0)
  for(;t+1<NT;t+=2){
    STEP(pB0,pB1,pA0,pA1,t,(t+3<NT),(t+1<NT),(t+1<NT));       ENDW(t);   RESC(); ROT();
    STEP(pA0,pA1,pB0,pB1,t+1,(t+4<NT),(t+2<NT),(t+2<NT));     ENDW(t+1); RESC(); ROT();
  }
  STEP(pB0,pB1,pA0,pA1,NT-1,false,false,false); RESC();
  { float sacc=pB0[0]+pB0[1]; _Pragma("unroll") for(int r=2;r<16;++r)sacc+=pB0[r]; _Pragma("unroll") for(int r=0;r<16;++r)sacc+=pB1[r]; l_reg+=sacc;
    pw0=(u32x4){PKW(pB0,0),PKW(pB0,2),PKW(pB0,4),PKW(pB0,6)};pw1=(u32x4){PKW(pB0,8),PKW(pB0,10),PKW(pB0,12),PKW(pB0,14)};pw2=(u32x4){PKW(pB1,0),PKW(pB1,2),PKW(pB1,4),PKW(pB1,6)};pw3=(u32x4){PKW(pB1,8),PKW(pB1,10),PKW(pB1,12),PKW(pB1,14)};
    SBAR(); pv(o,vb0+sl_cur,PAF(0),PAF(1),PAF(2),PAF(3)); }
  #undef PKW
  #undef PAF
  #undef VFR
  #undef PIN
  #undef MX3
  #undef GAPA
  #undef GAPB
  #undef EX
  #undef VRD
  #undef KRD
  #undef STEP
  #undef ENDW
  {auto rr=__builtin_amdgcn_permlane32_swap(__float_as_uint(l_reg),__float_as_uint(l_reg),false,false);l_reg=__uint_as_float(rr[0])+__uint_as_float(rr[1]);}
  if(hi==0)wsf[32+r32]=l_reg;asm volatile("s_waitcnt lgkmcnt(0)":::"memory");
  float rli[16];
  #pragma unroll
  for(int r=0;r<16;++r)rli[r]=__builtin_amdgcn_rcpf(wsf[32+crow(r,hi)]);
  bf16*Ow=Op+(long)(q0+wid*QBLK)*DM;
  { bf16*stg=(bf16*)(shm+LDS_OST)+wid*2048;
    #pragma unroll
    for(int r=0;r<16;++r){const int orow=crow(r,hi);
      #pragma unroll
      for(int d0=0;d0<2;++d0)stg[orow*64+d0*32+r32]=__float2bfloat16(o[d0][r]*rli[r]);}
    asm volatile("s_waitcnt lgkmcnt(0)":::"memory");
    #pragma unroll
    for(int i=0;i<4;++i){const int row=i*8+(lane>>3),ch=lane&7; const u32x4 v=*(const u32x4*)(stg+row*64+ch*8); ATTN_STORE16(Ow+(long)row*DM+ch*8,v);} }
  asm volatile("s_waitcnt lgkmcnt(0)\n\ts_barrier":::"memory");
  #undef DMA_K
  #undef DMA_V
  #undef CMASK
  #undef START
  #undef RESC
  #undef ROT
}
constexpr int ATTN_LDS_BYTES=LDS_BYTES;
#undef SBAR
#undef WAIT_BAR
}

#define GAS __attribute__((address_space(1)))
#define LAS __attribute__((address_space(3)))
typedef unsigned short bf16;
typedef unsigned v4u __attribute__((ext_vector_type(4)));
typedef unsigned v2u __attribute__((ext_vector_type(2)));
typedef float f32x4 __attribute__((ext_vector_type(4)));
typedef float f32x16 __attribute__((ext_vector_type(16)));
typedef short bf16x8 __attribute__((ext_vector_type(8)));
typedef short s16x4 __attribute__((ext_vector_type(4)));
#define LDS_WAIT() asm volatile("s_waitcnt lgkmcnt(0)" ::: "memory")

constexpr int DMODEL = 1024, NIN = 9728, FFH = 2816;
constexpr int S_P = 4096, S_S = 2048;
constexpr int CT = 32768, NCHUNK = 3;
constexpr float EPS = 1e-6f;
constexpr float C2 = 0.18033688011112042f;
constexpr int LDS_BYTES = 147456;
constexpr int NWAVES = 8;

constexpr size_t MiB = 1u << 20;
constexpr size_t WS_MOD = 1 * MiB, WS_ROPE = 2 * MiB;
constexpr size_t WS_WIN = 4 * MiB, WS_WA = 23 * MiB, WS_WB = 25 * MiB, WS_WOUT = 26 * MiB, WS_WGU = 28 * MiB, WS_WDN = 39 * MiB;
constexpr size_t WS_H = 48 * MiB;
constexpr size_t WS_QA = 112 * MiB, WS_KA = 176 * MiB, WS_VA = 240 * MiB, WS_G0 = 304 * MiB  , WS_G1 = 592 * MiB, WS_G2 = 656 * MiB;
constexpr size_t WS_O1 = 720 * MiB, WS_O2 = 784 * MiB, WS_OG = 848 * MiB  , WS_LSE = 944 * MiB  , WS_END = 948 * MiB;
constexpr size_t WS_OA = WS_QA, WS_OB = WS_G0, WS_MRG = WS_KA, WS_ACT = WS_VA;

struct Args {
    const float *x_prompt, *x_sample, *c_prompt, *c_sample, *w_ada, *b_ada, *g_mix, *w_in, *lq1, *lk1, *lq2, *lk2, *g_subln, *w_a, *w_b, *w_out, *g_ffn, *w_gu, *w_down, *g_final;
    float* out; unsigned char* ws;
};

typedef const __attribute__((address_space(4))) Args* CArgs;
__device__ __forceinline__ CArgs argp() { CArgs p = (CArgs)__builtin_amdgcn_kernarg_segment_ptr(); asm volatile("" : "+s"(p)); return p; }

__device__ __forceinline__ float wave_sum(float v) {
#pragma unroll
    for (int o = 1; o < 64; o <<= 1) v += __shfl_xor(v, o);
    return v;
}
__device__ __forceinline__ unsigned f2bf(float f) { unsigned u = __builtin_bit_cast(unsigned, f); return (u + 0x7fffu + ((u >> 16) & 1u)) >> 16; }
__device__ __forceinline__ unsigned pk2(float lo, float hi) { return f2bf(lo) | (f2bf(hi) << 16); }
__device__ __forceinline__ float bflo(unsigned w) { return __builtin_bit_cast(float, w << 16); }
__device__ __forceinline__ float bfhi(unsigned w) { return __builtin_bit_cast(float, w & 0xffff0000u); }

__device__ __forceinline__ int maprow(int mode, int n) {
    if (mode == 1) {
        const bool qk = (n < 2048) || (n >= 3072 && n < 7680 && ((n - 3072) % 1536) < 1024);
        const int i = n & 63;
        if (qk && i < 16) return n - i + ((i < 8) ? 2 * i : 2 * (i - 8) + 1);
        return n;
    }
    if (mode == 2) {
        const bool up = n >= FFH; const int j = up ? n - FFH : n;
        return 8 * (j >> 2) + (j & 3) + (up ? 4 : 0);
    }
    return n;
}
__device__ __forceinline__ void p0_transpose_item(const float* W, int K, int N, bf16* WT, int mode, LAS float* scr, int item, int lane) {
    const int nblk = N / 32, kb = item / nblk, nb = item % nblk, k0 = 64 * kb, n0 = 32 * nb;
#pragma unroll 8
    for (int i = 0; i < 32; ++i) { const int kk = 2 * i + (lane >> 5); scr[kk * 33 + (lane & 31)] = W[(size_t)(k0 + kk) * N + n0 + (lane & 31)]; }
    LDS_WAIT(); asm volatile("" ::: "memory");
    const int c = lane & 7;
#pragma unroll
    for (int j = 0; j < 4; ++j) { const int n = (lane >> 3) + 8 * j; const LAS float* s = scr + (8 * c) * 33 + n;
        v4u o; o.x = pk2(s[0 * 33], s[1 * 33]); o.y = pk2(s[2 * 33], s[3 * 33]); o.z = pk2(s[4 * 33], s[5 * 33]); o.w = pk2(s[6 * 33], s[7 * 33]);
        *(GAS v4u*)(WT + (size_t)maprow(mode, n0 + n) * K + k0 + 8 * c) = o; }
    LDS_WAIT(); asm volatile("" ::: "memory");
}
__constant__ double ROPE_INVREV[8] = {0.15915494309189535, 0.03086376340470123, 0.005985185712713705, 0.001160663641240061,
                                      0.00022507907903927653, 4.364795279280289e-05, 8.464330808241401e-06, 1.6414262627950345e-06};

__device__ __forceinline__ void p0_prologue(LAS unsigned char* lds, int tid, int lane, int wave, int vcu, int G) {
    CArgs ap = argp(); unsigned char* ws = ap->ws;
    LAS float* scr = (LAS float*)(lds + wave * 16384);
    const int gw = vcu * NWAVES + wave, NGW = G * NWAVES;
    constexpr int I_IN = 16 * (NIN / 32), I_A = 16 * 32, I_B = 8 * 32, I_O = 16 * 32, I_GU = 16 * (2 * FFH / 32), I_DN = (FFH / 64) * 32;
    constexpr int NITEMS = I_IN + I_A + I_B + I_O + I_GU + I_DN;
    for (int it = gw; it < NITEMS; it += NGW) {
        int r = it;
        if (r < I_IN) { p0_transpose_item(ap->w_in, 1024, NIN, (bf16*)(ws + WS_WIN), 1, scr, r, lane); continue; } r -= I_IN;
        if (r < I_A) { p0_transpose_item(ap->w_a, 1024, 1024, (bf16*)(ws + WS_WA), 0, scr, r, lane); continue; } r -= I_A;
        if (r < I_B) { p0_transpose_item(ap->w_b, 512, 1024, (bf16*)(ws + WS_WB), 0, scr, r, lane); continue; } r -= I_B;
        if (r < I_O) { p0_transpose_item(ap->w_out, 1024, 1024, (bf16*)(ws + WS_WOUT), 0, scr, r, lane); continue; } r -= I_O;
        if (r < I_GU) { p0_transpose_item(ap->w_gu, 1024, 2 * FFH, (bf16*)(ws + WS_WGU), 2, scr, r, lane); continue; } r -= I_GU;
        p0_transpose_item(ap->w_down, FFH, 1024, (bf16*)(ws + WS_WDN), 0, scr, r, lane);
    }
    for (int idx = blockIdx.x * 512 + tid; idx < 4096 * 8; idx += G * 512) {
        const int pos = idx >> 3, i = idx & 7;
        const double rev = (double)pos * ROPE_INVREV[i]; const float fr = (float)(rev - __builtin_floor(rev));
        float2 cs; cs.x = __builtin_amdgcn_cosf(fr); cs.y = __builtin_amdgcn_sinf(fr);
        ((float2*)(ws + WS_ROPE))[idx] = cs;
    }
    __syncthreads();
    const int bx = blockIdx.x;
    if (bx < 192) {
        const int n0 = bx * 32, b = lane & 31, h = lane >> 5;
        const float* crow_ = (b < 16) ? ap->c_prompt + (size_t)b * 1024 : ap->c_sample + (size_t)(b - 16) * 1024;
        f32x16 acc = {};
#pragma unroll 4
        for (int i = 0; i < 16; ++i) {
            const int k = 128 * wave + 8 * i + 4 * h;
            const f32x4 c4 = *(const f32x4*)(crow_ + k);
#pragma unroll
            for (int e = 0; e < 4; ++e) {
                const float cv = c4[e], sv = cv / (1.f + __expf(-cv));
                const float wv = ap->w_ada[(size_t)(k + e) * 6144 + n0 + (lane & 31)];
                acc = __builtin_amdgcn_mfma_f32_32x32x2f32(sv, wv, acc, 0, 0, 0);
            }
        }
        LAS float* red = (LAS float*)lds;
#pragma unroll
        for (int r = 0; r < 16; ++r) red[(wave * 16 + r) * 64 + lane] = acc[r];
        __syncthreads();
#pragma unroll
        for (int j = 0; j < 2; ++j) {
            const int o = tid + 512 * j, nn = o & 31, bb = o >> 5;
            const int hh = (bb >> 2) & 1, r = (bb & 3) + 4 * (bb >> 3), ln = nn + 32 * hh;
            float s = ap->b_ada[n0 + nn];
#pragma unroll
            for (int w = 0; w < 8; ++w) s += red[(w * 16 + r) * 64 + ln];
            ((float*)(ws + WS_MOD))[(size_t)bb * 6144 + n0 + nn] = s;
        }
    }
    __syncthreads();
}

__device__ __forceinline__ void rows_norm_mod(const float* xsrc, bf16* dst, const float* gain, const float* mod, int sh_idx, int sc_idx, int S, int b0, int gw, int NGW, int lane) {
    f32x4 g[4];
#pragma unroll
    for (int j = 0; j < 4; ++j) g[j] = *(const f32x4*)(gain + 4 * lane + 256 * j);
    for (int row = gw; row < CT; row += NGW) {
        const int b = b0 + row / S;
        const GAS f32x4* xr = (const GAS f32x4*)(xsrc + (size_t)row * 1024) + lane;
        f32x4 v[4]; float ss = 0.f;
#pragma unroll
        for (int j = 0; j < 4; ++j) { v[j] = xr[64 * j]; ss += (v[j].x * v[j].x + v[j].y * v[j].y) + (v[j].z * v[j].z + v[j].w * v[j].w); }
        const float rstd = 1.f / sqrtf(wave_sum(ss) * (1.f / 1024.f) + EPS);
        const float* mb = mod + (size_t)b * 6144;
        GAS unsigned long long* o8 = (GAS unsigned long long*)(dst + (size_t)row * 1024) + lane;
#pragma unroll
        for (int j = 0; j < 4; ++j) {
            const f32x4 sc = *(const f32x4*)(mb + sc_idx * 1024 + 4 * lane + 256 * j), sh = *(const f32x4*)(mb + sh_idx * 1024 + 4 * lane + 256 * j);
            const f32x4 h = v[j] * rstd * g[j] * (1.f + sc) + sh;
            o8[64 * j] = (unsigned long long)pk2(h.x, h.y) | ((unsigned long long)pk2(h.z, h.w) << 32);
        }
    }
}
__device__ __forceinline__ void rows_final_norm(float* x, const float* gain, int gw, int NGW, int lane) {
    f32x4 g[4];
#pragma unroll
    for (int j = 0; j < 4; ++j) g[j] = *(const f32x4*)(gain + 4 * lane + 256 * j);
    for (int row = gw; row < CT; row += NGW) {
        GAS f32x4* xr = (GAS f32x4*)(x + (size_t)row * 1024) + lane;
        f32x4 v[4]; float ss = 0.f;
#pragma unroll
        for (int j = 0; j < 4; ++j) { v[j] = xr[64 * j]; ss += (v[j].x * v[j].x + v[j].y * v[j].y) + (v[j].z * v[j].z + v[j].w * v[j].w); }
        const float rstd = 1.f / sqrtf(wave_sum(ss) * (1.f / 1024.f) + EPS);
#pragma unroll
        for (int j = 0; j < 4; ++j) xr[64 * j] = v[j] * rstd * g[j];
    }
}
__device__ __forceinline__ void rows_combine(int gw, int NGW, int lane) {
    CArgs ap = argp(); unsigned char* ws = ap->ws;
    const float e1 = __expf(wave_sum(ap->lq1[lane] * ap->lk1[lane])), e2 = __expf(wave_sum(ap->lq2[lane] * ap->lk2[lane]));
    const float lam = e1 - e2 + 0.2f;
    f32x4 gs[4];
#pragma unroll
    for (int j = 0; j < 4; ++j) gs[j] = *(const f32x4*)(ap->g_subln + ((16 * lane) & 127) + 4 * j) * 0.8f;
    const bf16* O1 = (const bf16*)(ws + WS_O1); const bf16* O2 = (const bf16*)(ws + WS_O2); bf16* OA = (bf16*)(ws + WS_OA);
    const bf16* OG = (const bf16*)(ws + WS_OG); const float* LSE = (const float*)(ws + WS_LSE); bf16* OB = (bf16*)(ws + WS_OB);
    for (int row = gw; row < CT; row += NGW) {
        const v4u* p1 = (const v4u*)(O1 + (size_t)row * 1024 + 16 * lane); const v4u* p2 = (const v4u*)(O2 + (size_t)row * 1024 + 16 * lane);
        const v4u a0 = p1[0], a1 = p1[1], b0 = p2[0], b1 = p2[1];
        float d[16];
#pragma unroll
        for (int i = 0; i < 4; ++i) { d[2 * i] = bflo(a0[i]) - lam * bflo(b0[i]); d[2 * i + 1] = bfhi(a0[i]) - lam * bfhi(b0[i]);
                                      d[8 + 2 * i] = bflo(a1[i]) - lam * bflo(b1[i]); d[8 + 2 * i + 1] = bfhi(a1[i]) - lam * bfhi(b1[i]); }
        float ss = 0.f;
#pragma unroll
        for (int i = 0; i < 16; ++i) ss += d[i] * d[i];
        ss += __shfl_xor(ss, 1); ss += __shfl_xor(ss, 2); ss += __shfl_xor(ss, 4);
        const float rs = 1.f / sqrtf(ss * (1.f / 128.f) + EPS);
        v4u o0, o1;
#pragma unroll
        for (int i = 0; i < 4; ++i) { o0[i] = pk2(d[2 * i] * rs * gs[i >> 1][(2 * i) & 3], d[2 * i + 1] * rs * gs[i >> 1][(2 * i + 1) & 3]);
                                      o1[i] = pk2(d[8 + 2 * i] * rs * gs[2 + (i >> 1)][(2 * i) & 3], d[8 + 2 * i + 1] * rs * gs[2 + (i >> 1)][(2 * i + 1) & 3]); }
        v4u* po = (v4u*)(OA + (size_t)row * 1024 + 16 * lane); po[0] = o0; po[1] = o1;
        const int hd = lane >> 3;
        const float l0 = LSE[((size_t)0 * CT + row) * 8 + hd], l1 = LSE[((size_t)1 * CT + row) * 8 + hd], l2 = LSE[((size_t)2 * CT + row) * 8 + hd];
        const float mx = fmaxf(l0, fmaxf(l1, l2));
        float w0 = __builtin_amdgcn_exp2f(l0 - mx), w1 = __builtin_amdgcn_exp2f(l1 - mx), w2 = __builtin_amdgcn_exp2f(l2 - mx);
        const float inv = 1.f / (w0 + w1 + w2); w0 *= inv; w1 *= inv; w2 *= inv;
        const v4u g0 = *(const v4u*)(OG + ((size_t)0 * CT + row) * 512 + 8 * lane), g1 = *(const v4u*)(OG + ((size_t)1 * CT + row) * 512 + 8 * lane), g2 = *(const v4u*)(OG + ((size_t)2 * CT + row) * 512 + 8 * lane);
        v4u ob;
#pragma unroll
        for (int i = 0; i < 4; ++i) ob[i] = pk2(w0 * bflo(g0[i]) + w1 * bflo(g1[i]) + w2 * bflo(g2[i]), w0 * bfhi(g0[i]) + w1 * bfhi(g1[i]) + w2 * bfhi(g2[i]));
        *(v4u*)(OB + (size_t)row * 512 + 8 * lane) = ob;
    }
}

using pg8::Unit;
typedef pg8::f32x4 pf4;
__device__ __forceinline__ v4u pack8(const pf4 v0, const pf4 v1) { v4u w; w.x = pg8::cvt_pk_bf16(v0[0], v0[1]); w.y = pg8::cvt_pk_bf16(v0[2], v0[3]); w.z = pg8::cvt_pk_bf16(v1[0], v1[1]); w.w = pg8::cvt_pk_bf16(v1[2], v1[3]); return w; }
__device__ __forceinline__ float sigm(float x) { return __builtin_amdgcn_rcpf(1.f + __expf(-x)); }

struct EpiIn {
    static constexpr bool PERM = true, AFTER_DRAIN = false;
    unsigned char* ws; int S;
    __device__ __forceinline__ void operator()(const pf4 (&acc)[2][2][4][2], const Unit& u, int wr, int wc, int fr, int fq) const {
        int pm_ = u.pm, pn_ = u.pn; asm volatile("" : "+s"(pm_), "+s"(pn_)); const Unit uu{pm_, pn_};
        const int pn = uu.pn; int kind, ldc = 1024, ct; size_t base;
        if (pn < 4) { kind = 1; base = WS_QA; ct = pn; }
        else if (pn < 8) { kind = 2; base = WS_KA; ct = pn - 4; }
        else if (pn < 12) { kind = 0; base = WS_VA; ct = pn - 8; }
        else if (pn < 30) { const int q = pn - 12, g = q / 6, r = q % 6, part = r >> 1; ct = r & 1; ldc = 512; base = WS_G0 + (size_t)(g * 3 + part) * 32 * MiB; kind = part == 0 ? 1 : (part == 1 ? 2 : 0); }
        else if (pn < 34) { kind = 3; base = WS_G1; ct = pn - 30; }
        else { kind = 3; base = WS_G2; ct = pn - 34; }
        bf16* O = (bf16*)(ws + base);
        const int row0 = uu.pm * 256 + wr * 64 + fr, col0 = ct * 256 + wc * 32 + 8 * fq;
        const bool ropew = (kind == 1 || kind == 2) && ((wc & 1) == 0); const bool ropel = fq < 2;
        const float sc = kind == 1 ? C2 : 1.f;
        const float* rope = (const float*)(ws + WS_ROPE);
#pragma unroll
        for (int ai = 0; ai < 2; ++ai)
#pragma unroll
            for (int m = 0; m < 4; ++m) {
                const int row = row0 + ai * 128 + m * 16;
                pf4 cs0 = {1.f, 0.f, 1.f, 0.f}, cs1 = {1.f, 0.f, 1.f, 0.f};
                if (ropew) { const float* rp = rope + ((size_t)(row % S) * 8 + 4 * (fq & 1)) * 2; cs0 = *(const pf4*)rp; cs1 = *(const pf4*)(rp + 4); }
                bf16* rowp = O + (size_t)row * ldc + col0;
#pragma unroll
                for (int bj = 0; bj < 2; ++bj) {
                    pf4 v0 = acc[ai][bj][m][0], v1 = acc[ai][bj][m][1];
                    if (ropew) {
                        pf4 r0, r1;
                        r0[0] = v0[0] * cs0[0] - v0[1] * cs0[1]; r0[1] = v0[1] * cs0[0] + v0[0] * cs0[1];
                        r0[2] = v0[2] * cs0[2] - v0[3] * cs0[3]; r0[3] = v0[3] * cs0[2] + v0[2] * cs0[3];
                        r1[0] = v1[0] * cs1[0] - v1[1] * cs1[1]; r1[1] = v1[1] * cs1[0] + v1[0] * cs1[1];
                        r1[2] = v1[2] * cs1[2] - v1[3] * cs1[3]; r1[3] = v1[3] * cs1[2] + v1[2] * cs1[3];
                        if (ropel) { v0 = r0; v1 = r1; }
                    }
                    if (kind == 3) {
#pragma unroll
                        for (int e = 0; e < 4; ++e) { v0[e] = sigm(v0[e]); v1[e] = sigm(v1[e]); }
                    }
                    v0 = v0 * sc; v1 = v1 * sc;
                    *(v4u*)(rowp + bj * 128) = pack8(v0, v1);
                }
                asm volatile("" ::: "memory");
            }
    }
};
struct EpiGate {
    static constexpr bool PERM = true, AFTER_DRAIN = false;
    const bf16* gate; bf16* O; int mode;
    __device__ __forceinline__ void operator()(const pf4 (&acc)[2][2][4][2], const Unit& u, int wr, int wc, int fr, int fq) const {
        int pm_ = u.pm, pn_ = u.pn; asm volatile("" : "+s"(pm_), "+s"(pn_)); const Unit uu{pm_, pn_};
        const int row0 = uu.pm * 256 + wr * 64 + fr, col0 = uu.pn * 256 + wc * 32 + 8 * fq;
#pragma unroll
        for (int ai = 0; ai < 2; ++ai)
#pragma unroll
            for (int m = 0; m < 4; ++m) {
                const size_t off = (size_t)(row0 + ai * 128 + m * 16) * 1024 + col0;
#pragma unroll
                for (int bj = 0; bj < 2; ++bj) {
                    const v4u gv = *(const v4u*)(gate + off + bj * 128);
                    pf4 v0 = acc[ai][bj][m][0], v1 = acc[ai][bj][m][1];
                    v0[0] *= bflo(gv.x); v0[1] *= bfhi(gv.x); v0[2] *= bflo(gv.y); v0[3] *= bfhi(gv.y);
                    v1[0] *= bflo(gv.z); v1[1] *= bfhi(gv.z); v1[2] *= bflo(gv.w); v1[3] *= bfhi(gv.w);
                    if (mode) { const v4u pv = *(const v4u*)(O + off + bj * 128);
                        v0[0] += bflo(pv.x); v0[1] += bfhi(pv.x); v0[2] += bflo(pv.y); v0[3] += bfhi(pv.y);
                        v1[0] += bflo(pv.z); v1[1] += bfhi(pv.z); v1[2] += bflo(pv.w); v1[3] += bfhi(pv.w); }
                    *(v4u*)(O + off + bj * 128) = pack8(v0, v1);
                }
                asm volatile("" ::: "memory");
            }
    }
};
struct EpiRes {
    static constexpr bool PERM = true, AFTER_DRAIN = false;
    const float* base; float* out; const float* mod; int gidx, S, b0;
    __device__ __forceinline__ void operator()(const pf4 (&acc)[2][2][4][2], const Unit& u, int wr, int wc, int fr, int fq) const {
        int pm_ = u.pm, pn_ = u.pn; asm volatile("" : "+s"(pm_), "+s"(pn_)); const Unit uu{pm_, pn_};
        const int row0 = uu.pm * 256 + wr * 64 + fr, col0 = uu.pn * 256 + wc * 32 + 8 * fq;
        const float* gp = mod + (size_t)(b0 + (uu.pm * 256) / S) * 6144 + gidx * 1024 + col0;
        pf4 gt[2][2];
#pragma unroll
        for (int bj = 0; bj < 2; ++bj) { gt[bj][0] = *(const pf4*)(gp + bj * 128); gt[bj][1] = *(const pf4*)(gp + bj * 128 + 4); }
#pragma unroll
        for (int ai = 0; ai < 2; ++ai)
#pragma unroll
            for (int m = 0; m < 4; ++m) {
                const size_t off = (size_t)(row0 + ai * 128 + m * 16) * 1024 + col0;
#pragma unroll
                for (int bj = 0; bj < 2; ++bj) {
                    const pf4 x0 = *(const pf4*)(base + off + bj * 128), x1 = *(const pf4*)(base + off + bj * 128 + 4);
                    *(pf4*)(out + off + bj * 128) = x0 + gt[bj][0] * acc[ai][bj][m][0];
                    *(pf4*)(out + off + bj * 128 + 4) = x1 + gt[bj][1] * acc[ai][bj][m][1];
                }
                asm volatile("" ::: "memory");
            }
    }
};
struct EpiGU {
    static constexpr bool PERM = true, AFTER_DRAIN = false;
    bf16* act;
    __device__ __forceinline__ void operator()(const pf4 (&acc)[2][2][4][2], const Unit& u, int wr, int wc, int fr, int fq) const {
        int pm_ = u.pm, pn_ = u.pn; asm volatile("" : "+s"(pm_), "+s"(pn_)); const Unit uu{pm_, pn_};
        const int row0 = uu.pm * 256 + wr * 64 + fr, col0 = uu.pn * 128 + wc * 16 + 4 * fq;
#pragma unroll
        for (int ai = 0; ai < 2; ++ai)
#pragma unroll
            for (int m = 0; m < 4; ++m) {
                bf16* rowp = act + (size_t)(row0 + ai * 128 + m * 16) * FFH + col0;
#pragma unroll
                for (int bj = 0; bj < 2; ++bj) {
                    const pf4 g = acc[ai][bj][m][0], up = acc[ai][bj][m][1]; pf4 r;
#pragma unroll
                    for (int e = 0; e < 4; ++e) r[e] = g[e] * sigm(g[e]) * up[e];
                    v2u w; w.x = pg8::cvt_pk_bf16(r[0], r[1]); w.y = pg8::cvt_pk_bf16(r[2], r[3]);
                    *(v2u*)(rowp + bj * 64) = w;
                }
                asm volatile("" ::: "memory");
            }
    }
};

__device__ __forceinline__ float halfmax(float m) { auto rr = __builtin_amdgcn_permlane32_swap(__float_as_uint(m), __float_as_uint(m), false, false); return fmaxf(__uint_as_float(rr[0]), __uint_as_float(rr[1])); }
__device__ __forceinline__ float halfsum(float m) { auto rr = __builtin_amdgcn_permlane32_swap(__float_as_uint(m), __float_as_uint(m), false, false); return __uint_as_float(rr[0]) + __uint_as_float(rr[1]); }
typedef short v4i16_t __attribute__((ext_vector_type(4)));
__device__ __forceinline__ s16x4 trrd(LAS unsigned char* p) { return __builtin_bit_cast(s16x4, __builtin_amdgcn_ds_read_tr16_b64_v4i16((LAS v4i16_t*)p)); }
__device__ __forceinline__ void dil_unit(const bf16* Qg, const bf16* Kg, const bf16* Vg, bf16* Og, float* Lg, int r, int n, int dil, int T, LAS unsigned char* wl, int lane) {
    const int r32 = lane & 31, hi = lane >> 5;
    LAS unsigned char* vimg = wl;
    LAS bf16* stg = (LAS bf16*)(wl + 4096);
    LAS float* wsf = (LAS float*)(wl + 8192);
    const int vwr = ((lane & 7) >> 2) * 2048 + (lane >> 3) * 64 + (lane & 3) * 16;
    const int vrd = ((lane >> 4) & 1) * 32 + (lane & 3) * 8 + (4 * hi + ((lane & 15) >> 2)) * 64;
    for (int qi = 0; qi < 2; ++qi) {
        const int tq0 = 64 * n + 32 * qi;
        const bf16* qp = Qg + (size_t)(r + dil * (tq0 + r32)) * 512 + 8 * hi;
        bf16x8 qf[4];
#pragma unroll
        for (int d0 = 0; d0 < 4; ++d0) qf[d0] = *(const bf16x8*)(qp + 16 * d0);
        f32x16 s[5];
#pragma unroll
        for (int kb = 0; kb < 5; ++kb) {
            const int tk0 = tq0 - 64 + 32 * kb; int tk = tk0 + r32; tk = tk < 0 ? 0 : (tk >= T ? T - 1 : tk);
            const bf16* kp = Kg + (size_t)(r + dil * tk) * 512 + 8 * hi;
            bf16x8 kf[4];
#pragma unroll
            for (int d0 = 0; d0 < 4; ++d0) kf[d0] = *(const bf16x8*)(kp + 16 * d0);
            f32x16 acc = {};
#pragma unroll
            for (int d0 = 0; d0 < 4; ++d0) acc = __builtin_amdgcn_mfma_f32_32x32x16_bf16(kf[d0], qf[d0], acc, 0, 0, 0);
#pragma unroll
            for (int rr = 0; rr < 16; ++rr) {
                const int cr = (rr & 3) + 8 * (rr >> 2) + 4 * hi; const int rel = -64 + 32 * kb + cr - r32; const int kt = tk0 + cr;
                const bool ok = (rel >= -64) && (rel <= 64) && (kt >= 0) && (kt < T);
                acc[rr] = ok ? acc[rr] : -INFINITY;
            }
            s[kb] = acc;
        }
        float mx = -INFINITY;
#pragma unroll
        for (int kb = 0; kb < 5; ++kb)
#pragma unroll
            for (int rr = 0; rr < 16; ++rr) mx = fmaxf(mx, s[kb][rr]);
        mx = halfmax(mx);
        float lsum = 0.f;
#pragma unroll
        for (int kb = 0; kb < 5; ++kb)
#pragma unroll
            for (int rr = 0; rr < 16; ++rr) { const float p = __builtin_amdgcn_exp2f(s[kb][rr] - mx); s[kb][rr] = p; lsum += p; }
        lsum = halfsum(lsum);
        f32x16 o[2]; o[0] = f32x16{}; o[1] = f32x16{};
#pragma unroll
        for (int kb = 0; kb < 5; ++kb) {
            const int tk0 = tq0 - 64 + 32 * kb;
            bf16x8 vv[4];
#pragma unroll
            for (int j = 0; j < 4; ++j) { int tk = tk0 + 8 * j + (lane >> 3); tk = tk < 0 ? 0 : (tk >= T ? T - 1 : tk);
                vv[j] = *(const bf16x8*)(Vg + (size_t)(r + dil * tk) * 512 + 8 * (lane & 7)); }
#pragma unroll
            for (int j = 0; j < 4; ++j) *(LAS bf16x8*)(vimg + vwr + j * 512) = vv[j];
#pragma unroll
            for (int ks = 0; ks < 2; ++ks) {
                v4u pw;
#pragma unroll
                for (int e = 0; e < 4; ++e) pw[e] = pg8::cvt_pk_bf16(s[kb][8 * ks + 2 * e], s[kb][8 * ks + 2 * e + 1]);
                const bf16x8 pa = __builtin_bit_cast(bf16x8, pw);
#pragma unroll
                for (int d0 = 0; d0 < 2; ++d0) {
                    const s16x4 lo = trrd(vimg + vrd + d0 * 2048 + ks * 1024), hh = trrd(vimg + vrd + d0 * 2048 + ks * 1024 + 512);
                    const bf16x8 vb = (bf16x8){lo[0], lo[1], lo[2], lo[3], hh[0], hh[1], hh[2], hh[3]};
                    o[d0] = __builtin_amdgcn_mfma_f32_32x32x16_bf16(pa, vb, o[d0], 0, 0, 0);
                }
            }
        }
        if (hi == 0) wsf[r32] = lsum;
#pragma unroll
        for (int rr = 0; rr < 16; ++rr) {
            const int orow = (rr & 3) + 8 * (rr >> 2) + 4 * hi; const float rl = __builtin_amdgcn_rcpf(wsf[orow]);
#pragma unroll
            for (int d0 = 0; d0 < 2; ++d0) stg[orow * 64 + d0 * 32 + r32] = (bf16)f2bf(o[d0][rr] * rl);
        }
#pragma unroll
        for (int i = 0; i < 4; ++i) { const int row = i * 8 + (lane >> 3), ch = lane & 7; const v4u v = *(const LAS v4u*)(stg + row * 64 + ch * 8);
            *(v4u*)(Og + (size_t)(r + dil * (tq0 + row)) * 512 + ch * 8) = v; }
        if (hi == 0) Lg[(size_t)(r + dil * (tq0 + r32)) * 8] = mx + __builtin_amdgcn_logf(lsum);
    }
}

#define XB_TMO      128
#define XB_XCNT(j)  (256  + 64 * (j))
#define XB_XSUB(j)  (1280 + 64 * (j))
#define XB_XGEN(j)  (2304 + 64 * (j))
#define XB_TOP      3328
#define XB_TOPGEN   3392
#define XCD_BAR_WORDS 3456
#define XB_SPIN_CAP (1u << 18)

__device__ __forceinline__ unsigned xb_ld(unsigned* p)              { return __hip_atomic_load(p, __ATOMIC_RELAXED, __HIP_MEMORY_SCOPE_AGENT); }
__device__ __forceinline__ unsigned xb_add(unsigned* p, unsigned v) { return __hip_atomic_fetch_add(p, v, __ATOMIC_RELAXED, __HIP_MEMORY_SCOPE_AGENT); }
__device__ __forceinline__ unsigned xb_xcc_id() { return (unsigned)__builtin_amdgcn_s_getreg((3 << 11) | 20) & 0xFu; }
#define XB_SPIN(cond, bar) do { unsigned _sp = 0; while (cond) { __builtin_amdgcn_s_sleep(1); \
    if ((++_sp & 255u) == 0u) { if (xb_ld(&(bar)[XB_TMO])) break; if (_sp > XB_SPIN_CAP) { atomicAdd(&(bar)[XB_TMO], 1u); break; } } } } while (0)

struct XcdBarrier {
    unsigned* bar; unsigned x;
    volatile LAS unsigned* st;
};

__device__ __forceinline__ XcdBarrier xcd_barrier_post(unsigned* bar, volatile LAS unsigned* st) {
    XcdBarrier b; b.bar = bar; b.x = xb_xcc_id(); b.st = st;
    if (threadIdx.x == 0) (void)xb_add(&bar[XB_XCNT(b.x)], 1u);
    return b;
}
__device__ __forceinline__ void xcd_barrier_complete(unsigned* bar, unsigned x, unsigned& nloc, unsigned& nx) {
    const unsigned G = gridDim.x * gridDim.y * gridDim.z;
    unsigned sum, cnt, mine, sp = 0u;
    for (;;) {
        sum = 0u; cnt = 0u; mine = 0u;
#pragma unroll
        for (unsigned j = 0; j < 16; ++j) { const unsigned c = xb_ld(&bar[XB_XCNT(j)]); sum += c; cnt += (c > 0u) ? 1u : 0u; mine = (j == x) ? c : mine; }
        if (sum == G) break;
        __builtin_amdgcn_s_sleep(1);
        if ((++sp & 255u) == 0u) { if (xb_ld(&bar[XB_TMO])) break; if (sp > XB_SPIN_CAP) { atomicAdd(&bar[XB_TMO], 1u); break; } }
    }
    nloc = mine > 0u ? mine : 1u; nx = cnt > 0u ? cnt : 1u;
}

__device__ __forceinline__ void xcd_barrier(const XcdBarrier& b) {
    asm volatile("s_waitcnt vmcnt(0)" ::: "memory");
    __syncthreads();
    if (threadIdx.x == 0) {
        unsigned* bar = b.bar;
        __builtin_amdgcn_s_waitcnt(0);
        unsigned nloc = b.st[0], nx = b.st[1];
        if (nloc == 0u) { xcd_barrier_complete(bar, b.x, nloc, nx); b.st[0] = nloc; b.st[1] = nx; }
        const unsigned old = xb_add(&bar[XB_XSUB(b.x)], 1u);
        const unsigned gen = old / nloc;
        if (old + 1u == (gen + 1u) * nloc) {
            __builtin_amdgcn_fence(__ATOMIC_RELEASE, "agent");
            asm volatile("s_waitcnt vmcnt(0)" ::: "memory");
            const unsigned og = xb_add(&bar[XB_TOP], 1u);
            const unsigned tg = og / nx;
            if (og + 1u == (tg + 1u) * nx) xb_add(&bar[XB_TOPGEN], 1u);
            else XB_SPIN(xb_ld(&bar[XB_TOPGEN]) == tg, bar);
            __builtin_amdgcn_fence(__ATOMIC_ACQUIRE, "agent");
            xb_add(&bar[XB_XGEN(b.x)], 1u);
            asm volatile("s_waitcnt vmcnt(0)" ::: "memory");
        } else {
            XB_SPIN(xb_ld(&bar[XB_XGEN(b.x)]) == gen, bar);
            __builtin_amdgcn_fence(__ATOMIC_ACQUIRE, "agent");
            asm volatile("s_waitcnt vmcnt(0)" ::: "memory");
        }
    }
    __syncthreads();
}

#ifndef PROBE_DIL
#define PROBE_DIL 1
#endif
#ifndef PROBE_ATT
#define PROBE_ATT 1
#endif
#ifndef PROBE_ROWS
#define PROBE_ROWS 1
#endif
#ifndef PROBE_SYNC
#define PROBE_SYNC 1
#endif
#define GSYNC() do { for (int s_ = 0; s_ < PROBE_SYNC; ++s_) xcd_barrier(bar); } while (0)
__global__ void __launch_bounds__(NWAVES * 64, 2) fwd_megakernel(Args a) {
    extern __shared__ __attribute__((aligned(16))) unsigned char lds_raw[];
    cg::grid_group grid = cg::this_grid();
    LAS unsigned char* lds = (LAS unsigned char*)lds_raw;
    const int tid = threadIdx.x, lane = tid & 63, wave = __builtin_amdgcn_readfirstlane(tid >> 6);
    const int G = gridDim.x, bx = blockIdx.x;
    const int vcu = (G % 8 == 0) ? (bx % 8) * (G / 8) + bx / 8 : bx;
    const int gw = vcu * NWAVES + wave, NGW = G * NWAVES;

#ifndef NO_P0
    volatile LAS unsigned* MISC = (volatile LAS unsigned*)(lds + 131072 + 320);
    if (tid < 32) MISC[tid] = 0u;
    __syncthreads();
    XcdBarrier bar = xcd_barrier_post((unsigned*)argp()->ws, MISC + 8);
    p0_prologue(lds, tid, lane, wave, vcu, G);
#endif
    grid.sync();

    const int lane0 = lane;
    for (int c = 0; c < NCHUNK; ++c) {
        int lane = lane0; asm volatile("" : "+v"(lane));
        const int S = (c < 2) ? S_P : S_S, nseq = CT / S, b0 = (c < 2) ? c * 8 : 16;
#define FETCH() CArgs ap = argp(); unsigned char* ws = ap->ws; const float* mod = (const float*)(ws + WS_MOD); (void)mod
#define XC() ((c < 2) ? ap->x_prompt + (size_t)c * CT * 1024 : ap->x_sample)
#define OUTC() (ap->out + (size_t)c * CT * 1024)
        for (int rep_ = 0; rep_ < PROBE_ROWS; ++rep_) { FETCH(); rows_norm_mod(XC(), (bf16*)(ws + WS_H), ap->g_mix, mod, 0, 1, S, b0, gw, NGW, lane); }
        GSYNC();
        {   FETCH();
            pg8::Gemm g{(const pg8::bf16_t*)(ws + WS_H), (const pg8::bf16_t*)(ws + WS_WIN), CT, NIN, 1024}; pg8::StaticOrder So; So.init(CT, NIN, G, bx);
            EpiIn E{ws, S};
#ifndef NO_GIN
            pg8::gemm_phase<EpiIn, pg8::StaticOrder, PG8_ALIGN, PG8_SP2>(lds, g, So, E);
#endif
        }
        GSYNC();
        {   FETCH();
            const int NQB = S / 256, NT = S / 64, nunits = nseq * 32 * NQB;
            for (int rep_ = 0; rep_ < PROBE_ATT; ++rep_)
            for (int id = vcu; id < nunits; id += G) {
                const int qb = id % NQB; int t = id / NQB; const int combo = t & 3; t >>= 2; const int h8 = t & 7, seq = t >> 3;
                const int cmap = combo >> 1, vh = combo & 1;
                const size_t rb = (size_t)seq * S * 1024;
                const attn_body::bf16* Qp = (const attn_body::bf16*)(ws + WS_QA) + rb + (h8 * 2 + cmap) * 64;
                const attn_body::bf16* Kp = (const attn_body::bf16*)(ws + WS_KA) + rb + (h8 * 2 + cmap) * 64;
                const attn_body::bf16* Vp = (const attn_body::bf16*)(ws + WS_VA) + rb + (h8 * 2 + vh) * 64;
                attn_body::bf16* Op = (attn_body::bf16*)(ws + (cmap ? WS_O2 : WS_O1)) + rb + (h8 * 2 + vh) * 64;
#ifndef NO_ATT
                attn_body::attn_unit<8>(Qp, Kp, Vp, Op, qb * 256, NT, (char*)lds_raw);
#endif
            }
            __syncthreads();
            const int nb64 = S / 64, ndu = 3 * nseq * nb64;
            for (int rep_ = 0; rep_ < PROBE_DIL; ++rep_)
            for (int id = vcu; id < ndu; id += G) {
                const int rn = id % nb64; int t = id / nb64; const int seq = t % nseq, g = t / nseq;
                const int dil = (g == 0) ? 1 : (g == 1 ? 4 : 16), T = S / dil, nb = T / 64, r = rn / nb, n = rn % nb;
                const size_t rb = (size_t)seq * S * 512 + wave * 64;
                const bf16* Qg = (const bf16*)(ws + WS_G0 + (size_t)(g * 3 + 0) * 32 * MiB) + rb;
                const bf16* Kg = (const bf16*)(ws + WS_G0 + (size_t)(g * 3 + 1) * 32 * MiB) + rb;
                const bf16* Vg = (const bf16*)(ws + WS_G0 + (size_t)(g * 3 + 2) * 32 * MiB) + rb;
                bf16* Og = (bf16*)(ws + WS_OG + (size_t)g * 32 * MiB) + rb;
                float* Lg = (float*)(ws + WS_LSE) + ((size_t)g * CT + (size_t)seq * S) * 8 + wave;
#ifndef NO_DIL
                dil_unit(Qg, Kg, Vg, Og, Lg, r, n, dil, T, lds + wave * 8704, lane);
#endif
            }
        }
        GSYNC();
#ifndef NO_COMB
        for (int rep_ = 0; rep_ < PROBE_ROWS; ++rep_) rows_combine(gw, NGW, lane);
#endif
        GSYNC();
        {   FETCH();
            pg8::StaticOrder So; So.init(CT, 1024, G, bx);
            pg8::Gemm ga{(const pg8::bf16_t*)(ws + WS_OA), (const pg8::bf16_t*)(ws + WS_WA), CT, 1024, 1024};
            EpiGate Ea{(const bf16*)(ws + WS_G1), (bf16*)(ws + WS_MRG), 0};
#ifndef NO_GG
            pg8::gemm_phase<EpiGate, pg8::StaticOrder, PG8_ALIGN, PG8_SP2>(lds, ga, So, Ea);
#endif
            pg8::Gemm gb{(const pg8::bf16_t*)(ws + WS_OB), (const pg8::bf16_t*)(ws + WS_WB), CT, 1024, 512};
            EpiGate Eb{(const bf16*)(ws + WS_G2), (bf16*)(ws + WS_MRG), 1};
#ifndef NO_GG
            pg8::gemm_phase<EpiGate, pg8::StaticOrder, PG8_ALIGN, PG8_SP2>(lds, gb, So, Eb);
#endif
        }
        GSYNC();
        {   FETCH();
            pg8::StaticOrder So; So.init(CT, 1024, G, bx);
            pg8::Gemm g{(const pg8::bf16_t*)(ws + WS_MRG), (const pg8::bf16_t*)(ws + WS_WOUT), CT, 1024, 1024};
            EpiRes E{XC(), OUTC(), mod, 2, S, b0};
#ifndef NO_GR
            pg8::gemm_phase<EpiRes, pg8::StaticOrder, PG8_ALIGN, PG8_SP2>(lds, g, So, E);
#endif
        }
        GSYNC();
        for (int rep_ = 0; rep_ < PROBE_ROWS; ++rep_) { FETCH(); rows_norm_mod(OUTC(), (bf16*)(ws + WS_H), ap->g_ffn, mod, 3, 4, S, b0, gw, NGW, lane); }
        GSYNC();
        {   FETCH();
            pg8::StaticOrder So; So.init(CT, 2 * FFH, G, bx);
            pg8::Gemm g{(const pg8::bf16_t*)(ws + WS_H), (const pg8::bf16_t*)(ws + WS_WGU), CT, 2 * FFH, 1024};
            EpiGU E{(bf16*)(ws + WS_ACT)};
#ifndef NO_GU
            pg8::gemm_phase<EpiGU, pg8::StaticOrder, PG8_ALIGN, PG8_SP2>(lds, g, So, E);
#endif
        }
        GSYNC();
        {   FETCH();
            pg8::StaticOrder So; So.init(CT, 1024, G, bx);
            pg8::Gemm g{(const pg8::bf16_t*)(ws + WS_ACT), (const pg8::bf16_t*)(ws + WS_WDN), CT, 1024, FFH};
            float* oc_ = OUTC(); EpiRes E{oc_, oc_, mod, 5, S, b0};
#ifndef NO_GR
            pg8::gemm_phase<EpiRes, pg8::StaticOrder, PG8_ALIGN, PG8_SP2>(lds, g, So, E);
#endif
        }
        GSYNC();
        { FETCH(); rows_final_norm(OUTC(), ap->g_final, gw, NGW, lane); }
    }
}

extern "C" void kernel_launch(void* const* d_in, const int* in_sizes, int n_in, void* d_out, int out_size, void* d_ws, size_t ws_size, hipStream_t stream) {
    static int grid = 0;
    if (grid == 0) {
        if (n_in != 20 || ws_size < WS_END) { fprintf(stderr, "kernel_launch: unexpected n_in %d / ws_size %zu (need %zu)\n", n_in, ws_size, (size_t)WS_END); grid = -1; return; }
        int dev = 0, cus = 0, per_cu = 0;
        hipGetDevice(&dev); hipDeviceGetAttribute(&cus, hipDeviceAttributeMultiprocessorCount, dev);
        if (hipFuncSetAttribute((const void*)fwd_megakernel, hipFuncAttributeMaxDynamicSharedMemorySize, LDS_BYTES) != hipSuccess) { fprintf(stderr, "kernel_launch: hipFuncSetAttribute failed\n"); grid = -1; return; }
        if (hipOccupancyMaxActiveBlocksPerMultiprocessor(&per_cu, (const void*)fwd_megakernel, NWAVES * 64, LDS_BYTES) != hipSuccess || per_cu < 1) { fprintf(stderr, "kernel_launch: occupancy query says %d\n", per_cu); per_cu = 1; }
        (void)hipGetLastError();
        grid = cus * 1;
        fprintf(stderr, "kernel_launch: grid %d (cus %d, per_cu %d)\n", grid, cus, per_cu);
    }
    if (grid < 0) return;
    Args a{};
    a.x_prompt = (const float*)d_in[0]; a.x_sample = (const float*)d_in[1]; a.c_prompt = (const float*)d_in[2]; a.c_sample = (const float*)d_in[3];
    a.w_ada = (const float*)d_in[4]; a.b_ada = (const float*)d_in[5]; a.g_mix = (const float*)d_in[6]; a.w_in = (const float*)d_in[7];
    a.lq1 = (const float*)d_in[8]; a.lk1 = (const float*)d_in[9]; a.lq2 = (const float*)d_in[10]; a.lk2 = (const float*)d_in[11]; a.g_subln = (const float*)d_in[12];
    a.w_a = (const float*)d_in[13]; a.w_b = (const float*)d_in[14]; a.w_out = (const float*)d_in[15]; a.g_ffn = (const float*)d_in[16]; a.w_gu = (const float*)d_in[17];
    a.w_down = (const float*)d_in[18]; a.g_final = (const float*)d_in[19];
    a.out = (float*)d_out; a.ws = (unsigned char*)d_ws;
    if (hipMemsetAsync(d_ws, 0, 16384, stream) != hipSuccess) { fprintf(stderr, "kernel_launch: memset failed\n"); return; }
    void* args[] = {&a};
    hipError_t e = hipLaunchCooperativeKernel((const void*)fwd_megakernel, dim3(grid), dim3(NWAVES * 64), args, LDS_BYTES, stream);
    if (e != hipSuccess) fprintf(stderr, "kernel_launch: cooperative launch failed: %s (grid %d)\n", hipGetErrorString(e), grid);
}
```

```cpp
#include <hip/hip_runtime.h>
#include <hip/hip_bf16.h>
#include <hip/hip_cooperative_groups.h>
#include <cstdio>
#include <cstdint>
namespace cg = cooperative_groups;
namespace pg8 {
#define PG8_LAS __attribute__((address_space(3)))
typedef unsigned short bf16_t;
typedef short bf16x8 __attribute__((ext_vector_type(8)));
typedef float f32x4 __attribute__((ext_vector_type(4)));
typedef unsigned u32x4 __attribute__((ext_vector_type(4)));
constexpr int BM = 256, BK = 64, HALF = 128, HTB = HALF * BK * 2  , STAGE_BYTES = 8 * HTB, NXCD = 8, WGM = 8;

__host__ __device__ __forceinline__ int lds_byte(int r, int c) { const int st = (r >> 4) * 2 + (c >> 5), rr = r & 15, cc = c & 31, ob = rr * 64 + cc * 2; return st * 1024 + (ob ^ (((ob >> 9) & 1) << 5)); }
__host__ __device__ __forceinline__ void stage_rc(int b, int& R, int& C) { const int st = b / 1024, sb = b % 1024, swz = sb ^ (((sb >> 9) & 1) << 5); R = (st >> 1) * 16 + swz / 64; C = (st & 1) * 32 + (swz % 64) / 2; }
__host__ __device__ __forceinline__ int perm32(int rho) { const int n = rho >> 4, i = rho & 15; return 8 * (i >> 2) + 4 * n + (i & 3); }

struct Unit { int pm, pn; };
struct Gemm { const bf16_t* A; const bf16_t* Bt; int M, N, K; };

struct StaticOrder {
    int nM, nN, nwg, G, c;
    __host__ __device__ void init(int M, int N, int G_, int c_) { nM = M / BM; nN = N / BM; nwg = nM * nN; G = G_; c = c_; }
    __host__ __device__ bool next(int i, Unit& u) const {
        const long L = (long)i * G + c; if (L >= nwg) return false;
        int wgid = (int)L; { const int q = nwg / NXCD, r = nwg % NXCD, xcd = wgid % NXCD, off = wgid / NXCD; wgid = (xcd < r ? xcd * (q + 1) : r * (q + 1) + (xcd - r) * q) + off; }
        const int nig = WGM * nN, gid = wgid / nig, fm = gid * WGM, gsz = (nM - fm) < WGM ? (nM - fm) : WGM;
        u.pm = fm + ((wgid % nig) % gsz); u.pn = (wgid % nig) / gsz; return true;
    }
    __device__ __forceinline__ void a_ready(const Unit&) const {}
    __device__ __forceinline__ void done(const Unit&) const {}
};

__device__ __forceinline__ unsigned cvt_pk_bf16(float lo, float hi) { unsigned r; asm volatile("v_cvt_pk_bf16_f32 %0, %1, %2" : "=v"(r) : "v"(lo), "v"(hi)); return r; }
typedef float f32x2 __attribute__((ext_vector_type(2)));
template <class Epi, class Sched, bool ALIGN_EPI = false, bool SP2 = false>
__device__ __forceinline__ void gemm_phase(PG8_LAS unsigned char* lds, const Gemm g, const Sched& S, const Epi& E) {
    int tid_ = threadIdx.x; asm volatile("" : "+v"(tid_));
    const int tid = tid_, wid = __builtin_amdgcn_readfirstlane(tid >> 6), lane = tid & 63, wr = wid >> 2, wc = wid & 3, fr = lane & 15, fq = lane >> 4;
    const int K = g.K, nt = K / BK;
    unsigned voffA[2], voffB[2];
#pragma unroll
    for (int i = 0; i < 2; ++i) { int R, C; stage_rc(tid * 16 + i * 8192, R, C); const int Rb = Epi::PERM ? ((R & ~31) + perm32(R & 31)) : R;
        voffA[i] = (unsigned)(R * K + C) * 2u; voffB[i] = (unsigned)(Rb * K + C) * 2u; }
    const size_t kstep = (size_t)(BK * 2);
    const size_t hstep = (size_t)HALF * K * 2;
    const size_t tstep = 2 * hstep;
    const unsigned ldsw = (unsigned)wid * 1024u;
    const int aoff = lds_byte(wr * 64 + fr, fq * 8), boff = lds_byte(wc * 32 + fr, fq * 8);
#define PG8_SA(b, h) (((b) * 2 + (h)) * HTB)
#define PG8_SB(b, h) ((4 + (b) * 2 + (h)) * HTB)
#define PG8_STAGE(bufoff, gbase, voff) do { _Pragma("unroll") for (int _i = 0; _i < 2; ++_i) \
        __builtin_amdgcn_global_load_lds((const unsigned*)((const char*)(gbase) + (voff)[_i]), (PG8_LAS unsigned*)(lds + (bufoff) + ldsw + _i * 8192), 16, 0, 0); } while (0)
#define PG8_LDA(dst, b, h) do { _Pragma("unroll") for (int m = 0; m < 4; ++m) _Pragma("unroll") for (int k = 0; k < 2; ++k) dst[m][k] = *(const PG8_LAS bf16x8*)(lds + PG8_SA(b, h) + aoff + m * 2048 + k * 1024); } while (0)
#define PG8_LDB(dst, b, h) do { _Pragma("unroll") for (int n = 0; n < 2; ++n) _Pragma("unroll") for (int k = 0; k < 2; ++k) dst[n][k] = *(const PG8_LAS bf16x8*)(lds + PG8_SB(b, h) + boff + n * 2048 + k * 1024); } while (0)
#define PG8_MMA(ai, bj, At, Bt) do { __builtin_amdgcn_s_setprio(1); _Pragma("unroll") for (int m = 0; m < 4; ++m) _Pragma("unroll") for (int n = 0; n < 2; ++n) _Pragma("unroll") for (int k = 0; k < 2; ++k) \
        acc[ai][bj][m][n] = __builtin_amdgcn_mfma_f32_16x16x32_bf16(Bt[n][k], At[m][k], acc[ai][bj][m][n], 0, 0, 0); __builtin_amdgcn_s_setprio(0); } while (0)
#define PG8_WAIT_V(n) asm volatile("s_waitcnt vmcnt(" #n ")" ::: "memory")
#define PG8_WAIT_L(n) asm volatile("s_waitcnt lgkmcnt(" #n ")" ::: "memory")
#define PG8_BAR __builtin_amdgcn_s_barrier()
#define PG8_SCHED __builtin_amdgcn_sched_barrier(0)
    Unit cur, nxt; int ui = 0;
    if (!S.next(0, cur)) return;
    f32x4 acc[2][2][4][2];
#pragma unroll
    for (int a = 0; a < 2; ++a)
#pragma unroll
        for (int b = 0; b < 2; ++b)
#pragma unroll
            for (int m = 0; m < 4; ++m)
#pragma unroll
                for (int n = 0; n < 2; ++n) acc[a][b][m][n] = (f32x4){0.f, 0.f, 0.f, 0.f};
    bf16x8 At[4][2], B0[2][2], B1[2][2];
    const char* cA = (const char*)g.A + (size_t)cur.pm * tstep; const char* cB = (const char*)g.Bt + (size_t)cur.pn * tstep;
    S.a_ready(cur);
    if constexpr (SP2) {
        PG8_STAGE(PG8_SB(0, 0), cB, voffB); PG8_STAGE(PG8_SB(0, 1), cB + hstep, voffB); PG8_STAGE(PG8_SA(0, 0), cA, voffA); PG8_STAGE(PG8_SA(0, 1), cA + hstep, voffA);
        if (wr == 1) PG8_BAR;
        PG8_WAIT_V(2); PG8_BAR;
        PG8_STAGE(PG8_SB(1, 0), cB + kstep, voffB); PG8_STAGE(PG8_SA(1, 0), cA + kstep, voffA); PG8_STAGE(PG8_SB(1, 1), cB + hstep + kstep, voffB);
        PG8_WAIT_V(6); PG8_BAR;
    } else {
        PG8_STAGE(PG8_SB(0, 0), cB, voffB); PG8_STAGE(PG8_SA(0, 0), cA, voffA); PG8_STAGE(PG8_SB(0, 1), cB + hstep, voffB); PG8_STAGE(PG8_SA(0, 1), cA + hstep, voffA);
        if (wr == 1) PG8_BAR;
        PG8_WAIT_V(4); PG8_BAR;
        PG8_STAGE(PG8_SB(1, 0), cB + kstep, voffB); PG8_STAGE(PG8_SA(1, 0), cA + kstep, voffA); PG8_STAGE(PG8_SB(1, 1), cB + hstep + kstep, voffB);
        PG8_WAIT_V(6); PG8_BAR;
    }
    for (;;) {
        const bool has_next = S.next(ui + 1, nxt);
        const char* nA = has_next ? (const char*)g.A + (size_t)nxt.pm * tstep : cA; const char* nB = has_next ? (const char*)g.Bt + (size_t)nxt.pn * tstep : cB;
        for (int t = 0; t < nt; t += 2) {
            const bool last = (t == nt - 2);
            const char* a1 = cA + (size_t)(t + 1) * kstep;
            const char* a2 = last ? nA : cA + (size_t)(t + 2) * kstep; const char* b2 = last ? nB : cB + (size_t)(t + 2) * kstep;
            const char* a3 = a2 + kstep; const char* b3 = b2 + kstep;
            if (last && has_next) S.a_ready(nxt);
            if constexpr (SP2) {
            PG8_LDB(B0, 0, 0); PG8_LDB(B1, 0, 1); PG8_SCHED; PG8_LDA(At, 0, 0); PG8_STAGE(PG8_SA(1, 1), a1 + hstep, voffA);
            PG8_WAIT_V(8); PG8_WAIT_L(0); PG8_BAR; PG8_MMA(0, 0, At, B0); PG8_MMA(0, 1, At, B1); PG8_BAR; PG8_SCHED;
            PG8_LDA(At, 0, 1); PG8_STAGE(PG8_SB(0, 0), b2, voffB); PG8_STAGE(PG8_SB(0, 1), b2 + hstep, voffB); PG8_STAGE(PG8_SA(0, 0), a2, voffA);
            PG8_WAIT_V(8); PG8_WAIT_L(0); PG8_BAR; PG8_MMA(1, 0, At, B0); PG8_MMA(1, 1, At, B1); PG8_BAR; PG8_SCHED;
            PG8_LDB(B0, 1, 0); PG8_LDB(B1, 1, 1); PG8_SCHED; PG8_LDA(At, 1, 0); PG8_STAGE(PG8_SA(0, 1), a2 + hstep, voffA);
            PG8_WAIT_V(8); PG8_WAIT_L(0); PG8_BAR; PG8_MMA(0, 0, At, B0); PG8_MMA(0, 1, At, B1); PG8_BAR; PG8_SCHED;
            PG8_LDA(At, 1, 1); PG8_STAGE(PG8_SB(1, 0), b3, voffB); PG8_STAGE(PG8_SB(1, 1), b3 + hstep, voffB); PG8_STAGE(PG8_SA(1, 0), a3, voffA);
            PG8_WAIT_V(8); PG8_WAIT_L(0); PG8_BAR; PG8_MMA(1, 0, At, B0); PG8_MMA(1, 1, At, B1); PG8_BAR; PG8_SCHED;
            } else {
            PG8_LDB(B0, 0, 0); PG8_SCHED; PG8_LDA(At, 0, 0); PG8_STAGE(PG8_SA(1, 1), a1 + hstep, voffA);
            PG8_WAIT_L(8); PG8_BAR; PG8_WAIT_L(0); PG8_MMA(0, 0, At, B0); PG8_BAR; PG8_SCHED;
            PG8_LDB(B1, 0, 1); PG8_STAGE(PG8_SB(0, 0), b2, voffB);
            PG8_BAR; PG8_WAIT_L(0); PG8_MMA(0, 1, At, B1); PG8_BAR;
            PG8_LDA(At, 0, 1); PG8_STAGE(PG8_SA(0, 0), a2, voffA);
            PG8_BAR; PG8_WAIT_L(0); PG8_MMA(1, 0, At, B0); PG8_BAR; PG8_SCHED;
            PG8_STAGE(PG8_SB(0, 1), b2 + hstep, voffB);
            PG8_WAIT_V(6); PG8_BAR; PG8_MMA(1, 1, At, B1); PG8_BAR;
            PG8_LDB(B0, 1, 0); PG8_SCHED; PG8_LDA(At, 1, 0); PG8_STAGE(PG8_SA(0, 1), a2 + hstep, voffA);
            PG8_WAIT_L(8); PG8_BAR; PG8_WAIT_L(0); PG8_MMA(0, 0, At, B0); PG8_BAR; PG8_SCHED;
            PG8_LDB(B1, 1, 1); PG8_STAGE(PG8_SB(1, 0), b3, voffB);
            PG8_BAR; PG8_WAIT_L(0); PG8_MMA(0, 1, At, B1); PG8_BAR;
            PG8_LDA(At, 1, 1); PG8_STAGE(PG8_SA(1, 0), a3, voffA);
            PG8_BAR; PG8_WAIT_L(0); PG8_MMA(1, 0, At, B0); PG8_BAR; PG8_SCHED;
            PG8_STAGE(PG8_SB(1, 1), b3 + hstep, voffB);
            PG8_WAIT_V(6); PG8_BAR; PG8_MMA(1, 1, At, B1); PG8_BAR;
            }
        }
        if constexpr (ALIGN_EPI) { if (wr == 0) PG8_BAR; }
        if constexpr (!Epi::AFTER_DRAIN) { E(acc, cur, wr, wc, fr, fq); S.done(cur); }
        if (!has_next) break;
#pragma unroll
        for (int a = 0; a < 2; ++a)
#pragma unroll
            for (int b = 0; b < 2; ++b)
#pragma unroll
                for (int m = 0; m < 4; ++m)
#pragma unroll
                    for (int n = 0; n < 2; ++n) acc[a][b][m][n] = (f32x4){0.f, 0.f, 0.f, 0.f};
        cur = nxt; cA = nA; cB = nB; ++ui;
        if constexpr (ALIGN_EPI) { if (wr == 1) PG8_BAR; }
    }
    PG8_WAIT_V(0);
    if constexpr (!ALIGN_EPI) { if (wr == 0) PG8_BAR; }
    PG8_BAR;
    if constexpr (Epi::AFTER_DRAIN) { E.fused(acc, cur, wr, wc, fr, fq, lds, wid, lane); S.done(cur); }
#undef PG8_SA
#undef PG8_SB
#undef PG8_STAGE
#undef PG8_LDA
#undef PG8_LDB
#undef PG8_MMA
#undef PG8_WAIT_V
#undef PG8_WAIT_L
#undef PG8_BAR
#undef PG8_SCHED
}
}
#ifndef PG8_SP2
#define PG8_SP2 true
#endif
#ifndef PG8_ALIGN
#define PG8_ALIGN true
#endif
#include <hip/hip_bf16.h>
#include <cmath>
namespace attn_body {
using bf16=__hip_bfloat16;
using bf16x8=__attribute__((ext_vector_type(8)))short;
using s16x4=__attribute__((ext_vector_type(4)))short;
using f32x16=__attribute__((ext_vector_type(16)))float;
using u32x4=__attribute__((ext_vector_type(4)))unsigned;
constexpr int D=64,DM=1024;
constexpr int NW=8,QBLK=32,QB=QBLK*NW,KVBLK=64;
__device__ __forceinline__ int crow(int r,int hi){return (r&3)+8*(r>>2)+4*hi;}
#define SBAR() __builtin_amdgcn_sched_barrier(0)
constexpr int NSLOT=3, SLOTB=8192;
constexpr int LDS_K=0, LDS_V=NSLOT*SLOTB, LDS_WS=3*NSLOT*SLOTB, LDS_OST=LDS_WS+NW*64*4, LDS_BYTES=LDS_OST+NW*8192;
constexpr float C2=0.125f*1.4426950408889634f;
__device__ __forceinline__ void glds16(const void*gsrc,unsigned lds_dst){unsigned keep;
  asm volatile("s_mov_b32 %0, m0\n\ts_mov_b32 m0, %2\n\ts_nop 0\n\tglobal_load_lds_dwordx4 %1, off\n\ts_mov_b32 m0, %0":"=&s"(keep):"v"(gsrc),"s"(lds_dst):"memory");}
__device__ __forceinline__ float max3f(float a,float b,float c){float r;asm("v_max3_f32 %0, %1, %2, %3":"=v"(r):"v"(a),"v"(b),"v"(c));return r;}
__device__ __forceinline__ float max2f(float a,float b){float r;asm("v_max_f32_e32 %0, %1, %2":"=v"(r):"v"(a),"v"(b));return r;}
__device__ __forceinline__ float fadd_s(float a,float b){float r;asm("v_add_f32_e32 %0, %1, %2":"=v"(r):"v"(a),"v"(b));return r;}
__device__ __forceinline__ float fsub_s(float a,float b){float r;asm("v_sub_f32_e32 %0, %1, %2":"=v"(r):"v"(a),"v"(b));return r;}
typedef float f32x2_t __attribute__((ext_vector_type(2))); typedef __bf16 bf16x2_t __attribute__((ext_vector_type(2)));
__device__ __forceinline__ unsigned cvtpk_s(float lo,float hi){f32x2_t v={lo,hi};bf16x2_t b=__builtin_convertvector(v,bf16x2_t);return __builtin_bit_cast(unsigned,b);}
#define WAIT_BAR(N) asm volatile("s_waitcnt vmcnt(" #N ") lgkmcnt(0)\n\ts_barrier":::"memory")

__device__ __forceinline__ void qkt(f32x16&p0,f32x16&p1,const char*Kslot,const bf16x8*qr,int r32,int hi){ const f32x16 negm=f32x16{};
  const char*kb=Kslot+hi*1024+r32*16;
  #pragma unroll
  for(int d0=0;d0<4;++d0){
    const bf16x8 b0=*reinterpret_cast<const bf16x8*>(kb+d0*2048);
    const bf16x8 b1=*reinterpret_cast<const bf16x8*>(kb+d0*2048+512);
    if(d0==0){p0=__builtin_amdgcn_mfma_f32_32x32x16_bf16(b0,qr[0],negm,0,0,0);p1=__builtin_amdgcn_mfma_f32_32x32x16_bf16(b1,qr[0],negm,0,0,0);}
    else{p0=__builtin_amdgcn_mfma_f32_32x32x16_bf16(b0,qr[d0],p0,0,0,0);p1=__builtin_amdgcn_mfma_f32_32x32x16_bf16(b1,qr[d0],p1,0,0,0);}}
}
typedef __attribute__((address_space(3))) const char* lds_cptr;
typedef short v4i16_t __attribute__((ext_vector_type(4)));
__device__ __forceinline__ void kload8(bf16x8*kf,lds_cptr kp){
  kf[0]=*(const __attribute__((address_space(3))) bf16x8*)(kp);      kf[1]=*(const __attribute__((address_space(3))) bf16x8*)(kp+512);
  kf[2]=*(const __attribute__((address_space(3))) bf16x8*)(kp+2048); kf[3]=*(const __attribute__((address_space(3))) bf16x8*)(kp+2560);
  kf[4]=*(const __attribute__((address_space(3))) bf16x8*)(kp+4096); kf[5]=*(const __attribute__((address_space(3))) bf16x8*)(kp+4608);
  kf[6]=*(const __attribute__((address_space(3))) bf16x8*)(kp+6144); kf[7]=*(const __attribute__((address_space(3))) bf16x8*)(kp+6656);
}
__device__ __forceinline__ void kload2(bf16x8*kf,lds_cptr kp,int j){ kf[2*j]=*(const __attribute__((address_space(3))) bf16x8*)(kp+j*2048); kf[2*j+1]=*(const __attribute__((address_space(3))) bf16x8*)(kp+j*2048+512); }
__device__ __forceinline__ s16x4 vtr(lds_cptr p){ return __builtin_bit_cast(s16x4,__builtin_amdgcn_ds_read_tr16_b64_v4i16((__attribute__((address_space(3))) v4i16_t*)p)); }
__device__ __forceinline__ float rowmax(const f32x16&p0,const f32x16&p1){
  float a=max3f(p0[0],p0[1],p1[0]),b=max3f(p0[2],p0[3],p1[1]);a=max3f(a,p1[2],p1[3]);
  #pragma unroll
  for(int r=4;r<16;r+=4){a=max3f(a,p0[r],p0[r+1]);b=max3f(b,p0[r+2],p0[r+3]);a=max3f(a,p1[r],p1[r+1]);b=max3f(b,p1[r+2],p1[r+3]);}
  const float m=max2f(a,b);
  auto rr=__builtin_amdgcn_permlane32_swap(__float_as_uint(m),__float_as_uint(m),false,false);
  return max2f(__uint_as_float(rr[0]),__uint_as_float(rr[1]));
}
__device__ __forceinline__ void pv(f32x16*o,int vb,bf16x8 pa0,bf16x8 pa1,bf16x8 pa2,bf16x8 pa3){
  #pragma unroll
  for(int d0=0;d0<4;++d0){s16x4 lo[4],hi[4];
    #pragma unroll
    for(int ks=0;ks<4;++ks){
      asm volatile("ds_read_b64_tr_b16 %0,%1 offset:%c2":"=&v"(lo[ks]):"v"(vb),"i"(d0*4096+ks*1024):"memory");
      asm volatile("ds_read_b64_tr_b16 %0,%1 offset:%c2":"=&v"(hi[ks]):"v"(vb),"i"(d0*4096+ks*1024+512):"memory");}
    asm volatile("s_waitcnt lgkmcnt(0)":::"memory");SBAR();
    #define PK(k) (bf16x8){lo[k][0],lo[k][1],lo[k][2],lo[k][3],hi[k][0],hi[k][1],hi[k][2],hi[k][3]}
    o[d0]=__builtin_amdgcn_mfma_f32_32x32x16_bf16(pa0,PK(0),o[d0],0,0,0);
    o[d0]=__builtin_amdgcn_mfma_f32_32x32x16_bf16(pa1,PK(1),o[d0],0,0,0);
    o[d0]=__builtin_amdgcn_mfma_f32_32x32x16_bf16(pa2,PK(2),o[d0],0,0,0);
    o[d0]=__builtin_amdgcn_mfma_f32_32x32x16_bf16(pa3,PK(3),o[d0],0,0,0);
    #undef PK
  }
}

#ifndef ATTN_STORE16
#define ATTN_STORE16(p,v) (*(u32x4*)(p)=(v))
#endif
template<int THRL> __device__ __forceinline__ void attn_unit(const bf16*Qp,const bf16*__restrict__ Kh,const bf16*__restrict__ Vh,bf16*Op,const int q0,const int NT,char*shm){
  int tid_=threadIdx.x; asm volatile("":"+v"(tid_));
  const int tid=tid_,lane=tid&63,r32=lane&31,hi=lane>>5; const int wid=__builtin_amdgcn_readfirstlane(tid>>6);
  const bf16*Qw=Qp+(long)(q0+wid*QBLK)*DM;
  const unsigned lds0=(unsigned)(uintptr_t)shm;
  float*wsf=(float*)(shm+LDS_WS)+wid*64;
  const bf16*ksrc=Kh+(long)lane*DM+wid*8;
  const bf16*vsrc=Vh+(long)(16*(wid&3)+(lane>>2))*DM+(wid>>2)*32+(lane&3)*8;
  const unsigned kdst=lds0+LDS_K+wid*1024, vdst=lds0+LDS_V+wid*1024;
  #define DMA_K(t,slot) glds16(ksrc+(long)(t)*KVBLK*DM,(unsigned)__builtin_amdgcn_readfirstlane(kdst+(slot)))
  #define DMA_V(t,slot) do{ glds16(vsrc+(long)(t)*KVBLK*DM,(unsigned)__builtin_amdgcn_readfirstlane(vdst+2*(slot))); glds16(vsrc+(long)(t)*KVBLK*DM+64,(unsigned)__builtin_amdgcn_readfirstlane(vdst+2*(slot)+8192)); }while(0)
  const int vb0=(int)(lds0+LDS_V)+((lane>>4)&1)*32+(lane&3)*8+(4*hi+((lane&15)>>2))*64;
  const char*Kbase=shm+LDS_K; bf16x8 kf[8];
  const lds_cptr shm3=(lds_cptr)shm; const lds_cptr kp0=shm3+LDS_K+hi*1024+r32*16; const lds_cptr vp0=shm3+LDS_V+((lane>>4)&1)*32+(lane&3)*8+(4*hi+((lane&15)>>2))*64;
  DMA_K(0,0);DMA_V(0,0);DMA_K(1,SLOTB);
  bf16x8 qr[4];
  #pragma unroll
  for(int d0=0;d0<4;++d0)qr[d0]=*reinterpret_cast<const bf16x8*>(&Qw[(long)r32*DM+d0*16+hi*8]);
  float mhat=0.f,l_reg=0.f;f32x16 o[4];o[0]=f32x16{};o[1]=f32x16{};o[2]=f32x16{};o[3]=f32x16{};
  #define CMASK(P0,P1,t) do{}while(0)
  bool resc=false;
  #define START(P0,P1) do{ const float rm=rowmax(P0,P1); resc=false; \
    { const float dl=rm; mhat=fadd_s(mhat,dl); \
      _Pragma("unroll") for(int r=0;r<16;++r){P0[r]=fsub_s(P0[r],dl);P1[r]=fsub_s(P1[r],dl);} } \
    _Pragma("unroll") for(int r=0;r<16;++r)P0[r]=__builtin_amdgcn_exp2f(P0[r]); }while(0)
  #define RESC() do{ if(resc){ asm volatile("s_waitcnt lgkmcnt(0)":::"memory"); \
      _Pragma("unroll") for(int d_=0;d_<4;++d_) _Pragma("unroll") for(int r=0;r<16;++r)o[d_][r]*=wsf[crow(r,hi)]; } }while(0)
  f32x16 pA0,pA1,pB0,pB1;
  int sl_prev=0,sl_cur=0,sl_next=SLOTB;
  #define ROT() do{sl_prev=sl_cur;sl_cur=sl_next;sl_next=(sl_next==(NSLOT-1)*SLOTB)?0:sl_next+SLOTB;}while(0)
  DMA_K(2,2*SLOTB);
  WAIT_BAR(4);
  qkt(pA0,pA1,Kbase,qr,r32,hi);asm volatile("s_nop 15\n\ts_nop 7":"+v"(pA0),"+v"(pA1));CMASK(pA0,pA1,0);
  START(pA0,pA1);
  _Pragma("unroll") for(int r=0;r<16;++r)pA1[r]=__builtin_amdgcn_exp2f(pA1[r]);
  WAIT_BAR(0);
  DMA_K(3,0);DMA_V(1,SLOTB);
  ROT();
  kload8(kf,kp0+sl_cur);
  WAIT_BAR(3);
  s16x4 vlo[8],vhi[8]; u32x4 pw0,pw1,pw2,pw3;
  #define PKW(P,B) cvtpk_s(P[B],P[B+1])
  #define PAF(k) __builtin_bit_cast(bf16x8,pw##k)
  #define VFR(i) (bf16x8){vlo[i][0],vlo[i][1],vlo[i][2],vlo[i][3],vhi[i][0],vhi[i][1],vhi[i][2],vhi[i][3]}
  #define PIN(x) asm volatile("":"+v"(x))
  #define MX3(a,b,c) __builtin_fmaxf(__builtin_fmaxf((a),(b)),(c))
  #define GAPA(MF,A0,A1,A2,A3,W0,W1,PW) do{ MF; sacc+=A0; sacc+=A1; sacc+=A2; sacc+=A3; PIN(sacc); W0; W1; PIN(PW); SBAR(); }while(0)
  #define EX(v) __builtin_amdgcn_exp2f(v)
  #define GAPB(MF,X,B) do{ MF; X[B]=EX(X[B]-mhat); X[B+1]=EX(X[B+1]-mhat); PIN(X); SBAR(); }while(0)
  #define VRD2(i) do{ vlo[i]=vtr(vp_+(8192+((i)>>2)*4096+((i)&3)*1024)); vhi[i]=vtr(vp_+(8192+((i)>>2)*4096+((i)&3)*1024+512)); SBAR(); }while(0)
  #define VRD(i) do{ vlo[i]=vtr(vp_+(((i)>>2)*4096+((i)&3)*1024)); vhi[i]=vtr(vp_+(((i)>>2)*4096+((i)&3)*1024+512)); }while(0)
  #define KRD(G,j) do{ if(G){ kload2(kf,kp0+sl_next,j); SBAR(); } }while(0)
  #define STEP(C0,C1,P0,P1,t,GK,GV,GL) do{ SBAR(); \
    const lds_cptr vp_=vp0+2*sl_prev; \
    VRD(0); SBAR(); float sacc=(P0[0]+P0[1]); \
    GAPA(C0=__builtin_amdgcn_mfma_f32_32x32x16_bf16(kf[0],qr[0],f32x16{},0,0,0), P0[2],P0[3],P0[4],P0[5],     pw0[0]=PKW(P0,0), pw0[1]=PKW(P0,2), pw0); \
    VRD(4); SBAR(); GAPA(C1=__builtin_amdgcn_mfma_f32_32x32x16_bf16(kf[1],qr[0],f32x16{},0,0,0), P0[6],P0[7],P0[8],P0[9],     pw0[2]=PKW(P0,4), pw0[3]=PKW(P0,6), pw0); \
    VRD(1); SBAR(); GAPA(C0=__builtin_amdgcn_mfma_f32_32x32x16_bf16(kf[2],qr[1],C0,0,0,0),   P0[10],P0[11],P0[12],P0[13], pw1[0]=PKW(P0,8), pw1[1]=PKW(P0,10), pw1); \
    VRD(5); SBAR(); GAPA(C1=__builtin_amdgcn_mfma_f32_32x32x16_bf16(kf[3],qr[1],C1,0,0,0),   P0[14],P0[15],P1[0],P1[1],   pw1[2]=PKW(P0,12),pw1[3]=PKW(P0,14), pw1); \
    VRD(2); SBAR(); GAPA(C0=__builtin_amdgcn_mfma_f32_32x32x16_bf16(kf[4],qr[2],C0,0,0,0),   P1[2],P1[3],P1[4],P1[5],     pw2[0]=PKW(P1,0), pw2[1]=PKW(P1,2), pw2); \
    VRD(6); SBAR(); GAPA(C1=__builtin_amdgcn_mfma_f32_32x32x16_bf16(kf[5],qr[2],C1,0,0,0),   P1[6],P1[7],P1[8],P1[9],     pw2[2]=PKW(P1,4), pw2[3]=PKW(P1,6), pw2); \
    VRD(3); SBAR(); GAPA(C0=__builtin_amdgcn_mfma_f32_32x32x16_bf16(kf[6],qr[3],C0,0,0,0),   P1[10],P1[11],P1[12],P1[13], pw3[0]=PKW(P1,8), pw3[1]=PKW(P1,10), pw3); \
    VRD(7); SBAR(); GAPA(C1=__builtin_amdgcn_mfma_f32_32x32x16_bf16(kf[7],qr[3],C1,0,0,0),   P1[14],P1[15],0.f,0.f,       pw3[2]=PKW(P1,12),pw3[3]=PKW(P1,14), pw3); \
    l_reg+=sacc; \
    if(GK){DMA_K((t)+3,sl_cur);} if(GV){DMA_V((t)+1,sl_next);} \
    CMASK(C0,C1,t); \
    { float a=MX3(C0[0],C0[1],C1[0]),b=MX3(C0[2],C0[3],C1[1]); a=MX3(a,C1[2],C1[3]); \
      _Pragma("unroll") for(int r=4;r<16;r+=4){a=MX3(a,C0[r],C0[r+1]);b=MX3(b,C0[r+2],C0[r+3]);a=MX3(a,C1[r],C1[r+1]);b=MX3(b,C1[r+2],C1[r+3]);} \
      float rm=__builtin_fmaxf(a,b); { auto rr=__builtin_amdgcn_permlane32_swap(__float_as_uint(rm),__float_as_uint(rm),false,false); rm=__builtin_fmaxf(__uint_as_float(rr[0]),__uint_as_float(rr[1])); } \
      resc=false; \
      rm-=mhat; \
      if(__builtin_expect(__any(rm>(float)THRL),0)){ const float dl=__builtin_fmaxf(rm,0.f); mhat+=dl; \
        const float f=__builtin_amdgcn_exp2f(-dl); l_reg*=f; if(hi==0)wsf[r32]=f; resc=true; } } \
    SBAR(); \
    GAPB(o[0]=__builtin_amdgcn_mfma_f32_32x32x16_bf16(PAF(0),VFR(0),o[0],0,0,0), C0,0);  VRD2(0); \
    GAPB(o[1]=__builtin_amdgcn_mfma_f32_32x32x16_bf16(PAF(0),VFR(4),o[1],0,0,0), C0,2);  VRD2(4); \
    KRD(GL,0); GAPB(o[0]=__builtin_amdgcn_mfma_f32_32x32x16_bf16(PAF(1),VFR(1),o[0],0,0,0), C0,4);  VRD2(1); \
    KRD(GL,1); GAPB(o[1]=__builtin_amdgcn_mfma_f32_32x32x16_bf16(PAF(1),VFR(5),o[1],0,0,0), C0,6);  VRD2(5); \
    KRD(GL,2); GAPB(o[0]=__builtin_amdgcn_mfma_f32_32x32x16_bf16(PAF(2),VFR(2),o[0],0,0,0), C0,8);  VRD2(2); \
    KRD(GL,3); GAPB(o[1]=__builtin_amdgcn_mfma_f32_32x32x16_bf16(PAF(2),VFR(6),o[1],0,0,0), C0,10); VRD2(6); \
    GAPB(o[0]=__builtin_amdgcn_mfma_f32_32x32x16_bf16(PAF(3),VFR(3),o[0],0,0,0), C0,12); VRD2(3); \
    GAPB(o[1]=__builtin_amdgcn_mfma_f32_32x32x16_bf16(PAF(3),VFR(7),o[1],0,0,0), C0,14); VRD2(7); \
    GAPB(o[2]=__builtin_amdgcn_mfma_f32_32x32x16_bf16(PAF(0),VFR(0),o[2],0,0,0), C1,0); \
    GAPB(o[3]=__builtin_amdgcn_mfma_f32_32x32x16_bf16(PAF(0),VFR(4),o[3],0,0,0), C1,2); \
    GAPB(o[2]=__builtin_amdgcn_mfma_f32_32x32x16_bf16(PAF(1),VFR(1),o[2],0,0,0), C1,4); \
    GAPB(o[3]=__builtin_amdgcn_mfma_f32_32x32x16_bf16(PAF(1),VFR(5),o[3],0,0,0), C1,6); \
    GAPB(o[2]=__builtin_amdgcn_mfma_f32_32x32x16_bf16(PAF(2),VFR(2),o[2],0,0,0), C1,8); \
    GAPB(o[3]=__builtin_amdgcn_mfma_f32_32x32x16_bf16(PAF(2),VFR(6),o[3],0,0,0), C1,10); \
    GAPB(o[2]=__builtin_amdgcn_mfma_f32_32x32x16_bf16(PAF(3),VFR(3),o[2],0,0,0), C1,12); \
    GAPB(o[3]=__builtin_amdgcn_mfma_f32_32x32x16_bf16(PAF(3),VFR(7),o[3],0,0,0), C1,14); \
    }while(0)
  int t=1;
  #undef CMASK
  #define CMASK(P0,P1,t) do{}while(0)
  for(;t+5<NT;t+=2){
    STEP(pB0,pB1,pA0,pA1,t,true,true,true);     WAIT_BAR(3); RESC(); ROT();
    STEP(pA0,pA1,pB0,pB1,t+1,true,true,true);   WAIT_BAR(3); RESC(); ROT();
  }
  #undef CMASK
  #define CMASK(P0,P1,t) do{}while(0)
  #define ENDW(tt) do{ if((tt)+3<NT){WAIT_BAR(3);} else if((tt)+2<NT){WAIT_BAR(2);} else {WAIT_BAR(0);} }while(0)
  for(;t+1<NT;t+=2){
    STEP(pB0,pB1,pA0,pA1,t,(t+3<NT),(t+1<NT),(t+1<NT));       ENDW(t);   RESC(); ROT();
    STEP(pA0,pA1,pB0,pB1,t+1,(t+4<NT),(t+2<NT),(t+2<NT));     ENDW(t+1); RESC(); ROT();
  }
  STEP(pB0,pB1,pA0,pA1,NT-1,false,false,false); RESC();
  { float sacc=pB0[0]+pB0[1]; _Pragma("unroll") for(int r=2;r<16;++r)sacc+=pB0[r]; _Pragma("unroll") for(int r=0;r<16;++r)sacc+=pB1[r]; l_reg+=sacc;
    pw0=(u32x4){PKW(pB0,0),PKW(pB0,2),PKW(pB0,4),PKW(pB0,6)};pw1=(u32x4){PKW(pB0,8),PKW(pB0,10),PKW(pB0,12),PKW(pB0,14)};pw2=(u32x4){PKW(pB1,0),PKW(pB1,2),PKW(pB1,4),PKW(pB1,6)};pw3=(u32x4){PKW(pB1,8),PKW(pB1,10),PKW(pB1,12),PKW(pB1,14)};
    SBAR(); pv(o,vb0+2*sl_cur,PAF(0),PAF(1),PAF(2),PAF(3)); }
  #undef PKW
  #undef PAF
  #undef VFR
  #undef PIN
  #undef MX3
  #undef GAPA
  #undef GAPB
  #undef EX
  #undef VRD
  #undef VRD2
  #undef KRD
  #undef STEP
  #undef ENDW
  {auto rr=__builtin_amdgcn_permlane32_swap(__float_as_uint(l_reg),__float_as_uint(l_reg),false,false);l_reg=__uint_as_float(rr[0])+__uint_as_float(rr[1]);}
  if(hi==0)wsf[32+r32]=l_reg;asm volatile("s_waitcnt lgkmcnt(0)":::"memory");
  float rli[16];
  #pragma unroll
  for(int r=0;r<16;++r)rli[r]=__builtin_amdgcn_rcpf(wsf[32+crow(r,hi)]);
  bf16*Ow=Op+(long)(q0+wid*QBLK)*DM;
  { bf16*stg=(bf16*)(shm+LDS_OST)+wid*4096;
    #pragma unroll
    for(int r=0;r<16;++r){const int orow=crow(r,hi);
      #pragma unroll
      for(int d0=0;d0<4;++d0)stg[orow*128+d0*32+r32]=__float2bfloat16(o[d0][r]*rli[r]);}
    asm volatile("s_waitcnt lgkmcnt(0)":::"memory");
    #pragma unroll
    for(int i=0;i<8;++i){const int row=i*4+(lane>>4),ch=lane&15; const u32x4 v=*(const u32x4*)(stg+row*128+ch*8); ATTN_STORE16(Ow+(long)row*DM+ch*8,v);} }
  asm volatile("s_waitcnt lgkmcnt(0)\n\ts_barrier":::"memory");
  #undef DMA_K
  #undef DMA_V
  #undef CMASK
  #undef START
  #undef RESC
  #undef ROT
}
constexpr int ATTN_LDS_BYTES=LDS_BYTES;
#undef SBAR
#undef WAIT_BAR
}

#define GAS __attribute__((address_space(1)))
#define LAS __attribute__((address_space(3)))
typedef unsigned short bf16;
typedef unsigned v4u __attribute__((ext_vector_type(4)));
typedef unsigned v2u __attribute__((ext_vector_type(2)));
typedef float f32x4 __attribute__((ext_vector_type(4)));
typedef float f32x16 __attribute__((ext_vector_type(16)));
typedef short bf16x8 __attribute__((ext_vector_type(8)));
typedef short s16x4 __attribute__((ext_vector_type(4)));
#define LDS_WAIT() asm volatile("s_waitcnt lgkmcnt(0)" ::: "memory")

constexpr int DMODEL = 1024, NIN = 9728, FFH = 2816;
constexpr int S_P = 4096, S_S = 2048;
constexpr int CT = 32768, NCHUNK = 3;
constexpr float EPS = 1e-6f;
constexpr float C2 = 0.18033688011112042f;
constexpr int LDS_BYTES = 147456;
constexpr int NWAVES = 8;

constexpr size_t MiB = 1u << 20;
constexpr size_t WS_MOD = 1 * MiB, WS_ROPE = 2 * MiB;
constexpr size_t WS_WIN = 4 * MiB, WS_WA = 23 * MiB, WS_WB = 25 * MiB, WS_WOUT = 26 * MiB, WS_WGU = 28 * MiB, WS_WDN = 39 * MiB;
constexpr size_t WS_H = 48 * MiB;
constexpr size_t WS_QA = 112 * MiB, WS_KA = 176 * MiB, WS_VA = 240 * MiB, WS_G0 = 304 * MiB  , WS_G1 = 592 * MiB, WS_G2 = 656 * MiB;
constexpr size_t WS_O1 = 720 * MiB, WS_O2 = 784 * MiB, WS_OG = 848 * MiB  , WS_LSE = 944 * MiB  , WS_END = 948 * MiB;
constexpr size_t WS_OA = WS_QA, WS_OB = WS_G0, WS_MRG = WS_KA, WS_ACT = WS_VA;

struct Args {
    const float *x_prompt, *x_sample, *c_prompt, *c_sample, *w_ada, *b_ada, *g_mix, *w_in, *lq1, *lk1, *lq2, *lk2, *g_subln, *w_a, *w_b, *w_out, *g_ffn, *w_gu, *w_down, *g_final;
    float* out; unsigned char* ws;
};

typedef const __attribute__((address_space(4))) Args* CArgs;
__device__ __forceinline__ CArgs argp() { CArgs p = (CArgs)__builtin_amdgcn_kernarg_segment_ptr(); asm volatile("" : "+s"(p)); return p; }

__device__ __forceinline__ float wave_sum(float v) {
#pragma unroll
    for (int o = 1; o < 64; o <<= 1) v += __shfl_xor(v, o);
    return v;
}
__device__ __forceinline__ unsigned f2bf(float f) { unsigned u = __builtin_bit_cast(unsigned, f); return (u + 0x7fffu + ((u >> 16) & 1u)) >> 16; }
__device__ __forceinline__ unsigned pk2(float lo, float hi) { return f2bf(lo) | (f2bf(hi) << 16); }
__device__ __forceinline__ float bflo(unsigned w) { return __builtin_bit_cast(float, w << 16); }
__device__ __forceinline__ float bfhi(unsigned w) { return __builtin_bit_cast(float, w & 0xffff0000u); }

__device__ __forceinline__ int maprow(int mode, int n) {
    if (mode == 1) {
        const bool qk = (n < 2048) || (n >= 3072 && n < 7680 && ((n - 3072) % 1536) < 1024);
        const int i = n & 63;
        if (qk && i < 16) return n - i + ((i < 8) ? 2 * i : 2 * (i - 8) + 1);
        return n;
    }
    if (mode == 2) {
        const bool up = n >= FFH; const int j = up ? n - FFH : n;
        return 8 * (j >> 2) + (j & 3) + (up ? 4 : 0);
    }
    return n;
}
__device__ __forceinline__ void p0_transpose_item(const float* W, int K, int N, bf16* WT, int mode, LAS float* scr, int item, int lane) {
    const int nblk = N / 32, kb = item / nblk, nb = item % nblk, k0 = 64 * kb, n0 = 32 * nb;
#pragma unroll 8
    for (int i = 0; i < 32; ++i) { const int kk = 2 * i + (lane >> 5); scr[kk * 33 + (lane & 31)] = W[(size_t)(k0 + kk) * N + n0 + (lane & 31)]; }
    LDS_WAIT(); asm volatile("" ::: "memory");
    const int c = lane & 7;
#pragma unroll
    for (int j = 0; j < 4; ++j) { const int n = (lane >> 3) + 8 * j; const LAS float* s = scr + (8 * c) * 33 + n;
        v4u o; o.x = pk2(s[0 * 33], s[1 * 33]); o.y = pk2(s[2 * 33], s[3 * 33]); o.z = pk2(s[4 * 33], s[5 * 33]); o.w = pk2(s[6 * 33], s[7 * 33]);
        *(GAS v4u*)(WT + (size_t)maprow(mode, n0 + n) * K + k0 + 8 * c) = o; }
    LDS_WAIT(); asm volatile("" ::: "memory");
}
__constant__ double ROPE_INVREV[8] = {0.15915494309189535, 0.03086376340470123, 0.005985185712713705, 0.001160663641240061,
                                      0.00022507907903927653, 4.364795279280289e-05, 8.464330808241401e-06, 1.6414262627950345e-06};

__device__ __forceinline__ void p0_prologue(LAS unsigned char* lds, int tid, int lane, int wave, int vcu, int G) {
    CArgs ap = argp(); unsigned char* ws = ap->ws;
    LAS float* scr = (LAS float*)(lds + wave * 16384);
    const int gw = vcu * NWAVES + wave, NGW = G * NWAVES;
    constexpr int I_IN = 16 * (NIN / 32), I_A = 16 * 32, I_B = 8 * 32, I_O = 16 * 32, I_GU = 16 * (2 * FFH / 32), I_DN = (FFH / 64) * 32;
    constexpr int NITEMS = I_IN + I_A + I_B + I_O + I_GU + I_DN;
    for (int it = gw; it < NITEMS; it += NGW) {
        int r = it;
        if (r < I_IN) { p0_transpose_item(ap->w_in, 1024, NIN, (bf16*)(ws + WS_WIN), 1, scr, r, lane); continue; } r -= I_IN;
        if (r < I_A) { p0_transpose_item(ap->w_a, 1024, 1024, (bf16*)(ws + WS_WA), 0, scr, r, lane); continue; } r -= I_A;
        if (r < I_B) { p0_transpose_item(ap->w_b, 512, 1024, (bf16*)(ws + WS_WB), 0, scr, r, lane); continue; } r -= I_B;
        if (r < I_O) { p0_transpose_item(ap->w_out, 1024, 1024, (bf16*)(ws + WS_WOUT), 0, scr, r, lane); continue; } r -= I_O;
        if (r < I_GU) { p0_transpose_item(ap->w_gu, 1024, 2 * FFH, (bf16*)(ws + WS_WGU), 2, scr, r, lane); continue; } r -= I_GU;
        p0_transpose_item(ap->w_down, FFH, 1024, (bf16*)(ws + WS_WDN), 0, scr, r, lane);
    }
    for (int idx = blockIdx.x * 512 + tid; idx < 4096 * 8; idx += G * 512) {
        const int pos = idx >> 3, i = idx & 7;
        const double rev = (double)pos * ROPE_INVREV[i]; const float fr = (float)(rev - __builtin_floor(rev));
        float2 cs; cs.x = __builtin_amdgcn_cosf(fr); cs.y = __builtin_amdgcn_sinf(fr);
        ((float2*)(ws + WS_ROPE))[idx] = cs;
    }
    __syncthreads();
    const int bx = blockIdx.x;
    if (bx < 192) {
        const int n0 = bx * 32, b = lane & 31, h = lane >> 5;
        const float* crow_ = (b < 16) ? ap->c_prompt + (size_t)b * 1024 : ap->c_sample + (size_t)(b - 16) * 1024;
        f32x16 acc = {};
#pragma unroll 4
        for (int i = 0; i < 16; ++i) {
            const int k = 128 * wave + 8 * i + 4 * h;
            const f32x4 c4 = *(const f32x4*)(crow_ + k);
#pragma unroll
            for (int e = 0; e < 4; ++e) {
                const float cv = c4[e], sv = cv / (1.f + __expf(-cv));
                const float wv = ap->w_ada[(size_t)(k + e) * 6144 + n0 + (lane & 31)];
                acc = __builtin_amdgcn_mfma_f32_32x32x2f32(sv, wv, acc, 0, 0, 0);
            }
        }
        LAS float* red = (LAS float*)lds;
#pragma unroll
        for (int r = 0; r < 16; ++r) red[(wave * 16 + r) * 64 + lane] = acc[r];
        __syncthreads();
#pragma unroll
        for (int j = 0; j < 2; ++j) {
            const int o = tid + 512 * j, nn = o & 31, bb = o >> 5;
            const int hh = (bb >> 2) & 1, r = (bb & 3) + 4 * (bb >> 3), ln = nn + 32 * hh;
            float s = ap->b_ada[n0 + nn];
#pragma unroll
            for (int w = 0; w < 8; ++w) s += red[(w * 16 + r) * 64 + ln];
            ((float*)(ws + WS_MOD))[(size_t)bb * 6144 + n0 + nn] = s;
        }
    }
    __syncthreads();
}

__device__ __forceinline__ void rows_norm_mod(const float* xsrc, bf16* dst, const float* gain, const float* mod, int sh_idx, int sc_idx, int S, int b0, int gw, int NGW, int lane) {
    f32x4 g[4];
#pragma unroll
    for (int j = 0; j < 4; ++j) g[j] = *(const f32x4*)(gain + 4 * lane + 256 * j);
    for (int row = gw; row < CT; row += NGW) {
        const int b = b0 + row / S;
        const GAS f32x4* xr = (const GAS f32x4*)(xsrc + (size_t)row * 1024) + lane;
        f32x4 v[4]; float ss = 0.f;
#pragma unroll
        for (int j = 0; j < 4; ++j) { v[j] = xr[64 * j]; ss += (v[j].x * v[j].x + v[j].y * v[j].y) + (v[j].z * v[j].z + v[j].w * v[j].w); }
        const float rstd = 1.f / sqrtf(wave_sum(ss) * (1.f / 1024.f) + EPS);
        const float* mb = mod + (size_t)b * 6144;
        GAS unsigned long long* o8 = (GAS unsigned long long*)(dst + (size_t)row * 1024) + lane;
#pragma unroll
        for (int j = 0; j < 4; ++j) {
            const f32x4 sc = *(const f32x4*)(mb + sc_idx * 1024 + 4 * lane + 256 * j), sh = *(const f32x4*)(mb + sh_idx * 1024 + 4 * lane + 256 * j);
            const f32x4 h = v[j] * rstd * g[j] * (1.f + sc) + sh;
            o8[64 * j] = (unsigned long long)pk2(h.x, h.y) | ((unsigned long long)pk2(h.z, h.w) << 32);
        }
    }
}
__device__ __forceinline__ void rows_final_norm(float* x, const float* gain, int gw, int NGW, int lane) {
    f32x4 g[4];
#pragma unroll
    for (int j = 0; j < 4; ++j) g[j] = *(const f32x4*)(gain + 4 * lane + 256 * j);
    for (int row = gw; row < CT; row += NGW) {
        GAS f32x4* xr = (GAS f32x4*)(x + (size_t)row * 1024) + lane;
        f32x4 v[4]; float ss = 0.f;
#pragma unroll
        for (int j = 0; j < 4; ++j) { v[j] = xr[64 * j]; ss += (v[j].x * v[j].x + v[j].y * v[j].y) + (v[j].z * v[j].z + v[j].w * v[j].w); }
        const float rstd = 1.f / sqrtf(wave_sum(ss) * (1.f / 1024.f) + EPS);
#pragma unroll
        for (int j = 0; j < 4; ++j) xr[64 * j] = v[j] * rstd * g[j];
    }
}
__device__ __forceinline__ void rows_combine(int gw, int NGW, int lane) {
    CArgs ap = argp(); unsigned char* ws = ap->ws;
    const float e1 = __expf(wave_sum(ap->lq1[lane] * ap->lk1[lane])), e2 = __expf(wave_sum(ap->lq2[lane] * ap->lk2[lane]));
    const float lam = e1 - e2 + 0.2f;
    f32x4 gs[4];
#pragma unroll
    for (int j = 0; j < 4; ++j) gs[j] = *(const f32x4*)(ap->g_subln + ((16 * lane) & 127) + 4 * j) * 0.8f;
    const bf16* O1 = (const bf16*)(ws + WS_O1); const bf16* O2 = (const bf16*)(ws + WS_O2); bf16* OA = (bf16*)(ws + WS_OA);
    const bf16* OG = (const bf16*)(ws + WS_OG); const float* LSE = (const float*)(ws + WS_LSE); bf16* OB = (bf16*)(ws + WS_OB);
    for (int row = gw; row < CT; row += NGW) {
        const v4u* p1 = (const v4u*)(O1 + (size_t)row * 1024 + 16 * lane); const v4u* p2 = (const v4u*)(O2 + (size_t)row * 1024 + 16 * lane);
        const v4u a0 = p1[0], a1 = p1[1], b0 = p2[0], b1 = p2[1];
        float d[16];
#pragma unroll
        for (int i = 0; i < 4; ++i) { d[2 * i] = bflo(a0[i]) - lam * bflo(b0[i]); d[2 * i + 1] = bfhi(a0[i]) - lam * bfhi(b0[i]);
                                      d[8 + 2 * i] = bflo(a1[i]) - lam * bflo(b1[i]); d[8 + 2 * i + 1] = bfhi(a1[i]) - lam * bfhi(b1[i]); }
        float ss = 0.f;
#pragma unroll
        for (int i = 0; i < 16; ++i) ss += d[i] * d[i];
        ss += __shfl_xor(ss, 1); ss += __shfl_xor(ss, 2); ss += __shfl_xor(ss, 4);
        const float rs = 1.f / sqrtf(ss * (1.f / 128.f) + EPS);
        v4u o0, o1;
#pragma unroll
        for (int i = 0; i < 4; ++i) { o0[i] = pk2(d[2 * i] * rs * gs[i >> 1][(2 * i) & 3], d[2 * i + 1] * rs * gs[i >> 1][(2 * i + 1) & 3]);
                                      o1[i] = pk2(d[8 + 2 * i] * rs * gs[2 + (i >> 1)][(2 * i) & 3], d[8 + 2 * i + 1] * rs * gs[2 + (i >> 1)][(2 * i + 1) & 3]); }
        v4u* po = (v4u*)(OA + (size_t)row * 1024 + 16 * lane); po[0] = o0; po[1] = o1;
        const int hd = lane >> 3;
        const float l0 = LSE[((size_t)0 * CT + row) * 8 + hd], l1 = LSE[((size_t)1 * CT + row) * 8 + hd], l2 = LSE[((size_t)2 * CT + row) * 8 + hd];
        const float mx = fmaxf(l0, fmaxf(l1, l2));
        float w0 = __builtin_amdgcn_exp2f(l0 - mx), w1 = __builtin_amdgcn_exp2f(l1 - mx), w2 = __builtin_amdgcn_exp2f(l2 - mx);
        const float inv = 1.f / (w0 + w1 + w2); w0 *= inv; w1 *= inv; w2 *= inv;
        const v4u g0 = *(const v4u*)(OG + ((size_t)0 * CT + row) * 512 + 8 * lane), g1 = *(const v4u*)(OG + ((size_t)1 * CT + row) * 512 + 8 * lane), g2 = *(const v4u*)(OG + ((size_t)2 * CT + row) * 512 + 8 * lane);
        v4u ob;
#pragma unroll
        for (int i = 0; i < 4; ++i) ob[i] = pk2(w0 * bflo(g0[i]) + w1 * bflo(g1[i]) + w2 * bflo(g2[i]), w0 * bfhi(g0[i]) + w1 * bfhi(g1[i]) + w2 * bfhi(g2[i]));
        *(v4u*)(OB + (size_t)row * 512 + 8 * lane) = ob;
    }
}

using pg8::Unit;
typedef pg8::f32x4 pf4;
__device__ __forceinline__ v4u pack8(const pf4 v0, const pf4 v1) { v4u w; w.x = pg8::cvt_pk_bf16(v0[0], v0[1]); w.y = pg8::cvt_pk_bf16(v0[2], v0[3]); w.z = pg8::cvt_pk_bf16(v1[0], v1[1]); w.w = pg8::cvt_pk_bf16(v1[2], v1[3]); return w; }
__device__ __forceinline__ float sigm(float x) { return __builtin_amdgcn_rcpf(1.f + __expf(-x)); }

struct EpiIn {
    static constexpr bool PERM = true, AFTER_DRAIN = false;
    unsigned char* ws; int S;
    __device__ __forceinline__ void operator()(const pf4 (&acc)[2][2][4][2], const Unit& u, int wr, int wc, int fr, int fq) const {
        int pm_ = u.pm, pn_ = u.pn; asm volatile("" : "+s"(pm_), "+s"(pn_)); const Unit uu{pm_, pn_};
        const int pn = uu.pn; int kind, ldc = 1024, ct; size_t base;
        if (pn < 4) { kind = 1; base = WS_QA; ct = pn; }
        else if (pn < 8) { kind = 2; base = WS_KA; ct = pn - 4; }
        else if (pn < 12) { kind = 0; base = WS_VA; ct = pn - 8; }
        else if (pn < 30) { const int q = pn - 12, g = q / 6, r = q % 6, part = r >> 1; ct = r & 1; ldc = 512; base = WS_G0 + (size_t)(g * 3 + part) * 32 * MiB; kind = part == 0 ? 1 : (part == 1 ? 2 : 0); }
        else if (pn < 34) { kind = 3; base = WS_G1; ct = pn - 30; }
        else { kind = 3; base = WS_G2; ct = pn - 34; }
        bf16* O = (bf16*)(ws + base);
        const int row0 = uu.pm * 256 + wr * 64 + fr, col0 = ct * 256 + wc * 32 + 8 * fq;
        const bool ropew = (kind == 1 || kind == 2) && ((wc & 1) == 0); const bool ropel = fq < 2;
        const float sc = kind == 1 ? C2 : 1.f;
        const float* rope = (const float*)(ws + WS_ROPE);
#pragma unroll
        for (int ai = 0; ai < 2; ++ai)
#pragma unroll
            for (int m = 0; m < 4; ++m) {
                const int row = row0 + ai * 128 + m * 16;
                pf4 cs0 = {1.f, 0.f, 1.f, 0.f}, cs1 = {1.f, 0.f, 1.f, 0.f};
                if (ropew) { const float* rp = rope + ((size_t)(row % S) * 8 + 4 * (fq & 1)) * 2; cs0 = *(const pf4*)rp; cs1 = *(const pf4*)(rp + 4); }
                bf16* rowp = O + (size_t)row * ldc + col0;
#pragma unroll
                for (int bj = 0; bj < 2; ++bj) {
                    pf4 v0 = acc[ai][bj][m][0], v1 = acc[ai][bj][m][1];
                    if (ropew) {
                        pf4 r0, r1;
                        r0[0] = v0[0] * cs0[0] - v0[1] * cs0[1]; r0[1] = v0[1] * cs0[0] + v0[0] * cs0[1];
                        r0[2] = v0[2] * cs0[2] - v0[3] * cs0[3]; r0[3] = v0[3] * cs0[2] + v0[2] * cs0[3];
                        r1[0] = v1[0] * cs1[0] - v1[1] * cs1[1]; r1[1] = v1[1] * cs1[0] + v1[0] * cs1[1];
                        r1[2] = v1[2] * cs1[2] - v1[3] * cs1[3]; r1[3] = v1[3] * cs1[2] + v1[2] * cs1[3];
                        if (ropel) { v0 = r0; v1 = r1; }
                    }
                    if (kind == 3) {
#pragma unroll
                        for (int e = 0; e < 4; ++e) { v0[e] = sigm(v0[e]); v1[e] = sigm(v1[e]); }
                    }
                    v0 = v0 * sc; v1 = v1 * sc;
                    *(v4u*)(rowp + bj * 128) = pack8(v0, v1);
                }
                asm volatile("" ::: "memory");
            }
    }
};
struct EpiGate {
    static constexpr bool PERM = true, AFTER_DRAIN = false;
    const bf16* gate; bf16* O; int mode;
    __device__ __forceinline__ void operator()(const pf4 (&acc)[2][2][4][2], const Unit& u, int wr, int wc, int fr, int fq) const {
        int pm_ = u.pm, pn_ = u.pn; asm volatile("" : "+s"(pm_), "+s"(pn_)); const Unit uu{pm_, pn_};
        const int row0 = uu.pm * 256 + wr * 64 + fr, col0 = uu.pn * 256 + wc * 32 + 8 * fq;
#pragma unroll
        for (int ai = 0; ai < 2; ++ai)
#pragma unroll
            for (int m = 0; m < 4; ++m) {
                const size_t off = (size_t)(row0 + ai * 128 + m * 16) * 1024 + col0;
#pragma unroll
                for (int bj = 0; bj < 2; ++bj) {
                    const v4u gv = *(const v4u*)(gate + off + bj * 128);
                    pf4 v0 = acc[ai][bj][m][0], v1 = acc[ai][bj][m][1];
                    v0[0] *= bflo(gv.x); v0[1] *= bfhi(gv.x); v0[2] *= bflo(gv.y); v0[3] *= bfhi(gv.y);
                    v1[0] *= bflo(gv.z); v1[1] *= bfhi(gv.z); v1[2] *= bflo(gv.w); v1[3] *= bfhi(gv.w);
                    if (mode) { const v4u pv = *(const v4u*)(O + off + bj * 128);
                        v0[0] += bflo(pv.x); v0[1] += bfhi(pv.x); v0[2] += bflo(pv.y); v0[3] += bfhi(pv.y);
                        v1[0] += bflo(pv.z); v1[1] += bfhi(pv.z); v1[2] += bflo(pv.w); v1[3] += bfhi(pv.w); }
                    *(v4u*)(O + off + bj * 128) = pack8(v0, v1);
                }
                asm volatile("" ::: "memory");
            }
    }
};
struct EpiRes {
    static constexpr bool PERM = true, AFTER_DRAIN = false;
    const float* base; float* out; const float* mod; int gidx, S, b0;
    __device__ __forceinline__ void operator()(const pf4 (&acc)[2][2][4][2], const Unit& u, int wr, int wc, int fr, int fq) const {
        int pm_ = u.pm, pn_ = u.pn; asm volatile("" : "+s"(pm_), "+s"(pn_)); const Unit uu{pm_, pn_};
        const int row0 = uu.pm * 256 + wr * 64 + fr, col0 = uu.pn * 256 + wc * 32 + 8 * fq;
        const float* gp = mod + (size_t)(b0 + (uu.pm * 256) / S) * 6144 + gidx * 1024 + col0;
        pf4 gt[2][2];
#pragma unroll
        for (int bj = 0; bj < 2; ++bj) { gt[bj][0] = *(const pf4*)(gp + bj * 128); gt[bj][1] = *(const pf4*)(gp + bj * 128 + 4); }
#pragma unroll
        for (int ai = 0; ai < 2; ++ai)
#pragma unroll
            for (int m = 0; m < 4; ++m) {
                const size_t off = (size_t)(row0 + ai * 128 + m * 16) * 1024 + col0;
#pragma unroll
                for (int bj = 0; bj < 2; ++bj) {
                    const pf4 x0 = *(const pf4*)(base + off + bj * 128), x1 = *(const pf4*)(base + off + bj * 128 + 4);
                    *(pf4*)(out + off + bj * 128) = x0 + gt[bj][0] * acc[ai][bj][m][0];
                    *(pf4*)(out + off + bj * 128 + 4) = x1 + gt[bj][1] * acc[ai][bj][m][1];
                }
                asm volatile("" ::: "memory");
            }
    }
};
struct EpiGU {
    static constexpr bool PERM = true, AFTER_DRAIN = false;
    bf16* act;
    __device__ __forceinline__ void operator()(const pf4 (&acc)[2][2][4][2], const Unit& u, int wr, int wc, int fr, int fq) const {
        int pm_ = u.pm, pn_ = u.pn; asm volatile("" : "+s"(pm_), "+s"(pn_)); const Unit uu{pm_, pn_};
        const int row0 = uu.pm * 256 + wr * 64 + fr, col0 = uu.pn * 128 + wc * 16 + 4 * fq;
#pragma unroll
        for (int ai = 0; ai < 2; ++ai)
#pragma unroll
            for (int m = 0; m < 4; ++m) {
                bf16* rowp = act + (size_t)(row0 + ai * 128 + m * 16) * FFH + col0;
#pragma unroll
                for (int bj = 0; bj < 2; ++bj) {
                    const pf4 g = acc[ai][bj][m][0], up = acc[ai][bj][m][1]; pf4 r;
#pragma unroll
                    for (int e = 0; e < 4; ++e) r[e] = g[e] * sigm(g[e]) * up[e];
                    v2u w; w.x = pg8::cvt_pk_bf16(r[0], r[1]); w.y = pg8::cvt_pk_bf16(r[2], r[3]);
                    *(v2u*)(rowp + bj * 64) = w;
                }
                asm volatile("" ::: "memory");
            }
    }
};

__device__ __forceinline__ float halfmax(float m) { auto rr = __builtin_amdgcn_permlane32_swap(__float_as_uint(m), __float_as_uint(m), false, false); return fmaxf(__uint_as_float(rr[0]), __uint_as_float(rr[1])); }
__device__ __forceinline__ float halfsum(float m) { auto rr = __builtin_amdgcn_permlane32_swap(__float_as_uint(m), __float_as_uint(m), false, false); return __uint_as_float(rr[0]) + __uint_as_float(rr[1]); }
typedef short v4i16_t __attribute__((ext_vector_type(4)));
__device__ __forceinline__ s16x4 trrd(LAS unsigned char* p) { return __builtin_bit_cast(s16x4, __builtin_amdgcn_ds_read_tr16_b64_v4i16((LAS v4i16_t*)p)); }
__device__ __forceinline__ void dil_unit(const bf16* Qg, const bf16* Kg, const bf16* Vg, bf16* Og, float* Lg, int r, int n, int dil, int T, LAS unsigned char* wl, int lane) {
    const int r32 = lane & 31, hi = lane >> 5;
    LAS unsigned char* vimg = wl;
    LAS bf16* stg = (LAS bf16*)(wl + 4096);
    LAS float* wsf = (LAS float*)(wl + 8192);
    const int vwr = ((lane & 7) >> 2) * 2048 + (lane >> 3) * 64 + (lane & 3) * 16;
    const int vrd = ((lane >> 4) & 1) * 32 + (lane & 3) * 8 + (4 * hi + ((lane & 15) >> 2)) * 64;
    for (int qi = 0; qi < 2; ++qi) {
        const int tq0 = 64 * n + 32 * qi;
        const bf16* qp = Qg + (size_t)(r + dil * (tq0 + r32)) * 512 + 8 * hi;
        bf16x8 qf[4];
#pragma unroll
        for (int d0 = 0; d0 < 4; ++d0) qf[d0] = *(const bf16x8*)(qp + 16 * d0);
        f32x16 s[5];
#pragma unroll
        for (int kb = 0; kb < 5; ++kb) {
            const int tk0 = tq0 - 64 + 32 * kb; int tk = tk0 + r32; tk = tk < 0 ? 0 : (tk >= T ? T - 1 : tk);
            const bf16* kp = Kg + (size_t)(r + dil * tk) * 512 + 8 * hi;
            bf16x8 kf[4];
#pragma unroll
            for (int d0 = 0; d0 < 4; ++d0) kf[d0] = *(const bf16x8*)(kp + 16 * d0);
            f32x16 acc = {};
#pragma unroll
            for (int d0 = 0; d0 < 4; ++d0) acc = __builtin_amdgcn_mfma_f32_32x32x16_bf16(kf[d0], qf[d0], acc, 0, 0, 0);
#pragma unroll
            for (int rr = 0; rr < 16; ++rr) {
                const int cr = (rr & 3) + 8 * (rr >> 2) + 4 * hi; const int rel = -64 + 32 * kb + cr - r32; const int kt = tk0 + cr;
                const bool ok = (rel >= -64) && (rel <= 64) && (kt >= 0) && (kt < T);
                acc[rr] = ok ? acc[rr] : -INFINITY;
            }
            s[kb] = acc;
        }
        float mx = -INFINITY;
#pragma unroll
        for (int kb = 0; kb < 5; ++kb)
#pragma unroll
            for (int rr = 0; rr < 16; ++rr) mx = fmaxf(mx, s[kb][rr]);
        mx = halfmax(mx);
        float lsum = 0.f;
#pragma unroll
        for (int kb = 0; kb < 5; ++kb)
#pragma unroll
            for (int rr = 0; rr < 16; ++rr) { const float p = __builtin_amdgcn_exp2f(s[kb][rr] - mx); s[kb][rr] = p; lsum += p; }
        lsum = halfsum(lsum);
        f32x16 o[2]; o[0] = f32x16{}; o[1] = f32x16{};
#pragma unroll
        for (int kb = 0; kb < 5; ++kb) {
            const int tk0 = tq0 - 64 + 32 * kb;
            bf16x8 vv[4];
#pragma unroll
            for (int j = 0; j < 4; ++j) { int tk = tk0 + 8 * j + (lane >> 3); tk = tk < 0 ? 0 : (tk >= T ? T - 1 : tk);
                vv[j] = *(const bf16x8*)(Vg + (size_t)(r + dil * tk) * 512 + 8 * (lane & 7)); }
#pragma unroll
            for (int j = 0; j < 4; ++j) *(LAS bf16x8*)(vimg + vwr + j * 512) = vv[j];
#pragma unroll
            for (int ks = 0; ks < 2; ++ks) {
                v4u pw;
#pragma unroll
                for (int e = 0; e < 4; ++e) pw[e] = pg8::cvt_pk_bf16(s[kb][8 * ks + 2 * e], s[kb][8 * ks + 2 * e + 1]);
                const bf16x8 pa = __builtin_bit_cast(bf16x8, pw);
#pragma unroll
                for (int d0 = 0; d0 < 2; ++d0) {
                    const s16x4 lo = trrd(vimg + vrd + d0 * 2048 + ks * 1024), hh = trrd(vimg + vrd + d0 * 2048 + ks * 1024 + 512);
                    const bf16x8 vb = (bf16x8){lo[0], lo[1], lo[2], lo[3], hh[0], hh[1], hh[2], hh[3]};
                    o[d0] = __builtin_amdgcn_mfma_f32_32x32x16_bf16(pa, vb, o[d0], 0, 0, 0);
                }
            }
        }
        if (hi == 0) wsf[r32] = lsum;
#pragma unroll
        for (int rr = 0; rr < 16; ++rr) {
            const int orow = (rr & 3) + 8 * (rr >> 2) + 4 * hi; const float rl = __builtin_amdgcn_rcpf(wsf[orow]);
#pragma unroll
            for (int d0 = 0; d0 < 2; ++d0) stg[orow * 64 + d0 * 32 + r32] = (bf16)f2bf(o[d0][rr] * rl);
        }
#pragma unroll
        for (int i = 0; i < 4; ++i) { const int row = i * 8 + (lane >> 3), ch = lane & 7; const v4u v = *(const LAS v4u*)(stg + row * 64 + ch * 8);
            *(v4u*)(Og + (size_t)(r + dil * (tq0 + row)) * 512 + ch * 8) = v; }
        if (hi == 0) Lg[(size_t)(r + dil * (tq0 + r32)) * 8] = mx + __builtin_amdgcn_logf(lsum);
    }
}

#define XB_TMO      128
#define XB_XCNT(j)  (256  + 64 * (j))
#define XB_XSUB(j)  (1280 + 64 * (j))
#define XB_XGEN(j)  (2304 + 64 * (j))
#define XB_TOP      3328
#define XB_TOPGEN   3392
#define XCD_BAR_WORDS 3456
#define XB_SPIN_CAP (1u << 18)

__device__ __forceinline__ unsigned xb_ld(unsigned* p)              { return __hip_atomic_load(p, __ATOMIC_RELAXED, __HIP_MEMORY_SCOPE_AGENT); }
__device__ __forceinline__ unsigned xb_add(unsigned* p, unsigned v) { return __hip_atomic_fetch_add(p, v, __ATOMIC_RELAXED, __HIP_MEMORY_SCOPE_AGENT); }
__device__ __forceinline__ unsigned xb_xcc_id() { return (unsigned)__builtin_amdgcn_s_getreg((3 << 11) | 20) & 0xFu; }
#define XB_SPIN(cond, bar) do { unsigned _sp = 0; while (cond) { __builtin_amdgcn_s_sleep(1); \
    if ((++_sp & 255u) == 0u) { if (xb_ld(&(bar)[XB_TMO])) break; if (_sp > XB_SPIN_CAP) { atomicAdd(&(bar)[XB_TMO], 1u); break; } } } } while (0)

struct XcdBarrier {
    unsigned* bar; unsigned x;
    volatile LAS unsigned* st;
};

__device__ __forceinline__ XcdBarrier xcd_barrier_post(unsigned* bar, volatile LAS unsigned* st) {
    XcdBarrier b; b.bar = bar; b.x = xb_xcc_id(); b.st = st;
    if (threadIdx.x == 0) (void)xb_add(&bar[XB_XCNT(b.x)], 1u);
    return b;
}
__device__ __forceinline__ void xcd_barrier_complete(unsigned* bar, unsigned x, unsigned& nloc, unsigned& nx) {
    const unsigned G = gridDim.x * gridDim.y * gridDim.z;
    unsigned sum, cnt, mine, sp = 0u;
    for (;;) {
        sum = 0u; cnt = 0u; mine = 0u;
#pragma unroll
        for (unsigned j = 0; j < 16; ++j) { const unsigned c = xb_ld(&bar[XB_XCNT(j)]); sum += c; cnt += (c > 0u) ? 1u : 0u; mine = (j == x) ? c : mine; }
        if (sum == G) break;
        __builtin_amdgcn_s_sleep(1);
        if ((++sp & 255u) == 0u) { if (xb_ld(&bar[XB_TMO])) break; if (sp > XB_SPIN_CAP) { atomicAdd(&bar[XB_TMO], 1u); break; } }
    }
    nloc = mine > 0u ? mine : 1u; nx = cnt > 0u ? cnt : 1u;
}

__device__ __forceinline__ void xcd_barrier(const XcdBarrier& b) {
    asm volatile("s_waitcnt vmcnt(0)" ::: "memory");
    __syncthreads();
    if (threadIdx.x == 0) {
        unsigned* bar = b.bar;
        __builtin_amdgcn_s_waitcnt(0);
        unsigned nloc = b.st[0], nx = b.st[1];
        if (nloc == 0u) { xcd_barrier_complete(bar, b.x, nloc, nx); b.st[0] = nloc; b.st[1] = nx; }
        const unsigned old = xb_add(&bar[XB_XSUB(b.x)], 1u);
        const unsigned gen = old / nloc;
        if (old + 1u == (gen + 1u) * nloc) {
            __builtin_amdgcn_fence(__ATOMIC_RELEASE, "agent");
            asm volatile("s_waitcnt vmcnt(0)" ::: "memory");
            const unsigned og = xb_add(&bar[XB_TOP], 1u);
            const unsigned tg = og / nx;
            if (og + 1u == (tg + 1u) * nx) xb_add(&bar[XB_TOPGEN], 1u);
            else XB_SPIN(xb_ld(&bar[XB_TOPGEN]) == tg, bar);
            __builtin_amdgcn_fence(__ATOMIC_ACQUIRE, "agent");
            xb_add(&bar[XB_XGEN(b.x)], 1u);
            asm volatile("s_waitcnt vmcnt(0)" ::: "memory");
        } else {
            XB_SPIN(xb_ld(&bar[XB_XGEN(b.x)]) == gen, bar);
            __builtin_amdgcn_fence(__ATOMIC_ACQUIRE, "agent");
            asm volatile("s_waitcnt vmcnt(0)" ::: "memory");
        }
    }
    __syncthreads();
}

#ifndef PROBE_GIN
#define PROBE_GIN 1
#endif
#ifndef PROBE_GU
#define PROBE_GU 1
#endif
#ifndef PROBE_DIL
#define PROBE_DIL 1
#endif
#ifndef PROBE_ATT
#define PROBE_ATT 1
#endif
#ifndef PROBE_ROWS
#define PROBE_ROWS 1
#endif
#ifndef PROBE_SYNC
#define PROBE_SYNC 1
#endif
#define GSYNC() do { for (int s_ = 0; s_ < PROBE_SYNC; ++s_) xcd_barrier(bar); } while (0)
__global__ void __launch_bounds__(NWAVES * 64, 2) fwd_megakernel(Args a) {
    extern __shared__ __attribute__((aligned(16))) unsigned char lds_raw[];
    cg::grid_group grid = cg::this_grid();
    LAS unsigned char* lds = (LAS unsigned char*)lds_raw;
    const int tid = threadIdx.x, lane = tid & 63, wave = __builtin_amdgcn_readfirstlane(tid >> 6);
    const int G = gridDim.x, bx = blockIdx.x;
    const int vcu = (G % 8 == 0) ? (bx % 8) * (G / 8) + bx / 8 : bx;
    const int gw = vcu * NWAVES + wave, NGW = G * NWAVES;

#ifndef NO_P0
    volatile LAS unsigned* MISC = (volatile LAS unsigned*)(lds + LDS_BYTES - 256);
    if (tid < 32) MISC[tid] = 0u;
    __syncthreads();
    XcdBarrier bar = xcd_barrier_post((unsigned*)argp()->ws, MISC + 8);
    p0_prologue(lds, tid, lane, wave, vcu, G);
#endif
    grid.sync();

    const int lane0 = lane;
    for (int c = 0; c < NCHUNK; ++c) {
        int lane = lane0; asm volatile("" : "+v"(lane));
        const int S = (c < 2) ? S_P : S_S, nseq = CT / S, b0 = (c < 2) ? c * 8 : 16;
#define FETCH() CArgs ap = argp(); unsigned char* ws = ap->ws; const float* mod = (const float*)(ws + WS_MOD); (void)mod
#define XC() ((c < 2) ? ap->x_prompt + (size_t)c * CT * 1024 : ap->x_sample)
#define OUTC() (ap->out + (size_t)c * CT * 1024)
        for (int rep_ = 0; rep_ < PROBE_ROWS; ++rep_) { FETCH(); rows_norm_mod(XC(), (bf16*)(ws + WS_H), ap->g_mix, mod, 0, 1, S, b0, gw, NGW, lane); }
        GSYNC();
        {   FETCH();
            pg8::Gemm g{(const pg8::bf16_t*)(ws + WS_H), (const pg8::bf16_t*)(ws + WS_WIN), CT, NIN, 1024}; pg8::StaticOrder So; So.init(CT, NIN, G, bx);
            EpiIn E{ws, S};
#ifndef NO_GIN
            for (int rep_ = 0; rep_ < PROBE_GIN; ++rep_)
            pg8::gemm_phase<EpiIn, pg8::StaticOrder, PG8_ALIGN, PG8_SP2>(lds, g, So, E);
#endif
        }
        GSYNC();
        {   FETCH();
            const int NQB = S / 256, NT = S / 64, nunits = nseq * 16 * NQB;
            for (int rep_ = 0; rep_ < PROBE_ATT; ++rep_)
            for (int id = vcu; id < nunits; id += G) {
                const int qb = id % NQB; int t = id / NQB; const int cmap = t & 1; t >>= 1; const int h8 = t & 7, seq = t >> 3;
                const size_t rb = (size_t)seq * S * 1024;
                const attn_body::bf16* Qp = (const attn_body::bf16*)(ws + WS_QA) + rb + (h8 * 2 + cmap) * 64;
                const attn_body::bf16* Kp = (const attn_body::bf16*)(ws + WS_KA) + rb + (h8 * 2 + cmap) * 64;
                const attn_body::bf16* Vp = (const attn_body::bf16*)(ws + WS_VA) + rb + h8 * 128;
                attn_body::bf16* Op = (attn_body::bf16*)(ws + (cmap ? WS_O2 : WS_O1)) + rb + h8 * 128;
#ifndef NO_ATT
                attn_body::attn_unit<8>(Qp, Kp, Vp, Op, qb * 256, NT, (char*)lds_raw);
#endif
            }
            __syncthreads();
            const int nb64 = S / 64, ndu = 3 * nseq * nb64;
            for (int rep_ = 0; rep_ < PROBE_DIL; ++rep_)
            for (int id = vcu; id < ndu; id += G) {
                const int rn = id % nb64; int t = id / nb64; const int seq = t % nseq, g = t / nseq;
                const int dil = (g == 0) ? 1 : (g == 1 ? 4 : 16), T = S / dil, nb = T / 64, r = rn / nb, n = rn % nb;
                const size_t rb = (size_t)seq * S * 512 + wave * 64;
                const bf16* Qg = (const bf16*)(ws + WS_G0 + (size_t)(g * 3 + 0) * 32 * MiB) + rb;
                const bf16* Kg = (const bf16*)(ws + WS_G0 + (size_t)(g * 3 + 1) * 32 * MiB) + rb;
                const bf16* Vg = (const bf16*)(ws + WS_G0 + (size_t)(g * 3 + 2) * 32 * MiB) + rb;
                bf16* Og = (bf16*)(ws + WS_OG + (size_t)g * 32 * MiB) + rb;
                float* Lg = (float*)(ws + WS_LSE) + ((size_t)g * CT + (size_t)seq * S) * 8 + wave;
#ifndef NO_DIL
                dil_unit(Qg, Kg, Vg, Og, Lg, r, n, dil, T, lds + wave * 8704, lane);
#endif
            }
        }
        GSYNC();
#ifndef NO_COMB
        for (int rep_ = 0; rep_ < PROBE_ROWS; ++rep_) rows_combine(gw, NGW, lane);
#endif
        GSYNC();
        {   FETCH();
            pg8::StaticOrder So; So.init(CT, 1024, G, bx);
            pg8::Gemm ga{(const pg8::bf16_t*)(ws + WS_OA), (const pg8::bf16_t*)(ws + WS_WA), CT, 1024, 1024};
            EpiGate Ea{(const bf16*)(ws + WS_G1), (bf16*)(ws + WS_MRG), 0};
#ifndef NO_GG
            pg8::gemm_phase<EpiGate, pg8::StaticOrder, PG8_ALIGN, PG8_SP2>(lds, ga, So, Ea);
#endif
            pg8::Gemm gb{(const pg8::bf16_t*)(ws + WS_OB), (const pg8::bf16_t*)(ws + WS_WB), CT, 1024, 512};
            EpiGate Eb{(const bf16*)(ws + WS_G2), (bf16*)(ws + WS_MRG), 1};
#ifndef NO_GG
            pg8::gemm_phase<EpiGate, pg8::StaticOrder, PG8_ALIGN, PG8_SP2>(lds, gb, So, Eb);
#endif
        }
        GSYNC();
        {   FETCH();
            pg8::StaticOrder So; So.init(CT, 1024, G, bx);
            pg8::Gemm g{(const pg8::bf16_t*)(ws + WS_MRG), (const pg8::bf16_t*)(ws + WS_WOUT), CT, 1024, 1024};
            EpiRes E{XC(), OUTC(), mod, 2, S, b0};
#ifndef NO_GR
            pg8::gemm_phase<EpiRes, pg8::StaticOrder, PG8_ALIGN, PG8_SP2>(lds, g, So, E);
#endif
        }
        GSYNC();
        for (int rep_ = 0; rep_ < PROBE_ROWS; ++rep_) { FETCH(); rows_norm_mod(OUTC(), (bf16*)(ws + WS_H), ap->g_ffn, mod, 3, 4, S, b0, gw, NGW, lane); }
        GSYNC();
        {   FETCH();
            pg8::StaticOrder So; So.init(CT, 2 * FFH, G, bx);
            pg8::Gemm g{(const pg8::bf16_t*)(ws + WS_H), (const pg8::bf16_t*)(ws + WS_WGU), CT, 2 * FFH, 1024};
            EpiGU E{(bf16*)(ws + WS_ACT)};
#ifndef NO_GU
            for (int rep_ = 0; rep_ < PROBE_GU; ++rep_)
            pg8::gemm_phase<EpiGU, pg8::StaticOrder, PG8_ALIGN, PG8_SP2>(lds, g, So, E);
#endif
        }
        GSYNC();
        {   FETCH();
            pg8::StaticOrder So; So.init(CT, 1024, G, bx);
            pg8::Gemm g{(const pg8::bf16_t*)(ws + WS_ACT), (const pg8::bf16_t*)(ws + WS_WDN), CT, 1024, FFH};
            float* oc_ = OUTC(); EpiRes E{oc_, oc_, mod, 5, S, b0};
#ifndef NO_GR
            pg8::gemm_phase<EpiRes, pg8::StaticOrder, PG8_ALIGN, PG8_SP2>(lds, g, So, E);
#endif
        }
        GSYNC();
        { FETCH(); rows_final_norm(OUTC(), ap->g_final, gw, NGW, lane); }
    }
}

extern "C" void kernel_launch(void* const* d_in, const int* in_sizes, int n_in, void* d_out, int out_size, void* d_ws, size_t ws_size, hipStream_t stream) {
    static int grid = 0;
    if (grid == 0) {
        if (n_in != 20 || ws_size < WS_END) { fprintf(stderr, "kernel_launch: unexpected n_in %d / ws_size %zu (need %zu)\n", n_in, ws_size, (size_t)WS_END); grid = -1; return; }
        int dev = 0, cus = 0, per_cu = 0;
        hipGetDevice(&dev); hipDeviceGetAttribute(&cus, hipDeviceAttributeMultiprocessorCount, dev);
        if (hipFuncSetAttribute((const void*)fwd_megakernel, hipFuncAttributeMaxDynamicSharedMemorySize, LDS_BYTES) != hipSuccess) { fprintf(stderr, "kernel_launch: hipFuncSetAttribute failed\n"); grid = -1; return; }
        if (hipOccupancyMaxActiveBlocksPerMultiprocessor(&per_cu, (const void*)fwd_megakernel, NWAVES * 64, LDS_BYTES) != hipSuccess || per_cu < 1) { fprintf(stderr, "kernel_launch: occupancy query says %d\n", per_cu); per_cu = 1; }
        (void)hipGetLastError();
        grid = cus * 1;
        fprintf(stderr, "kernel_launch: grid %d (cus %d, per_cu %d)\n", grid, cus, per_cu);
    }
    if (grid < 0) return;
    Args a{};
    a.x_prompt = (const float*)d_in[0]; a.x_sample = (const float*)d_in[1]; a.c_prompt = (const float*)d_in[2]; a.c_sample = (const float*)d_in[3];
    a.w_ada = (const float*)d_in[4]; a.b_ada = (const float*)d_in[5]; a.g_mix = (const float*)d_in[6]; a.w_in = (const float*)d_in[7];
    a.lq1 = (const float*)d_in[8]; a.lk1 = (const float*)d_in[9]; a.lq2 = (const float*)d_in[10]; a.lk2 = (const float*)d_in[11]; a.g_subln = (const float*)d_in[12];
    a.w_a = (const float*)d_in[13]; a.w_b = (const float*)d_in[14]; a.w_out = (const float*)d_in[15]; a.g_ffn = (const float*)d_in[16]; a.w_gu = (const float*)d_in[17];
    a.w_down = (const float*)d_in[18]; a.g_final = (const float*)d_in[19];
    a.out = (float*)d_out; a.ws = (unsigned char*)d_ws;
    if (hipMemsetAsync(d_ws, 0, 16384, stream) != hipSuccess) { fprintf(stderr, "kernel_launch: memset failed\n"); return; }
    void* args[] = {&a};
    hipError_t e = hipLaunchCooperativeKernel((const void*)fwd_megakernel, dim3(grid), dim3(NWAVES * 64), args, LDS_BYTES, stream);
    if (e != hipSuccess) fprintf(stderr, "kernel_launch: cooperative launch failed: %s (grid %d)\n", hipGetErrorString(e), grid);
}
```

```cpp
#include <hip/hip_runtime.h>
#include <hip/hip_bf16.h>
#include <hip/hip_cooperative_groups.h>
#include <cstdio>
#include <cstdint>
namespace cg = cooperative_groups;
namespace pg8 {
#define PG8_LAS __attribute__((address_space(3)))
typedef unsigned short bf16_t;
typedef short bf16x8 __attribute__((ext_vector_type(8)));
typedef float f32x4 __attribute__((ext_vector_type(4)));
typedef unsigned u32x4 __attribute__((ext_vector_type(4)));
constexpr int BM = 256, BK = 64, HALF = 128, HTB = HALF * BK * 2  , STAGE_BYTES = 8 * HTB, NXCD = 8, WGM = 8;

__host__ __device__ __forceinline__ int lds_byte(int r, int c) { const int st = (r >> 4) * 2 + (c >> 5), rr = r & 15, cc = c & 31, ob = rr * 64 + cc * 2; return st * 1024 + (ob ^ (((ob >> 9) & 1) << 5)); }
__host__ __device__ __forceinline__ void stage_rc(int b, int& R, int& C) { const int st = b / 1024, sb = b % 1024, swz = sb ^ (((sb >> 9) & 1) << 5); R = (st >> 1) * 16 + swz / 64; C = (st & 1) * 32 + (swz % 64) / 2; }
__host__ __device__ __forceinline__ int perm32(int rho) { const int n = rho >> 4, i = rho & 15; return 8 * (i >> 2) + 4 * n + (i & 3); }

struct Unit { int pm, pn; };
struct Gemm { const bf16_t* A; const bf16_t* Bt; int M, N, K; };

struct StaticOrder {
    int nM, nN, nwg, G, c;
    __host__ __device__ void init(int M, int N, int G_, int c_) { nM = M / BM; nN = N / BM; nwg = nM * nN; G = G_; c = c_; }
    __host__ __device__ bool next(int i, Unit& u) const {
        const long L = (long)i * G + c; if (L >= nwg) return false;
        int wgid = (int)L; { const int q = nwg / NXCD, r = nwg % NXCD, xcd = wgid % NXCD, off = wgid / NXCD; wgid = (xcd < r ? xcd * (q + 1) : r * (q + 1) + (xcd - r) * q) + off; }
        const int nig = WGM * nN, gid = wgid / nig, fm = gid * WGM, gsz = (nM - fm) < WGM ? (nM - fm) : WGM;
        u.pm = fm + ((wgid % nig) % gsz); u.pn = (wgid % nig) / gsz; return true;
    }
    __device__ __forceinline__ void a_ready(const Unit&) const {}
    __device__ __forceinline__ void done(const Unit&) const {}
};

__device__ __forceinline__ unsigned cvt_pk_bf16(float lo, float hi) { unsigned r; asm volatile("v_cvt_pk_bf16_f32 %0, %1, %2" : "=v"(r) : "v"(lo), "v"(hi)); return r; }
typedef float f32x2 __attribute__((ext_vector_type(2)));
template <class Epi, class Sched, bool ALIGN_EPI = false, bool SP2 = false>
__device__ __forceinline__ void gemm_phase(PG8_LAS unsigned char* lds, const Gemm g, const Sched& S, const Epi& E) {
    int tid_ = threadIdx.x; asm volatile("" : "+v"(tid_));
    const int tid = tid_, wid = __builtin_amdgcn_readfirstlane(tid >> 6), lane = tid & 63, wr = wid >> 2, wc = wid & 3, fr = lane & 15, fq = lane >> 4;
    const int K = g.K, nt = K / BK;
    unsigned voffA[2], voffB[2];
#pragma unroll
    for (int i = 0; i < 2; ++i) { int R, C; stage_rc(tid * 16 + i * 8192, R, C); const int Rb = Epi::PERM ? ((R & ~31) + perm32(R & 31)) : R;
        voffA[i] = (unsigned)(R * K + C) * 2u; voffB[i] = (unsigned)(Rb * K + C) * 2u; }
    const size_t kstep = (size_t)(BK * 2);
    const size_t hstep = (size_t)HALF * K * 2;
    const size_t tstep = 2 * hstep;
    const unsigned ldsw = (unsigned)wid * 1024u;
    const int aoff = lds_byte(wr * 64 + fr, fq * 8), boff = lds_byte(wc * 32 + fr, fq * 8);
#define PG8_SA(b, h) (((b) * 2 + (h)) * HTB)
#define PG8_SB(b, h) ((4 + (b) * 2 + (h)) * HTB)
#define PG8_STAGE(bufoff, gbase, voff) do { _Pragma("unroll") for (int _i = 0; _i < 2; ++_i) \
        __builtin_amdgcn_global_load_lds((const unsigned*)((const char*)(gbase) + (voff)[_i]), (PG8_LAS unsigned*)(lds + (bufoff) + ldsw + _i * 8192), 16, 0, 0); } while (0)
#define PG8_LDA(dst, b, h) do { _Pragma("unroll") for (int m = 0; m < 4; ++m) _Pragma("unroll") for (int k = 0; k < 2; ++k) dst[m][k] = *(const PG8_LAS bf16x8*)(lds + PG8_SA(b, h) + aoff + m * 2048 + k * 1024); } while (0)
#define PG8_LDB(dst, b, h) do { _Pragma("unroll") for (int n = 0; n < 2; ++n) _Pragma("unroll") for (int k = 0; k < 2; ++k) dst[n][k] = *(const PG8_LAS bf16x8*)(lds + PG8_SB(b, h) + boff + n * 2048 + k * 1024); } while (0)
#define PG8_MMA(ai, bj, At, Bt) do { __builtin_amdgcn_s_setprio(1); _Pragma("unroll") for (int m = 0; m < 4; ++m) _Pragma("unroll") for (int n = 0; n < 2; ++n) _Pragma("unroll") for (int k = 0; k < 2; ++k) \
        acc[ai][bj][m][n] = __builtin_amdgcn_mfma_f32_16x16x32_bf16(Bt[n][k], At[m][k], acc[ai][bj][m][n], 0, 0, 0); __builtin_amdgcn_s_setprio(0); } while (0)
#define PG8_WAIT_V(n) asm volatile("s_waitcnt vmcnt(" #n ")" ::: "memory")
#define PG8_WAIT_L(n) asm volatile("s_waitcnt lgkmcnt(" #n ")" ::: "memory")
#define PG8_BAR __builtin_amdgcn_s_barrier()
#define PG8_SCHED __builtin_amdgcn_sched_barrier(0)
    Unit cur, nxt; int ui = 0;
    if (!S.next(0, cur)) return;
    f32x4 acc[2][2][4][2];
#pragma unroll
    for (int a = 0; a < 2; ++a)
#pragma unroll
        for (int b = 0; b < 2; ++b)
#pragma unroll
            for (int m = 0; m < 4; ++m)
#pragma unroll
                for (int n = 0; n < 2; ++n) acc[a][b][m][n] = (f32x4){0.f, 0.f, 0.f, 0.f};
    bf16x8 At[4][2], B0[2][2], B1[2][2];
    const char* cA = (const char*)g.A + (size_t)cur.pm * tstep; const char* cB = (const char*)g.Bt + (size_t)cur.pn * tstep;
    S.a_ready(cur);
    if constexpr (SP2) {
        PG8_STAGE(PG8_SB(0, 0), cB, voffB); PG8_STAGE(PG8_SB(0, 1), cB + hstep, voffB); PG8_STAGE(PG8_SA(0, 0), cA, voffA); PG8_STAGE(PG8_SA(0, 1), cA + hstep, voffA);
        if (wr == 1) PG8_BAR;
        PG8_WAIT_V(2); PG8_BAR;
        PG8_STAGE(PG8_SB(1, 0), cB + kstep, voffB); PG8_STAGE(PG8_SA(1, 0), cA + kstep, voffA); PG8_STAGE(PG8_SB(1, 1), cB + hstep + kstep, voffB);
        PG8_WAIT_V(6); PG8_BAR;
    } else {
        PG8_STAGE(PG8_SB(0, 0), cB, voffB); PG8_STAGE(PG8_SA(0, 0), cA, voffA); PG8_STAGE(PG8_SB(0, 1), cB + hstep, voffB); PG8_STAGE(PG8_SA(0, 1), cA + hstep, voffA);
        if (wr == 1) PG8_BAR;
        PG8_WAIT_V(4); PG8_BAR;
        PG8_STAGE(PG8_SB(1, 0), cB + kstep, voffB); PG8_STAGE(PG8_SA(1, 0), cA + kstep, voffA); PG8_STAGE(PG8_SB(1, 1), cB + hstep + kstep, voffB);
        PG8_WAIT_V(6); PG8_BAR;
    }
    for (;;) {
        const bool has_next = S.next(ui + 1, nxt);
        const char* nA = has_next ? (const char*)g.A + (size_t)nxt.pm * tstep : cA; const char* nB = has_next ? (const char*)g.Bt + (size_t)nxt.pn * tstep : cB;
        for (int t = 0; t < nt; t += 2) {
            const bool last = (t == nt - 2);
            const char* a1 = cA + (size_t)(t + 1) * kstep;
            const char* a2 = last ? nA : cA + (size_t)(t + 2) * kstep; const char* b2 = last ? nB : cB + (size_t)(t + 2) * kstep;
            const char* a3 = a2 + kstep; const char* b3 = b2 + kstep;
            if (last && has_next) S.a_ready(nxt);
            if constexpr (SP2) {
            PG8_LDB(B0, 0, 0); PG8_LDB(B1, 0, 1); PG8_SCHED; PG8_LDA(At, 0, 0); PG8_STAGE(PG8_SA(1, 1), a1 + hstep, voffA);
            PG8_WAIT_V(8); PG8_WAIT_L(0); PG8_BAR; PG8_MMA(0, 0, At, B0); PG8_MMA(0, 1, At, B1); PG8_BAR; PG8_SCHED;
            PG8_LDA(At, 0, 1); PG8_STAGE(PG8_SB(0, 0), b2, voffB); PG8_STAGE(PG8_SB(0, 1), b2 + hstep, voffB); PG8_STAGE(PG8_SA(0, 0), a2, voffA);
            PG8_WAIT_V(8); PG8_WAIT_L(0); PG8_BAR; PG8_MMA(1, 0, At, B0); PG8_MMA(1, 1, At, B1); PG8_BAR; PG8_SCHED;
            PG8_LDB(B0, 1, 0); PG8_LDB(B1, 1, 1); PG8_SCHED; PG8_LDA(At, 1, 0); PG8_STAGE(PG8_SA(0, 1), a2 + hstep, voffA);
            PG8_WAIT_V(8); PG8_WAIT_L(0); PG8_BAR; PG8_MMA(0, 0, At, B0); PG8_MMA(0, 1, At, B1); PG8_BAR; PG8_SCHED;
            PG8_LDA(At, 1, 1); PG8_STAGE(PG8_SB(1, 0), b3, voffB); PG8_STAGE(PG8_SB(1, 1), b3 + hstep, voffB); PG8_STAGE(PG8_SA(1, 0), a3, voffA);
            PG8_WAIT_V(8); PG8_WAIT_L(0); PG8_BAR; PG8_MMA(1, 0, At, B0); PG8_MMA(1, 1, At, B1); PG8_BAR; PG8_SCHED;
            } else {
            PG8_LDB(B0, 0, 0); PG8_SCHED; PG8_LDA(At, 0, 0); PG8_STAGE(PG8_SA(1, 1), a1 + hstep, voffA);
            PG8_WAIT_L(8); PG8_BAR; PG8_WAIT_L(0); PG8_MMA(0, 0, At, B0); PG8_BAR; PG8_SCHED;
            PG8_LDB(B1, 0, 1); PG8_STAGE(PG8_SB(0, 0), b2, voffB);
            PG8_BAR; PG8_WAIT_L(0); PG8_MMA(0, 1, At, B1); PG8_BAR;
            PG8_LDA(At, 0, 1); PG8_STAGE(PG8_SA(0, 0), a2, voffA);
            PG8_BAR; PG8_WAIT_L(0); PG8_MMA(1, 0, At, B0); PG8_BAR; PG8_SCHED;
            PG8_STAGE(PG8_SB(0, 1), b2 + hstep, voffB);
            PG8_WAIT_V(6); PG8_BAR; PG8_MMA(1, 1, At, B1); PG8_BAR;
            PG8_LDB(B0, 1, 0); PG8_SCHED; PG8_LDA(At, 1, 0); PG8_STAGE(PG8_SA(0, 1), a2 + hstep, voffA);
            PG8_WAIT_L(8); PG8_BAR; PG8_WAIT_L(0); PG8_MMA(0, 0, At, B0); PG8_BAR; PG8_SCHED;
            PG8_LDB(B1, 1, 1); PG8_STAGE(PG8_SB(1, 0), b3, voffB);
            PG8_BAR; PG8_WAIT_L(0); PG8_MMA(0, 1, At, B1); PG8_BAR;
            PG8_LDA(At, 1, 1); PG8_STAGE(PG8_SA(1, 0), a3, voffA);
            PG8_BAR; PG8_WAIT_L(0); PG8_MMA(1, 0, At, B0); PG8_BAR; PG8_SCHED;
            PG8_STAGE(PG8_SB(1, 1), b3 + hstep, voffB);
            PG8_WAIT_V(6); PG8_BAR; PG8_MMA(1, 1, At, B1); PG8_BAR;
            }
        }
        if constexpr (ALIGN_EPI) { if (wr == 0) PG8_BAR; }
        if constexpr (!Epi::AFTER_DRAIN) { E(acc, cur, wr, wc, fr, fq); S.done(cur); }
        if (!has_next) break;
#pragma unroll
        for (int a = 0; a < 2; ++a)
#pragma unroll
            for (int b = 0; b < 2; ++b)
#pragma unroll
                for (int m = 0; m < 4; ++m)
#pragma unroll
                    for (int n = 0; n < 2; ++n) acc[a][b][m][n] = (f32x4){0.f, 0.f, 0.f, 0.f};
        cur = nxt; cA = nA; cB = nB; ++ui;
        if constexpr (ALIGN_EPI) { if (wr == 1) PG8_BAR; }
    }
    PG8_WAIT_V(0);
    if constexpr (!ALIGN_EPI) { if (wr == 0) PG8_BAR; }
    PG8_BAR;
    if constexpr (Epi::AFTER_DRAIN) { E.fused(acc, cur, wr, wc, fr, fq, lds, wid, lane); S.done(cur); }
#undef PG8_SA
#undef PG8_SB
#undef PG8_STAGE
#undef PG8_LDA
#undef PG8_LDB
#undef PG8_MMA
#undef PG8_WAIT_V
#undef PG8_WAIT_L
#undef PG8_BAR
#undef PG8_SCHED
}
}
#ifndef PG8_SP2
#define PG8_SP2 true
#endif
#ifndef PG8_ALIGN
#define PG8_ALIGN true
#endif
#include <hip/hip_bf16.h>
#include <cmath>
namespace attn_body {
using bf16=__hip_bfloat16;
using bf16x8=__attribute__((ext_vector_type(8)))short;
using s16x4=__attribute__((ext_vector_type(4)))short;
using f32x16=__attribute__((ext_vector_type(16)))float;
using u32x4=__attribute__((ext_vector_type(4)))unsigned;
constexpr int D=64,DM=1024;
constexpr int NW=8,QBLK=32,QB=QBLK*NW,KVBLK=64;
__device__ __forceinline__ int crow(int r,int hi){return (r&3)+8*(r>>2)+4*hi;}
#define SBAR() __builtin_amdgcn_sched_barrier(0)
constexpr int NSLOT=3, SLOTB=8192;
constexpr int LDS_K=0, LDS_V=NSLOT*SLOTB, LDS_WS=3*NSLOT*SLOTB, LDS_OST=LDS_WS+NW*64*4, LDS_BYTES=LDS_OST+NW*8192;
constexpr float C2=0.125f*1.4426950408889634f;
__device__ __forceinline__ void glds16(const void*gsrc,unsigned lds_dst){unsigned keep;
  asm volatile("s_mov_b32 %0, m0\n\ts_mov_b32 m0, %2\n\ts_nop 0\n\tglobal_load_lds_dwordx4 %1, off\n\ts_mov_b32 m0, %0":"=&s"(keep):"v"(gsrc),"s"(lds_dst):"memory");}
__device__ __forceinline__ float max3f(float a,float b,float c){float r;asm("v_max3_f32 %0, %1, %2, %3":"=v"(r):"v"(a),"v"(b),"v"(c));return r;}
__device__ __forceinline__ float max2f(float a,float b){float r;asm("v_max_f32_e32 %0, %1, %2":"=v"(r):"v"(a),"v"(b));return r;}
__device__ __forceinline__ float fadd_s(float a,float b){float r;asm("v_add_f32_e32 %0, %1, %2":"=v"(r):"v"(a),"v"(b));return r;}
__device__ __forceinline__ float fsub_s(float a,float b){float r;asm("v_sub_f32_e32 %0, %1, %2":"=v"(r):"v"(a),"v"(b));return r;}
typedef float f32x2_t __attribute__((ext_vector_type(2))); typedef __bf16 bf16x2_t __attribute__((ext_vector_type(2)));
__device__ __forceinline__ unsigned cvtpk_s(float lo,float hi){f32x2_t v={lo,hi};bf16x2_t b=__builtin_convertvector(v,bf16x2_t);return __builtin_bit_cast(unsigned,b);}
#define WAIT_BAR(N) asm volatile("s_waitcnt vmcnt(" #N ") lgkmcnt(0)\n\ts_barrier":::"memory")

__device__ __forceinline__ void qkt(f32x16&p0,f32x16&p1,const char*Kslot,const bf16x8*qr,int r32,int hi){ const f32x16 negm=f32x16{};
  const char*kb=Kslot+hi*1024+r32*16;
  #pragma unroll
  for(int d0=0;d0<4;++d0){
    const bf16x8 b0=*reinterpret_cast<const bf16x8*>(kb+d0*2048);
    const bf16x8 b1=*reinterpret_cast<const bf16x8*>(kb+d0*2048+512);
    if(d0==0){p0=__builtin_amdgcn_mfma_f32_32x32x16_bf16(b0,qr[0],negm,0,0,0);p1=__builtin_amdgcn_mfma_f32_32x32x16_bf16(b1,qr[0],negm,0,0,0);}
    else{p0=__builtin_amdgcn_mfma_f32_32x32x16_bf16(b0,qr[d0],p0,0,0,0);p1=__builtin_amdgcn_mfma_f32_32x32x16_bf16(b1,qr[d0],p1,0,0,0);}}
}
typedef __attribute__((address_space(3))) const char* lds_cptr;
typedef short v4i16_t __attribute__((ext_vector_type(4)));
__device__ __forceinline__ void kload8(bf16x8*kf,lds_cptr kp){
  kf[0]=*(const __attribute__((address_space(3))) bf16x8*)(kp);      kf[1]=*(const __attribute__((address_space(3))) bf16x8*)(kp+512);
  kf[2]=*(const __attribute__((address_space(3))) bf16x8*)(kp+2048); kf[3]=*(const __attribute__((address_space(3))) bf16x8*)(kp+2560);
  kf[4]=*(const __attribute__((address_space(3))) bf16x8*)(kp+4096); kf[5]=*(const __attribute__((address_space(3))) bf16x8*)(kp+4608);
  kf[6]=*(const __attribute__((address_space(3))) bf16x8*)(kp+6144); kf[7]=*(const __attribute__((address_space(3))) bf16x8*)(kp+6656);
}
__device__ __forceinline__ void kload2(bf16x8*kf,lds_cptr kp,int j){ kf[2*j]=*(const __attribute__((address_space(3))) bf16x8*)(kp+j*2048); kf[2*j+1]=*(const __attribute__((address_space(3))) bf16x8*)(kp+j*2048+512); }
__device__ __forceinline__ s16x4 vtr(lds_cptr p){ return __builtin_bit_cast(s16x4,__builtin_amdgcn_ds_read_tr16_b64_v4i16((__attribute__((address_space(3))) v4i16_t*)p)); }
__device__ __forceinline__ float rowmax(const f32x16&p0,const f32x16&p1){
  float a=max3f(p0[0],p0[1],p1[0]),b=max3f(p0[2],p0[3],p1[1]);a=max3f(a,p1[2],p1[3]);
  #pragma unroll
  for(int r=4;r<16;r+=4){a=max3f(a,p0[r],p0[r+1]);b=max3f(b,p0[r+2],p0[r+3]);a=max3f(a,p1[r],p1[r+1]);b=max3f(b,p1[r+2],p1[r+3]);}
  const float m=max2f(a,b);
  auto rr=__builtin_amdgcn_permlane32_swap(__float_as_uint(m),__float_as_uint(m),false,false);
  return max2f(__uint_as_float(rr[0]),__uint_as_float(rr[1]));
}
__device__ __forceinline__ void pv(f32x16*o,int vb,bf16x8 pa0,bf16x8 pa1,bf16x8 pa2,bf16x8 pa3){
  #pragma unroll
  for(int d0=0;d0<4;++d0){s16x4 lo[4],hi[4];
    #pragma unroll
    for(int ks=0;ks<4;++ks){
      asm volatile("ds_read_b64_tr_b16 %0,%1 offset:%c2":"=&v"(lo[ks]):"v"(vb),"i"(d0*4096+ks*1024):"memory");
      asm volatile("ds_read_b64_tr_b16 %0,%1 offset:%c2":"=&v"(hi[ks]):"v"(vb),"i"(d0*4096+ks*1024+512):"memory");}
    asm volatile("s_waitcnt lgkmcnt(0)":::"memory");SBAR();
    #define PK(k) (bf16x8){lo[k][0],lo[k][1],lo[k][2],lo[k][3],hi[k][0],hi[k][1],hi[k][2],hi[k][3]}
    o[d0]=__builtin_amdgcn_mfma_f32_32x32x16_bf16(pa0,PK(0),o[d0],0,0,0);
    o[d0]=__builtin_amdgcn_mfma_f32_32x32x16_bf16(pa1,PK(1),o[d0],0,0,0);
    o[d0]=__builtin_amdgcn_mfma_f32_32x32x16_bf16(pa2,PK(2),o[d0],0,0,0);
    o[d0]=__builtin_amdgcn_mfma_f32_32x32x16_bf16(pa3,PK(3),o[d0],0,0,0);
    #undef PK
  }
}

#ifndef ATTN_STORE16
#define ATTN_STORE16(p,v) (*(u32x4*)(p)=(v))
#endif
template<int THRL> __device__ __forceinline__ void attn_unit(const bf16*Qp,const bf16*__restrict__ Kh,const bf16*__restrict__ Vh,bf16*Op,const int q0,const int NT,char*shm){
  int tid_=threadIdx.x; asm volatile("":"+v"(tid_));
  const int tid=tid_,lane=tid&63,r32=lane&31,hi=lane>>5; const int wid=__builtin_amdgcn_readfirstlane(tid>>6);
  const bf16*Qw=Qp+(long)(q0+wid*QBLK)*DM;
  const unsigned lds0=(unsigned)(uintptr_t)shm;
  float*wsf=(float*)(shm+LDS_WS)+wid*64;
  const bf16*ksrc=Kh+(long)lane*DM+wid*8;
  const bf16*vsrc=Vh+(long)(16*(wid&3)+(lane>>2))*DM+(wid>>2)*32+(lane&3)*8;
  const unsigned kdst=lds0+LDS_K+wid*1024, vdst=lds0+LDS_V+wid*1024;
  #define DMA_K(t,slot) glds16(ksrc+(long)(t)*KVBLK*DM,(unsigned)__builtin_amdgcn_readfirstlane(kdst+(slot)))
  #define DMA_V(t,slot) do{ glds16(vsrc+(long)(t)*KVBLK*DM,(unsigned)__builtin_amdgcn_readfirstlane(vdst+2*(slot))); glds16(vsrc+(long)(t)*KVBLK*DM+64,(unsigned)__builtin_amdgcn_readfirstlane(vdst+2*(slot)+8192)); }while(0)
  const int vb0=(int)(lds0+LDS_V)+((lane>>4)&1)*32+(lane&3)*8+(4*hi+((lane&15)>>2))*64;
  const char*Kbase=shm+LDS_K; bf16x8 kf[8];
  const lds_cptr shm3=(lds_cptr)shm; const lds_cptr kp0=shm3+LDS_K+hi*1024+r32*16; const lds_cptr vp0=shm3+LDS_V+((lane>>4)&1)*32+(lane&3)*8+(4*hi+((lane&15)>>2))*64;
  DMA_K(0,0);DMA_V(0,0);DMA_K(1,SLOTB);
  bf16x8 qr[4];
  #pragma unroll
  for(int d0=0;d0<4;++d0)qr[d0]=*reinterpret_cast<const bf16x8*>(&Qw[(long)r32*DM+d0*16+hi*8]);
  float mhat=0.f,l_reg=0.f;f32x16 o[4];o[0]=f32x16{};o[1]=f32x16{};o[2]=f32x16{};o[3]=f32x16{};
  #define CMASK(P0,P1,t) do{}while(0)
  bool resc=false;
  #define START(P0,P1) do{ const float rm=rowmax(P0,P1); resc=false; \
    { const float dl=rm; mhat=fadd_s(mhat,dl); \
      _Pragma("unroll") for(int r=0;r<16;++r){P0[r]=fsub_s(P0[r],dl);P1[r]=fsub_s(P1[r],dl);} } \
    _Pragma("unroll") for(int r=0;r<16;++r)P0[r]=__builtin_amdgcn_exp2f(P0[r]); }while(0)
  #define RESC() do{ if(resc){ asm volatile("s_waitcnt lgkmcnt(0)":::"memory"); \
      _Pragma("unroll") for(int d_=0;d_<4;++d_) _Pragma("unroll") for(int r=0;r<16;++r)o[d_][r]*=wsf[crow(r,hi)]; } }while(0)
  f32x16 pA0,pA1,pB0,pB1;
  int sl_prev=0,sl_cur=0,sl_next=SLOTB;
  #define ROT() do{sl_prev=sl_cur;sl_cur=sl_next;sl_next=(sl_next==(NSLOT-1)*SLOTB)?0:sl_next+SLOTB;}while(0)
  DMA_K(2,2*SLOTB);
  WAIT_BAR(4);
  qkt(pA0,pA1,Kbase,qr,r32,hi);asm volatile("s_nop 15\n\ts_nop 7":"+v"(pA0),"+v"(pA1));CMASK(pA0,pA1,0);
  START(pA0,pA1);
  _Pragma("unroll") for(int r=0;r<16;++r)pA1[r]=__builtin_amdgcn_exp2f(pA1[r]);
  WAIT_BAR(0);
  DMA_K(3,0);DMA_V(1,SLOTB);
  ROT();
  kload8(kf,kp0+sl_cur);
  WAIT_BAR(3);
  s16x4 vlo[8],vhi[8]; u32x4 pw0,pw1,pw2,pw3;
  #define PKW(P,B) cvtpk_s(P[B],P[B+1])
  #define PAF(k) __builtin_bit_cast(bf16x8,pw##k)
  #define VFR(i) (bf16x8){vlo[i][0],vlo[i][1],vlo[i][2],vlo[i][3],vhi[i][0],vhi[i][1],vhi[i][2],vhi[i][3]}
  #define PIN(x) asm volatile("":"+v"(x))
  #define MX3(a,b,c) __builtin_fmaxf(__builtin_fmaxf((a),(b)),(c))
  #define GAPA(MF,A0,A1,A2,A3,W0,W1,PW) do{ MF; sacc+=A0; sacc+=A1; sacc+=A2; sacc+=A3; PIN(sacc); W0; W1; PIN(PW); SBAR(); }while(0)
  #define EX(v) __builtin_amdgcn_exp2f(v)
  #define GAPB(MF,X,B) do{ MF; X[B]=EX(X[B]-mhat); X[B+1]=EX(X[B+1]-mhat); PIN(X); SBAR(); }while(0)
  #define VRD2(i) do{ vlo[i]=vtr(vp_+(8192+((i)>>2)*4096+((i)&3)*1024)); vhi[i]=vtr(vp_+(8192+((i)>>2)*4096+((i)&3)*1024+512)); SBAR(); }while(0)
  #define VRD(i) do{ vlo[i]=vtr(vp_+(((i)>>2)*4096+((i)&3)*1024)); vhi[i]=vtr(vp_+(((i)>>2)*4096+((i)&3)*1024+512)); }while(0)
  #define KRD(G,j) do{ if(G){ kload2(kf,kp0+sl_next,j); SBAR(); } }while(0)
  #define STEP(C0,C1,P0,P1,t,GK,GV,GL) do{ SBAR(); \
    const lds_cptr vp_=vp0+2*sl_prev; \
    VRD(0); SBAR(); float sacc=(P0[0]+P0[1]); \
    GAPA(C0=__builtin_amdgcn_mfma_f32_32x32x16_bf16(kf[0],qr[0],f32x16{},0,0,0), P0[2],P0[3],P0[4],P0[5],     pw0[0]=PKW(P0,0), pw0[1]=PKW(P0,2), pw0); \
    VRD(4); SBAR(); GAPA(C1=__builtin_amdgcn_mfma_f32_32x32x16_bf16(kf[1],qr[0],f32x16{},0,0,0), P0[6],P0[7],P0[8],P0[9],     pw0[2]=PKW(P0,4), pw0[3]=PKW(P0,6), pw0); \
    VRD(1); SBAR(); GAPA(C0=__builtin_amdgcn_mfma_f32_32x32x16_bf16(kf[2],qr[1],C0,0,0,0),   P0[10],P0[11],P0[12],P0[13], pw1[0]=PKW(P0,8), pw1[1]=PKW(P0,10), pw1); \
    VRD(5); SBAR(); GAPA(C1=__builtin_amdgcn_mfma_f32_32x32x16_bf16(kf[3],qr[1],C1,0,0,0),   P0[14],P0[15],P1[0],P1[1],   pw1[2]=PKW(P0,12),pw1[3]=PKW(P0,14), pw1); \
    VRD(2); SBAR(); GAPA(C0=__builtin_amdgcn_mfma_f32_32x32x16_bf16(kf[4],qr[2],C0,0,0,0),   P1[2],P1[3],P1[4],P1[5],     pw2[0]=PKW(P1,0), pw2[1]=PKW(P1,2), pw2); \
    VRD(6); SBAR(); GAPA(C1=__builtin_amdgcn_mfma_f32_32x32x16_bf16(kf[5],qr[2],C1,0,0,0),   P1[6],P1[7],P1[8],P1[9],     pw2[2]=PKW(P1,4), pw2[3]=PKW(P1,6), pw2); \
    VRD(3); SBAR(); GAPA(C0=__builtin_amdgcn_mfma_f32_32x32x16_bf16(kf[6],qr[3],C0,0,0,0),   P1[10],P1[11],P1[12],P1[13], pw3[0]=PKW(P1,8), pw3[1]=PKW(P1,10), pw3); \
    VRD(7); SBAR(); GAPA(C1=__builtin_amdgcn_mfma_f32_32x32x16_bf16(kf[7],qr[3],C1,0,0,0),   P1[14],P1[15],0.f,0.f,       pw3[2]=PKW(P1,12),pw3[3]=PKW(P1,14), pw3); \
    l_reg+=sacc; \
    if(GK){DMA_K((t)+3,sl_cur);} if(GV){DMA_V((t)+1,sl_next);} \
    CMASK(C0,C1,t); \
    { float a=MX3(C0[0],C0[1],C1[0]),b=MX3(C0[2],C0[3],C1[1]); a=MX3(a,C1[2],C1[3]); \
      _Pragma("unroll") for(int r=4;r<16;r+=4){a=MX3(a,C0[r],C0[r+1]);b=MX3(b,C0[r+2],C0[r+3]);a=MX3(a,C1[r],C1[r+1]);b=MX3(b,C1[r+2],C1[r+3]);} \
      float rm=__builtin_fmaxf(a,b); { auto rr=__builtin_amdgcn_permlane32_swap(__float_as_uint(rm),__float_as_uint(rm),false,false); rm=__builtin_fmaxf(__uint_as_float(rr[0]),__uint_as_float(rr[1])); } \
      resc=false; \
      rm-=mhat; \
      if(__builtin_expect(__any(rm>(float)THRL),0)){ const float dl=__builtin_fmaxf(rm,0.f); mhat+=dl; \
        const float f=__builtin_amdgcn_exp2f(-dl); l_reg*=f; if(hi==0)wsf[r32]=f; resc=true; } } \
    SBAR(); \
    GAPB(o[0]=__builtin_amdgcn_mfma_f32_32x32x16_bf16(PAF(0),VFR(0),o[0],0,0,0), C0,0);  VRD2(0); \
    GAPB(o[1]=__builtin_amdgcn_mfma_f32_32x32x16_bf16(PAF(0),VFR(4),o[1],0,0,0), C0,2);  VRD2(4); \
    KRD(GL,0); GAPB(o[0]=__builtin_amdgcn_mfma_f32_32x32x16_bf16(PAF(1),VFR(1),o[0],0,0,0), C0,4);  VRD2(1); \
    KRD(GL,1); GAPB(o[1]=__builtin_amdgcn_mfma_f32_32x32x16_bf16(PAF(1),VFR(5),o[1],0,0,0), C0,6);  VRD2(5); \
    KRD(GL,2); GAPB(o[0]=__builtin_amdgcn_mfma_f32_32x32x16_bf16(PAF(2),VFR(2),o[0],0,0,0), C0,8);  VRD2(2); \
    KRD(GL,3); GAPB(o[1]=__builtin_amdgcn_mfma_f32_32x32x16_bf16(PAF(2),VFR(6),o[1],0,0,0), C0,10); VRD2(6); \
    GAPB(o[0]=__builtin_amdgcn_mfma_f32_32x32x16_bf16(PAF(3),VFR(3),o[0],0,0,0), C0,12); VRD2(3); \
    GAPB(o[1]=__builtin_amdgcn_mfma_f32_32x32x16_bf16(PAF(3),VFR(7),o[1],0,0,0), C0,14); VRD2(7); \
    GAPB(o[2]=__builtin_amdgcn_mfma_f32_32x32x16_bf16(PAF(0),VFR(0),o[2],0,0,0), C1,0); \
    GAPB(o[3]=__builtin_amdgcn_mfma_f32_32x32x16_bf16(PAF(0),VFR(4),o[3],0,0,0), C1,2); \
    GAPB(o[2]=__builtin_amdgcn_mfma_f32_32x32x16_bf16(PAF(1),VFR(1),o[2],0,0,0), C1,4); \
    GAPB(o[3]=__builtin_amdgcn_mfma_f32_32x32x16_bf16(PAF(1),VFR(5),o[3],0,0,0), C1,6); \
    GAPB(o[2]=__builtin_amdgcn_mfma_f32_32x32x16_bf16(PAF(2),VFR(2),o[2],0,0,0), C1,8); \
    GAPB(o[3]=__builtin_amdgcn_mfma_f32_32x32x16_bf16(PAF(2),VFR(6),o[3],0,0,0), C1,10); \
    GAPB(o[2]=__builtin_amdgcn_mfma_f32_32x32x16_bf16(PAF(3),VFR(3),o[2],0,0,0), C1,12); \
    GAPB(o[3]=__builtin_amdgcn_mfma_f32_32x32x16_bf16(PAF(3),VFR(7),o[3],0,0,0), C1,14); \
    }while(0)
  int t=1;
  #undef CMASK
  #define CMASK(P0,P1,t) do{}while(0)
  for(;t+5<NT;t+=2){
    STEP(pB0,pB1,pA0,pA1,t,true,true,true);     WAIT_BAR(3); RESC(); ROT();
    STEP(pA0,pA1,pB0,pB1,t+1,true,true,true);   WAIT_BAR(3); RESC(); ROT();
  }
  #undef CMASK
  #define CMASK(P0,P1,t) do{}while(0)
  #define ENDW(tt) do{ if((tt)+3<NT){WAIT_BAR(3);} else if((tt)+2<NT){WAIT_BAR(2);} else {WAIT_BAR(0);} }while(0)
  for(;t+1<NT;t+=2){
    STEP(pB0,pB1,pA0,pA1,t,(t+3<NT),(t+1<NT),(t+1<NT));       ENDW(t);   RESC(); ROT();
    STEP(pA0,pA1,pB0,pB1,t+1,(t+4<NT),(t+2<NT),(t+2<NT));     ENDW(t+1); RESC(); ROT();
  }
  STEP(pB0,pB1,pA0,pA1,NT-1,false,false,false); RESC();
  { float sacc=pB0[0]+pB0[1]; _Pragma("unroll") for(int r=2;r<16;++r)sacc+=pB0[r]; _Pragma("unroll") for(int r=0;r<16;++r)sacc+=pB1[r]; l_reg+=sacc;
    pw0=(u32x4){PKW(pB0,0),PKW(pB0,2),PKW(pB0,4),PKW(pB0,6)};pw1=(u32x4){PKW(pB0,8),PKW(pB0,10),PKW(pB0,12),PKW(pB0,14)};pw2=(u32x4){PKW(pB1,0),PKW(pB1,2),PKW(pB1,4),PKW(pB1,6)};pw3=(u32x4){PKW(pB1,8),PKW(pB1,10),PKW(pB1,12),PKW(pB1,14)};
    SBAR(); pv(o,vb0+2*sl_cur,PAF(0),PAF(1),PAF(2),PAF(3)); }
  #undef PKW
  #undef PAF
  #undef VFR
  #undef PIN
  #undef MX3
  #undef GAPA
  #undef GAPB
  #undef EX
  #undef VRD
  #undef VRD2
  #undef KRD
  #undef STEP
  #undef ENDW
  {auto rr=__builtin_amdgcn_permlane32_swap(__float_as_uint(l_reg),__float_as_uint(l_reg),false,false);l_reg=__uint_as_float(rr[0])+__uint_as_float(rr[1]);}
  if(hi==0)wsf[32+r32]=l_reg;asm volatile("s_waitcnt lgkmcnt(0)":::"memory");
  float rli[16];
  #pragma unroll
  for(int r=0;r<16;++r)rli[r]=__builtin_amdgcn_rcpf(wsf[32+crow(r,hi)]);
  bf16*Ow=Op+(long)(q0+wid*QBLK)*DM;
  { bf16*stg=(bf16*)(shm+LDS_OST)+wid*4096;
    #pragma unroll
    for(int r=0;r<16;++r){const int orow=crow(r,hi);
      #pragma unroll
      for(int d0=0;d0<4;++d0)stg[orow*128+d0*32+r32]=__float2bfloat16(o[d0][r]*rli[r]);}
    asm volatile("s_waitcnt lgkmcnt(0)":::"memory");
    #pragma unroll
    for(int i=0;i<8;++i){const int row=i*4+(lane>>4),ch=lane&15; const u32x4 v=*(const u32x4*)(stg+row*128+ch*8); ATTN_STORE16(Ow+(long)row*DM+ch*8,v);} }
  asm volatile("s_waitcnt lgkmcnt(0)\n\ts_barrier":::"memory");
  #undef DMA_K
  #undef DMA_V
  #undef CMASK
  #undef START
  #undef RESC
  #undef ROT
}
constexpr int ATTN_LDS_BYTES=LDS_BYTES;
#undef SBAR
#undef WAIT_BAR
}

#define GAS __attribute__((address_space(1)))
#define LAS __attribute__((address_space(3)))
typedef unsigned short bf16;
typedef unsigned v4u __attribute__((ext_vector_type(4)));
typedef unsigned v2u __attribute__((ext_vector_type(2)));
typedef float f32x4 __attribute__((ext_vector_type(4)));
typedef float f32x16 __attribute__((ext_vector_type(16)));
typedef short bf16x8 __attribute__((ext_vector_type(8)));
typedef short s16x4 __attribute__((ext_vector_type(4)));
#define LDS_WAIT() asm volatile("s_waitcnt lgkmcnt(0)" ::: "memory")

constexpr int DMODEL = 1024, NIN = 9728, FFH = 2816;
constexpr int S_P = 4096, S_S = 2048;
constexpr int CT = 32768, NCHUNK = 3;
constexpr float EPS = 1e-6f;
constexpr float C2 = 0.18033688011112042f;
constexpr int LDS_BYTES = 147456;
constexpr int NWAVES = 8;

constexpr size_t MiB = 1u << 20;
constexpr size_t WS_MOD = 1 * MiB, WS_ROPE = 2 * MiB;
constexpr size_t WS_WIN = 4 * MiB, WS_WA = 23 * MiB, WS_WB = 25 * MiB, WS_WOUT = 26 * MiB, WS_WGU = 28 * MiB, WS_WDN = 39 * MiB;
constexpr size_t WS_H = 48 * MiB;
constexpr size_t WS_QA = 112 * MiB, WS_KA = 176 * MiB, WS_VA = 240 * MiB, WS_G0 = 304 * MiB  , WS_G1 = 592 * MiB, WS_G2 = 656 * MiB;
constexpr size_t WS_O1 = 720 * MiB, WS_O2 = 784 * MiB, WS_OG = 848 * MiB  , WS_LSE = 944 * MiB  , WS_END = 948 * MiB;
constexpr size_t WS_OA = WS_QA, WS_OB = WS_G0, WS_MRG = WS_KA, WS_ACT = WS_VA, WS_X1 = WS_QA  , WS_X2 = WS_KA  ;

struct Args {
    const float *x_prompt, *x_sample, *c_prompt, *c_sample, *w_ada, *b_ada, *g_mix, *w_in, *lq1, *lk1, *lq2, *lk2, *g_subln, *w_a, *w_b, *w_out, *g_ffn, *w_gu, *w_down, *g_final;
    float* out; unsigned char* ws;
};

typedef const __attribute__((address_space(4))) Args* CArgs;
__device__ __forceinline__ CArgs argp() { CArgs p = (CArgs)__builtin_amdgcn_kernarg_segment_ptr(); asm volatile("" : "+s"(p)); return p; }

__device__ __forceinline__ float wave_sum(float v) {
#pragma unroll
    for (int o = 1; o < 64; o <<= 1) v += __shfl_xor(v, o);
    return v;
}
__device__ __forceinline__ unsigned f2bf(float f) { unsigned u = __builtin_bit_cast(unsigned, f); return (u + 0x7fffu + ((u >> 16) & 1u)) >> 16; }
__device__ __forceinline__ unsigned pk2(float lo, float hi) { return f2bf(lo) | (f2bf(hi) << 16); }
__device__ __forceinline__ float bflo(unsigned w) { return __builtin_bit_cast(float, w << 16); }
__device__ __forceinline__ float bfhi(unsigned w) { return __builtin_bit_cast(float, w & 0xffff0000u); }

__device__ __forceinline__ int maprow(int mode, int n) {
    if (mode == 1) {
        const bool qk = (n < 2048) || (n >= 3072 && n < 7680 && ((n - 3072) % 1536) < 1024);
        const int i = n & 63;
        if (qk && i < 16) return n - i + ((i < 8) ? 2 * i : 2 * (i - 8) + 1);
        return n;
    }
    if (mode == 2) {
        const bool up = n >= FFH; const int j = up ? n - FFH : n;
        return 8 * (j >> 2) + (j & 3) + (up ? 4 : 0);
    }
    return n;
}
__device__ __forceinline__ void p0_transpose_item(const float* W, int K, int N, bf16* WT, int mode, LAS float* scr, int item, int lane) {
    const int nblk = N / 32, kb = item / nblk, nb = item % nblk, k0 = 64 * kb, n0 = 32 * nb;
#pragma unroll 8
    for (int i = 0; i < 32; ++i) { const int kk = 2 * i + (lane >> 5); scr[kk * 33 + (lane & 31)] = W[(size_t)(k0 + kk) * N + n0 + (lane & 31)]; }
    LDS_WAIT(); asm volatile("" ::: "memory");
    const int c = lane & 7;
#pragma unroll
    for (int j = 0; j < 4; ++j) { const int n = (lane >> 3) + 8 * j; const LAS float* s = scr + (8 * c) * 33 + n;
        v4u o; o.x = pk2(s[0 * 33], s[1 * 33]); o.y = pk2(s[2 * 33], s[3 * 33]); o.z = pk2(s[4 * 33], s[5 * 33]); o.w = pk2(s[6 * 33], s[7 * 33]);
        *(GAS v4u*)(WT + (size_t)maprow(mode, n0 + n) * K + k0 + 8 * c) = o; }
    LDS_WAIT(); asm volatile("" ::: "memory");
}
__constant__ double ROPE_INVREV[8] = {0.15915494309189535, 0.03086376340470123, 0.005985185712713705, 0.001160663641240061,
                                      0.00022507907903927653, 4.364795279280289e-05, 8.464330808241401e-06, 1.6414262627950345e-06};

__device__ __forceinline__ void p0_prologue(LAS unsigned char* lds, int tid, int lane, int wave, int vcu, int G) {
    CArgs ap = argp(); unsigned char* ws = ap->ws;
    LAS float* scr = (LAS float*)(lds + wave * 16384);
    const int gw = vcu * NWAVES + wave, NGW = G * NWAVES;
    constexpr int I_IN = 16 * (NIN / 32), I_A = 16 * 32, I_B = 8 * 32, I_O = 16 * 32, I_GU = 16 * (2 * FFH / 32), I_DN = (FFH / 64) * 32;
    constexpr int NITEMS = I_IN + I_A + I_B + I_O + I_GU + I_DN;
    for (int it = gw; it < NITEMS; it += NGW) {
        int r = it;
        if (r < I_IN) { p0_transpose_item(ap->w_in, 1024, NIN, (bf16*)(ws + WS_WIN), 1, scr, r, lane); continue; } r -= I_IN;
        if (r < I_A) { p0_transpose_item(ap->w_a, 1024, 1024, (bf16*)(ws + WS_WA), 0, scr, r, lane); continue; } r -= I_A;
        if (r < I_B) { p0_transpose_item(ap->w_b, 512, 1024, (bf16*)(ws + WS_WB), 0, scr, r, lane); continue; } r -= I_B;
        if (r < I_O) { p0_transpose_item(ap->w_out, 1024, 1024, (bf16*)(ws + WS_WOUT), 0, scr, r, lane); continue; } r -= I_O;
        if (r < I_GU) { p0_transpose_item(ap->w_gu, 1024, 2 * FFH, (bf16*)(ws + WS_WGU), 2, scr, r, lane); continue; } r -= I_GU;
        p0_transpose_item(ap->w_down, FFH, 1024, (bf16*)(ws + WS_WDN), 0, scr, r, lane);
    }
    for (int idx = blockIdx.x * 512 + tid; idx < 4096 * 8; idx += G * 512) {
        const int pos = idx >> 3, i = idx & 7;
        const double rev = (double)pos * ROPE_INVREV[i]; const float fr = (float)(rev - __builtin_floor(rev));
        float2 cs; cs.x = __builtin_amdgcn_cosf(fr); cs.y = __builtin_amdgcn_sinf(fr);
        ((float2*)(ws + WS_ROPE))[idx] = cs;
    }
    __syncthreads();
    const int bx = blockIdx.x;
    if (bx < 192) {
        const int n0 = bx * 32, b = lane & 31, h = lane >> 5;
        const float* crow_ = (b < 16) ? ap->c_prompt + (size_t)b * 1024 : ap->c_sample + (size_t)(b - 16) * 1024;
        f32x16 acc = {};
#pragma unroll 4
        for (int i = 0; i < 16; ++i) {
            const int k = 128 * wave + 8 * i + 4 * h;
            const f32x4 c4 = *(const f32x4*)(crow_ + k);
#pragma unroll
            for (int e = 0; e < 4; ++e) {
                const float cv = c4[e], sv = cv / (1.f + __expf(-cv));
                const float wv = ap->w_ada[(size_t)(k + e) * 6144 + n0 + (lane & 31)];
                acc = __builtin_amdgcn_mfma_f32_32x32x2f32(sv, wv, acc, 0, 0, 0);
            }
        }
        LAS float* red = (LAS float*)lds;
#pragma unroll
        for (int r = 0; r < 16; ++r) red[(wave * 16 + r) * 64 + lane] = acc[r];
        __syncthreads();
#pragma unroll
        for (int j = 0; j < 2; ++j) {
            const int o = tid + 512 * j, nn = o & 31, bb = o >> 5;
            const int hh = (bb >> 2) & 1, r = (bb & 3) + 4 * (bb >> 3), ln = nn + 32 * hh;
            float s = ap->b_ada[n0 + nn];
#pragma unroll
            for (int w = 0; w < 8; ++w) s += red[(w * 16 + r) * 64 + ln];
            ((float*)(ws + WS_MOD))[(size_t)bb * 6144 + n0 + nn] = s;
        }
    }
    __syncthreads();
}

__device__ __forceinline__ f32x4 ld4(const float* p) { return *(const GAS f32x4*)p; }
__device__ __forceinline__ f32x4 ld4(const bf16* p) { const v2u w = *(const GAS v2u*)p; return (f32x4){bflo(w.x), bfhi(w.x), bflo(w.y), bfhi(w.y)}; }
template <class T> __device__ __forceinline__ void rows_norm_mod(const T* xsrc, bf16* dst, const float* gain, const float* mod, int sh_idx, int sc_idx, int S, int b0, int gw, int NGW, int lane) {
    f32x4 g[4];
#pragma unroll
    for (int j = 0; j < 4; ++j) g[j] = *(const f32x4*)(gain + 4 * lane + 256 * j);
    for (int row = gw; row < CT; row += NGW) {
        const int b = b0 + row / S;
        const T* xr = xsrc + (size_t)row * 1024 + 4 * lane;
        f32x4 v[4]; float ss = 0.f;
#pragma unroll
        for (int j = 0; j < 4; ++j) { v[j] = ld4(xr + 256 * j); ss += (v[j].x * v[j].x + v[j].y * v[j].y) + (v[j].z * v[j].z + v[j].w * v[j].w); }
        const float rstd = 1.f / sqrtf(wave_sum(ss) * (1.f / 1024.f) + EPS);
        const float* mb = mod + (size_t)b * 6144;
        GAS unsigned long long* o8 = (GAS unsigned long long*)(dst + (size_t)row * 1024) + lane;
#pragma unroll
        for (int j = 0; j < 4; ++j) {
            const f32x4 sc = *(const f32x4*)(mb + sc_idx * 1024 + 4 * lane + 256 * j), sh = *(const f32x4*)(mb + sh_idx * 1024 + 4 * lane + 256 * j);
            const f32x4 h = v[j] * rstd * g[j] * (1.f + sc) + sh;
            o8[64 * j] = (unsigned long long)pk2(h.x, h.y) | ((unsigned long long)pk2(h.z, h.w) << 32);
        }
    }
}
__device__ __forceinline__ void rows_final_norm(const bf16* x2, float* out, const float* gain, int gw, int NGW, int lane) {
    f32x4 g[4];
#pragma unroll
    for (int j = 0; j < 4; ++j) g[j] = *(const f32x4*)(gain + 4 * lane + 256 * j);
    for (int row = gw; row < CT; row += NGW) {
        const bf16* xr = x2 + (size_t)row * 1024 + 4 * lane;
        GAS f32x4* orow = (GAS f32x4*)(out + (size_t)row * 1024) + lane;
        f32x4 v[4]; float ss = 0.f;
#pragma unroll
        for (int j = 0; j < 4; ++j) { v[j] = ld4(xr + 256 * j); ss += (v[j].x * v[j].x + v[j].y * v[j].y) + (v[j].z * v[j].z + v[j].w * v[j].w); }
        const float rstd = 1.f / sqrtf(wave_sum(ss) * (1.f / 1024.f) + EPS);
#pragma unroll
        for (int j = 0; j < 4; ++j) orow[64 * j] = v[j] * rstd * g[j];
    }
}
__device__ __forceinline__ void rows_combine(int gw, int NGW, int lane) {
    CArgs ap = argp(); unsigned char* ws = ap->ws;
    const float e1 = __expf(wave_sum(ap->lq1[lane] * ap->lk1[lane])), e2 = __expf(wave_sum(ap->lq2[lane] * ap->lk2[lane]));
    const float lam = e1 - e2 + 0.2f;
    f32x4 gs[4];
#pragma unroll
    for (int j = 0; j < 4; ++j) gs[j] = *(const f32x4*)(ap->g_subln + ((16 * lane) & 127) + 4 * j) * 0.8f;
    const bf16* O1 = (const bf16*)(ws + WS_O1); const bf16* O2 = (const bf16*)(ws + WS_O2); bf16* OA = (bf16*)(ws + WS_OA);
    const bf16* OG = (const bf16*)(ws + WS_OG); const float* LSE = (const float*)(ws + WS_LSE); bf16* OB = (bf16*)(ws + WS_OB);
    for (int row = gw; row < CT; row += NGW) {
        const v4u* p1 = (const v4u*)(O1 + (size_t)row * 1024 + 16 * lane); const v4u* p2 = (const v4u*)(O2 + (size_t)row * 1024 + 16 * lane);
        const v4u a0 = p1[0], a1 = p1[1], b0 = p2[0], b1 = p2[1];
        float d[16];
#pragma unroll
        for (int i = 0; i < 4; ++i) { d[2 * i] = bflo(a0[i]) - lam * bflo(b0[i]); d[2 * i + 1] = bfhi(a0[i]) - lam * bfhi(b0[i]);
                                      d[8 + 2 * i] = bflo(a1[i]) - lam * bflo(b1[i]); d[8 + 2 * i + 1] = bfhi(a1[i]) - lam * bfhi(b1[i]); }
        float ss = 0.f;
#pragma unroll
        for (int i = 0; i < 16; ++i) ss += d[i] * d[i];
        ss += __shfl_xor(ss, 1); ss += __shfl_xor(ss, 2); ss += __shfl_xor(ss, 4);
        const float rs = 1.f / sqrtf(ss * (1.f / 128.f) + EPS);
        v4u o0, o1;
#pragma unroll
        for (int i = 0; i < 4; ++i) { o0[i] = pk2(d[2 * i] * rs * gs[i >> 1][(2 * i) & 3], d[2 * i + 1] * rs * gs[i >> 1][(2 * i + 1) & 3]);
                                      o1[i] = pk2(d[8 + 2 * i] * rs * gs[2 + (i >> 1)][(2 * i) & 3], d[8 + 2 * i + 1] * rs * gs[2 + (i >> 1)][(2 * i + 1) & 3]); }
        v4u* po = (v4u*)(OA + (size_t)row * 1024 + 16 * lane); po[0] = o0; po[1] = o1;
        const int hd = lane >> 3;
        const float l0 = LSE[((size_t)0 * CT + row) * 8 + hd], l1 = LSE[((size_t)1 * CT + row) * 8 + hd], l2 = LSE[((size_t)2 * CT + row) * 8 + hd];
        const float mx = fmaxf(l0, fmaxf(l1, l2));
        float w0 = __builtin_amdgcn_exp2f(l0 - mx), w1 = __builtin_amdgcn_exp2f(l1 - mx), w2 = __builtin_amdgcn_exp2f(l2 - mx);
        const float inv = 1.f / (w0 + w1 + w2); w0 *= inv; w1 *= inv; w2 *= inv;
        const v4u g0 = *(const v4u*)(OG + ((size_t)0 * CT + row) * 512 + 8 * lane), g1 = *(const v4u*)(OG + ((size_t)1 * CT + row) * 512 + 8 * lane), g2 = *(const v4u*)(OG + ((size_t)2 * CT + row) * 512 + 8 * lane);
        v4u ob;
#pragma unroll
        for (int i = 0; i < 4; ++i) ob[i] = pk2(w0 * bflo(g0[i]) + w1 * bflo(g1[i]) + w2 * bflo(g2[i]), w0 * bfhi(g0[i]) + w1 * bfhi(g1[i]) + w2 * bfhi(g2[i]));
        *(v4u*)(OB + (size_t)row * 512 + 8 * lane) = ob;
    }
}

using pg8::Unit;
typedef pg8::f32x4 pf4;
__device__ __forceinline__ v4u pack8(const pf4 v0, const pf4 v1) { v4u w; w.x = pg8::cvt_pk_bf16(v0[0], v0[1]); w.y = pg8::cvt_pk_bf16(v0[2], v0[3]); w.z = pg8::cvt_pk_bf16(v1[0], v1[1]); w.w = pg8::cvt_pk_bf16(v1[2], v1[3]); return w; }
__device__ __forceinline__ float sigm(float x) { return __builtin_amdgcn_rcpf(1.f + __expf(-x)); }

struct EpiIn {
    static constexpr bool PERM = true, AFTER_DRAIN = false;
    unsigned char* ws; int S;
    __device__ __forceinline__ void operator()(const pf4 (&acc)[2][2][4][2], const Unit& u, int wr, int wc, int fr, int fq) const {
        int pm_ = u.pm, pn_ = u.pn; asm volatile("" : "+s"(pm_), "+s"(pn_)); const Unit uu{pm_, pn_};
        const int pn = uu.pn; int kind, ldc = 1024, ct; size_t base;
        if (pn < 4) { kind = 1; base = WS_QA; ct = pn; }
        else if (pn < 8) { kind = 2; base = WS_KA; ct = pn - 4; }
        else if (pn < 12) { kind = 0; base = WS_VA; ct = pn - 8; }
        else if (pn < 30) { const int q = pn - 12, g = q / 6, r = q % 6, part = r >> 1; ct = r & 1; ldc = 512; base = WS_G0 + (size_t)(g * 3 + part) * 32 * MiB; kind = part == 0 ? 1 : (part == 1 ? 2 : 0); }
        else if (pn < 34) { kind = 3; base = WS_G1; ct = pn - 30; }
        else { kind = 3; base = WS_G2; ct = pn - 34; }
        bf16* O = (bf16*)(ws + base);
        const int row0 = uu.pm * 256 + wr * 64 + fr, col0 = ct * 256 + wc * 32 + 8 * fq;
        const bool ropew = (kind == 1 || kind == 2) && ((wc & 1) == 0); const bool ropel = fq < 2;
        const float sc = kind == 1 ? C2 : 1.f;
        const float* rope = (const float*)(ws + WS_ROPE);
        if (ropew) {
#pragma unroll
            for (int ai = 0; ai < 2; ++ai) {
            pf4 cs0[4], cs1[4];
#pragma unroll
            for (int q = 0; q < 4; ++q) { const int row = row0 + ai * 128 + q * 16; const float* rp = rope + ((size_t)(row % S) * 8 + 4 * (fq & 1)) * 2; cs0[q] = *(const pf4*)rp; cs1[q] = *(const pf4*)(rp + 4); }
            asm volatile("" ::: "memory");
#pragma unroll
            for (int q = 0; q < 4; ++q) {
                const int m = q, row = row0 + ai * 128 + m * 16;
                bf16* rowp = O + (size_t)row * ldc + col0;
#pragma unroll
                for (int bj = 0; bj < 2; ++bj) {
                    pf4 v0 = acc[ai][bj][m][0], v1 = acc[ai][bj][m][1];
                    pf4 r0, r1;
                    r0[0] = v0[0] * cs0[q][0] - v0[1] * cs0[q][1]; r0[1] = v0[1] * cs0[q][0] + v0[0] * cs0[q][1];
                    r0[2] = v0[2] * cs0[q][2] - v0[3] * cs0[q][3]; r0[3] = v0[3] * cs0[q][2] + v0[2] * cs0[q][3];
                    r1[0] = v1[0] * cs1[q][0] - v1[1] * cs1[q][1]; r1[1] = v1[1] * cs1[q][0] + v1[0] * cs1[q][1];
                    r1[2] = v1[2] * cs1[q][2] - v1[3] * cs1[q][3]; r1[3] = v1[3] * cs1[q][2] + v1[2] * cs1[q][3];
                    if (ropel) { v0 = r0; v1 = r1; }
                    v0 = v0 * sc; v1 = v1 * sc;
                    *(v4u*)(rowp + bj * 128) = pack8(v0, v1);
                }
            }
            asm volatile("" ::: "memory");
            }
        } else {
#pragma unroll
            for (int ai = 0; ai < 2; ++ai)
#pragma unroll
                for (int m = 0; m < 4; ++m) {
                    const int row = row0 + ai * 128 + m * 16;
                    bf16* rowp = O + (size_t)row * ldc + col0;
#pragma unroll
                    for (int bj = 0; bj < 2; ++bj) {
                        pf4 v0 = acc[ai][bj][m][0], v1 = acc[ai][bj][m][1];
                        if (kind == 3) {
#pragma unroll
                            for (int e = 0; e < 4; ++e) { v0[e] = sigm(v0[e]); v1[e] = sigm(v1[e]); }
                        }
                        v0 = v0 * sc; v1 = v1 * sc;
                        *(v4u*)(rowp + bj * 128) = pack8(v0, v1);
                    }
                }
        }
    }
};
struct EpiGate {
    static constexpr bool PERM = true, AFTER_DRAIN = false;
    const bf16* gate; bf16* O; int mode;
    __device__ __forceinline__ void operator()(const pf4 (&acc)[2][2][4][2], const Unit& u, int wr, int wc, int fr, int fq) const {
        int pm_ = u.pm, pn_ = u.pn; asm volatile("" : "+s"(pm_), "+s"(pn_)); const Unit uu{pm_, pn_};
        const int row0 = uu.pm * 256 + wr * 64 + fr, col0 = uu.pn * 256 + wc * 32 + 8 * fq;
#pragma unroll
        for (int ai = 0; ai < 2; ++ai) {
            v4u gv[4][2], pv[4][2];
#pragma unroll
            for (int m = 0; m < 4; ++m)
#pragma unroll
                for (int bj = 0; bj < 2; ++bj) { const size_t off = (size_t)(row0 + ai * 128 + m * 16) * 1024 + col0 + bj * 128;
                    gv[m][bj] = *(const v4u*)(gate + off); pv[m][bj] = mode ? *(const v4u*)(O + off) : (v4u){0u, 0u, 0u, 0u}; }
            asm volatile("" ::: "memory");
#pragma unroll
            for (int m = 0; m < 4; ++m)
#pragma unroll
                for (int bj = 0; bj < 2; ++bj) { const size_t off = (size_t)(row0 + ai * 128 + m * 16) * 1024 + col0 + bj * 128;
                    const v4u g = gv[m][bj], p = pv[m][bj];
                    pf4 v0 = acc[ai][bj][m][0], v1 = acc[ai][bj][m][1];
                    v0[0] = v0[0] * bflo(g.x) + bflo(p.x); v0[1] = v0[1] * bfhi(g.x) + bfhi(p.x); v0[2] = v0[2] * bflo(g.y) + bflo(p.y); v0[3] = v0[3] * bfhi(g.y) + bfhi(p.y);
                    v1[0] = v1[0] * bflo(g.z) + bflo(p.z); v1[1] = v1[1] * bfhi(g.z) + bfhi(p.z); v1[2] = v1[2] * bflo(g.w) + bflo(p.w); v1[3] = v1[3] * bfhi(g.w) + bfhi(p.w);
                    *(v4u*)(O + off) = pack8(v0, v1); }
            asm volatile("" ::: "memory");
        }
    }
};
template <bool IN_BF16> struct EpiRes {
    static constexpr bool PERM = true, AFTER_DRAIN = false;
    const void* base; bf16* out; const float* mod; int gidx, S, b0;
    __device__ __forceinline__ void operator()(const pf4 (&acc)[2][2][4][2], const Unit& u, int wr, int wc, int fr, int fq) const {
        int pm_ = u.pm, pn_ = u.pn; asm volatile("" : "+s"(pm_), "+s"(pn_)); const Unit uu{pm_, pn_};
        const int row0 = uu.pm * 256 + wr * 64 + fr, col0 = uu.pn * 256 + wc * 32 + 8 * fq;
        const float* gp = mod + (size_t)(b0 + (uu.pm * 256) / S) * 6144 + gidx * 1024 + col0;
        pf4 gt[2][2];
#pragma unroll
        for (int bj = 0; bj < 2; ++bj) { gt[bj][0] = *(const pf4*)(gp + bj * 128); gt[bj][1] = *(const pf4*)(gp + bj * 128 + 4); }
#pragma unroll
        for (int q = 0; q < 4; ++q) {
            pf4 xb[2][2][2];
#pragma unroll
            for (int mm = 0; mm < 2; ++mm)
#pragma unroll
                for (int bj = 0; bj < 2; ++bj) { const size_t off = (size_t)(row0 + (q >> 1) * 128 + ((q & 1) * 2 + mm) * 16) * 1024 + col0 + bj * 128;
                    if (IN_BF16) { const v4u w = *(const v4u*)((const bf16*)base + off);
                        xb[mm][bj][0] = (pf4){bflo(w.x), bfhi(w.x), bflo(w.y), bfhi(w.y)}; xb[mm][bj][1] = (pf4){bflo(w.z), bfhi(w.z), bflo(w.w), bfhi(w.w)}; }
                    else { xb[mm][bj][0] = *(const pf4*)((const float*)base + off); xb[mm][bj][1] = *(const pf4*)((const float*)base + off + 4); } }
            asm volatile("" ::: "memory");
#pragma unroll
            for (int mm = 0; mm < 2; ++mm)
#pragma unroll
                for (int bj = 0; bj < 2; ++bj) { const int ai = q >> 1, m = (q & 1) * 2 + mm; const size_t off = (size_t)(row0 + ai * 128 + m * 16) * 1024 + col0 + bj * 128;
                    *(v4u*)(out + off) = pack8(xb[mm][bj][0] + gt[bj][0] * acc[ai][bj][m][0], xb[mm][bj][1] + gt[bj][1] * acc[ai][bj][m][1]); }
            asm volatile("" ::: "memory");
        }
    }
};
struct EpiGU {
    static constexpr bool PERM = true, AFTER_DRAIN = false;
    bf16* act;
    __device__ __forceinline__ void operator()(const pf4 (&acc)[2][2][4][2], const Unit& u, int wr, int wc, int fr, int fq) const {
        int pm_ = u.pm, pn_ = u.pn; asm volatile("" : "+s"(pm_), "+s"(pn_)); const Unit uu{pm_, pn_};
        const int row0 = uu.pm * 256 + wr * 64 + fr, col0 = uu.pn * 128 + wc * 16 + 4 * fq;
#pragma unroll
        for (int ai = 0; ai < 2; ++ai)
#pragma unroll
            for (int m = 0; m < 4; ++m) {
                bf16* rowp = act + (size_t)(row0 + ai * 128 + m * 16) * FFH + col0;
#pragma unroll
                for (int bj = 0; bj < 2; ++bj) {
                    const pf4 g = acc[ai][bj][m][0], up = acc[ai][bj][m][1]; pf4 r;
#pragma unroll
                    for (int e = 0; e < 4; ++e) r[e] = g[e] * sigm(g[e]) * up[e];
                    v2u w; w.x = pg8::cvt_pk_bf16(r[0], r[1]); w.y = pg8::cvt_pk_bf16(r[2], r[3]);
                    *(v2u*)(rowp + bj * 64) = w;
                }
                asm volatile("" ::: "memory");
            }
    }
};

__device__ __forceinline__ float halfmax(float m) { auto rr = __builtin_amdgcn_permlane32_swap(__float_as_uint(m), __float_as_uint(m), false, false); return fmaxf(__uint_as_float(rr[0]), __uint_as_float(rr[1])); }
__device__ __forceinline__ float halfsum(float m) { auto rr = __builtin_amdgcn_permlane32_swap(__float_as_uint(m), __float_as_uint(m), false, false); return __uint_as_float(rr[0]) + __uint_as_float(rr[1]); }
typedef short v4i16_t __attribute__((ext_vector_type(4)));
__device__ __forceinline__ s16x4 trrd(LAS unsigned char* p) { return __builtin_bit_cast(s16x4, __builtin_amdgcn_ds_read_tr16_b64_v4i16((LAS v4i16_t*)p)); }
__device__ __forceinline__ void dil_unit(const bf16* Qg, const bf16* Kg, const bf16* Vg, bf16* Og, float* Lg, int r, int n, int dil, int T, LAS unsigned char* wl, int lane) {
    const int r32 = lane & 31, hi = lane >> 5;
    LAS unsigned char* vimg = wl;
    LAS bf16* stg = (LAS bf16*)(wl + 4096);
    LAS float* wsf = (LAS float*)(wl + 8192);
    const int vwr = ((lane & 7) >> 2) * 2048 + (lane >> 3) * 64 + (lane & 3) * 16;
    const int vrd = ((lane >> 4) & 1) * 32 + (lane & 3) * 8 + (4 * hi + ((lane & 15) >> 2)) * 64;
    for (int qi = 0; qi < 2; ++qi) {
        const int tq0 = 64 * n + 32 * qi;
        const bf16* qp = Qg + (size_t)(r + dil * (tq0 + r32)) * 512 + 8 * hi;
        bf16x8 qf[4];
#pragma unroll
        for (int d0 = 0; d0 < 4; ++d0) qf[d0] = *(const bf16x8*)(qp + 16 * d0);
        f32x16 s[5];
#pragma unroll
        for (int kb = 0; kb < 5; ++kb) {
            const int tk0 = tq0 - 64 + 32 * kb; int tk = tk0 + r32; tk = tk < 0 ? 0 : (tk >= T ? T - 1 : tk);
            const bf16* kp = Kg + (size_t)(r + dil * tk) * 512 + 8 * hi;
            bf16x8 kf[4];
#pragma unroll
            for (int d0 = 0; d0 < 4; ++d0) kf[d0] = *(const bf16x8*)(kp + 16 * d0);
            f32x16 acc = {};
#pragma unroll
            for (int d0 = 0; d0 < 4; ++d0) acc = __builtin_amdgcn_mfma_f32_32x32x16_bf16(kf[d0], qf[d0], acc, 0, 0, 0);
#pragma unroll
            for (int rr = 0; rr < 16; ++rr) {
                const int cr = (rr & 3) + 8 * (rr >> 2) + 4 * hi; const int rel = -64 + 32 * kb + cr - r32; const int kt = tk0 + cr;
                const bool ok = (rel >= -64) && (rel <= 64) && (kt >= 0) && (kt < T);
                acc[rr] = ok ? acc[rr] : -INFINITY;
            }
            s[kb] = acc;
        }
        float mx = -INFINITY;
#pragma unroll
        for (int kb = 0; kb < 5; ++kb)
#pragma unroll
            for (int rr = 0; rr < 16; ++rr) mx = fmaxf(mx, s[kb][rr]);
        mx = halfmax(mx);
        float lsum = 0.f;
#pragma unroll
        for (int kb = 0; kb < 5; ++kb)
#pragma unroll
            for (int rr = 0; rr < 16; ++rr) { const float p = __builtin_amdgcn_exp2f(s[kb][rr] - mx); s[kb][rr] = p; lsum += p; }
        lsum = halfsum(lsum);
        f32x16 o[2]; o[0] = f32x16{}; o[1] = f32x16{};
#pragma unroll
        for (int kb = 0; kb < 5; ++kb) {
            const int tk0 = tq0 - 64 + 32 * kb;
            bf16x8 vv[4];
#pragma unroll
            for (int j = 0; j < 4; ++j) { int tk = tk0 + 8 * j + (lane >> 3); tk = tk < 0 ? 0 : (tk >= T ? T - 1 : tk);
                vv[j] = *(const bf16x8*)(Vg + (size_t)(r + dil * tk) * 512 + 8 * (lane & 7)); }
#pragma unroll
            for (int j = 0; j < 4; ++j) *(LAS bf16x8*)(vimg + vwr + j * 512) = vv[j];
#pragma unroll
            for (int ks = 0; ks < 2; ++ks) {
                v4u pw;
#pragma unroll
                for (int e = 0; e < 4; ++e) pw[e] = pg8::cvt_pk_bf16(s[kb][8 * ks + 2 * e], s[kb][8 * ks + 2 * e + 1]);
                const bf16x8 pa = __builtin_bit_cast(bf16x8, pw);
#pragma unroll
                for (int d0 = 0; d0 < 2; ++d0) {
                    const s16x4 lo = trrd(vimg + vrd + d0 * 2048 + ks * 1024), hh = trrd(vimg + vrd + d0 * 2048 + ks * 1024 + 512);
                    const bf16x8 vb = (bf16x8){lo[0], lo[1], lo[2], lo[3], hh[0], hh[1], hh[2], hh[3]};
                    o[d0] = __builtin_amdgcn_mfma_f32_32x32x16_bf16(pa, vb, o[d0], 0, 0, 0);
                }
            }
        }
        if (hi == 0) wsf[r32] = lsum;
#pragma unroll
        for (int rr = 0; rr < 16; ++rr) {
            const int orow = (rr & 3) + 8 * (rr >> 2) + 4 * hi; const float rl = __builtin_amdgcn_rcpf(wsf[orow]);
#pragma unroll
            for (int d0 = 0; d0 < 2; ++d0) stg[orow * 64 + d0 * 32 + r32] = (bf16)f2bf(o[d0][rr] * rl);
        }
#pragma unroll
        for (int i = 0; i < 4; ++i) { const int row = i * 8 + (lane >> 3), ch = lane & 7; const v4u v = *(const LAS v4u*)(stg + row * 64 + ch * 8);
            *(v4u*)(Og + (size_t)(r + dil * (tq0 + row)) * 512 + ch * 8) = v; }
        if (hi == 0) Lg[(size_t)(r + dil * (tq0 + r32)) * 8] = mx + __builtin_amdgcn_logf(lsum);
    }
}

#define XB_TMO      128
#define XB_XCNT(j)  (256  + 64 * (j))
#define XB_XSUB(j)  (1280 + 64 * (j))
#define XB_XGEN(j)  (2304 + 64 * (j))
#define XB_TOP      3328
#define XB_TOPGEN   3392
#define XCD_BAR_WORDS 3456
#define XB_SPIN_CAP (1u << 18)

__device__ __forceinline__ unsigned xb_ld(unsigned* p)              { return __hip_atomic_load(p, __ATOMIC_RELAXED, __HIP_MEMORY_SCOPE_AGENT); }
__device__ __forceinline__ unsigned xb_add(unsigned* p, unsigned v) { return __hip_atomic_fetch_add(p, v, __ATOMIC_RELAXED, __HIP_MEMORY_SCOPE_AGENT); }
__device__ __forceinline__ unsigned xb_xcc_id() { return (unsigned)__builtin_amdgcn_s_getreg((3 << 11) | 20) & 0xFu; }
#define XB_SPIN(cond, bar) do { unsigned _sp = 0; while (cond) { __builtin_amdgcn_s_sleep(1); \
    if ((++_sp & 255u) == 0u) { if (xb_ld(&(bar)[XB_TMO])) break; if (_sp > XB_SPIN_CAP) { atomicAdd(&(bar)[XB_TMO], 1u); break; } } } } while (0)

struct XcdBarrier {
    unsigned* bar; unsigned x;
    volatile LAS unsigned* st;
};

__device__ __forceinline__ XcdBarrier xcd_barrier_post(unsigned* bar, volatile LAS unsigned* st) {
    XcdBarrier b; b.bar = bar; b.x = xb_xcc_id(); b.st = st;
    if (threadIdx.x == 0) (void)xb_add(&bar[XB_XCNT(b.x)], 1u);
    return b;
}
__device__ __forceinline__ void xcd_barrier_complete(unsigned* bar, unsigned x, unsigned& nloc, unsigned& nx) {
    const unsigned G = gridDim.x * gridDim.y * gridDim.z;
    unsigned sum, cnt, mine, sp = 0u;
    for (;;) {
        sum = 0u; cnt = 0u; mine = 0u;
#pragma unroll
        for (unsigned j = 0; j < 16; ++j) { const unsigned c = xb_ld(&bar[XB_XCNT(j)]); sum += c; cnt += (c > 0u) ? 1u : 0u; mine = (j == x) ? c : mine; }
        if (sum == G) break;
        __builtin_amdgcn_s_sleep(1);
        if ((++sp & 255u) == 0u) { if (xb_ld(&bar[XB_TMO])) break; if (sp > XB_SPIN_CAP) { atomicAdd(&bar[XB_TMO], 1u); break; } }
    }
    nloc = mine > 0u ? mine : 1u; nx = cnt > 0u ? cnt : 1u;
}

__device__ __forceinline__ void xcd_barrier(const XcdBarrier& b) {
    asm volatile("s_waitcnt vmcnt(0)" ::: "memory");
    __syncthreads();
    if (threadIdx.x == 0) {
        unsigned* bar = b.bar;
        __builtin_amdgcn_s_waitcnt(0);
        unsigned nloc = b.st[0], nx = b.st[1];
        if (nloc == 0u) { xcd_barrier_complete(bar, b.x, nloc, nx); b.st[0] = nloc; b.st[1] = nx; }
        const unsigned old = xb_add(&bar[XB_XSUB(b.x)], 1u);
        const unsigned gen = old / nloc;
        if (old + 1u == (gen + 1u) * nloc) {
            __builtin_amdgcn_fence(__ATOMIC_RELEASE, "agent");
            asm volatile("s_waitcnt vmcnt(0)" ::: "memory");
            const unsigned og = xb_add(&bar[XB_TOP], 1u);
            const unsigned tg = og / nx;
            if (og + 1u == (tg + 1u) * nx) xb_add(&bar[XB_TOPGEN], 1u);
            else XB_SPIN(xb_ld(&bar[XB_TOPGEN]) == tg, bar);
            __builtin_amdgcn_fence(__ATOMIC_ACQUIRE, "agent");
            xb_add(&bar[XB_XGEN(b.x)], 1u);
            asm volatile("s_waitcnt vmcnt(0)" ::: "memory");
        } else {
            XB_SPIN(xb_ld(&bar[XB_XGEN(b.x)]) == gen, bar);
            __builtin_amdgcn_fence(__ATOMIC_ACQUIRE, "agent");
            asm volatile("s_waitcnt vmcnt(0)" ::: "memory");
        }
    }
    __syncthreads();
}

#ifndef PROBE_GIN
#define PROBE_GIN 1
#endif
#ifndef PROBE_GU
#define PROBE_GU 1
#endif
#ifndef PROBE_DIL
#define PROBE_DIL 1
#endif
#ifndef PROBE_ATT
#define PROBE_ATT 1
#endif
#ifndef PROBE_ROWS
#define PROBE_ROWS 1
#endif
#ifndef PROBE_SYNC
#define PROBE_SYNC 1
#endif
#define GSYNC() do { for (int s_ = 0; s_ < PROBE_SYNC; ++s_) xcd_barrier(bar); } while (0)
__global__ void __launch_bounds__(NWAVES * 64, 2) fwd_megakernel(Args a) {
    extern __shared__ __attribute__((aligned(16))) unsigned char lds_raw[];
    cg::grid_group grid = cg::this_grid();
    LAS unsigned char* lds = (LAS unsigned char*)lds_raw;
    const int tid = threadIdx.x, lane = tid & 63, wave = __builtin_amdgcn_readfirstlane(tid >> 6);
    const int G = gridDim.x, bx = blockIdx.x;
    const int vcu = (G % 8 == 0) ? (bx % 8) * (G / 8) + bx / 8 : bx;
    const int gw = vcu * NWAVES + wave, NGW = G * NWAVES;

#ifndef NO_P0
    volatile LAS unsigned* MISC = (volatile LAS unsigned*)(lds + LDS_BYTES - 256);
    if (tid < 32) MISC[tid] = 0u;
    __syncthreads();
    XcdBarrier bar = xcd_barrier_post((unsigned*)argp()->ws, MISC + 8);
    p0_prologue(lds, tid, lane, wave, vcu, G);
#endif
    grid.sync();

    const int lane0 = lane;
    for (int c = 0; c < NCHUNK; ++c) {
        int lane = lane0; asm volatile("" : "+v"(lane));
        const int S = (c < 2) ? S_P : S_S, nseq = CT / S, b0 = (c < 2) ? c * 8 : 16;
#define FETCH() CArgs ap = argp(); unsigned char* ws = ap->ws; const float* mod = (const float*)(ws + WS_MOD); (void)mod
#define XC() ((c < 2) ? ap->x_prompt + (size_t)c * CT * 1024 : ap->x_sample)
#define OUTC() (ap->out + (size_t)c * CT * 1024)
        for (int rep_ = 0; rep_ < PROBE_ROWS; ++rep_) { FETCH(); rows_norm_mod(XC(), (bf16*)(ws + WS_H), ap->g_mix, mod, 0, 1, S, b0, gw, NGW, lane); }
        GSYNC();
        {   FETCH();
            pg8::Gemm g{(const pg8::bf16_t*)(ws + WS_H), (const pg8::bf16_t*)(ws + WS_WIN), CT, NIN, 1024}; pg8::StaticOrder So; So.init(CT, NIN, G, bx);
            EpiIn E{ws, S};
#ifndef NO_GIN
            for (int rep_ = 0; rep_ < PROBE_GIN; ++rep_)
            pg8::gemm_phase<EpiIn, pg8::StaticOrder, PG8_ALIGN, PG8_SP2>(lds, g, So, E);
#endif
        }
        GSYNC();
        {   FETCH();
            const int NQB = S / 256, NT = S / 64, nunits = nseq * 16 * NQB;
            for (int rep_ = 0; rep_ < PROBE_ATT; ++rep_)
            for (int id = vcu; id < nunits; id += G) {
                const int qb = id % NQB; int t = id / NQB; const int cmap = t & 1; t >>= 1; const int h8 = t & 7, seq = t >> 3;
                const size_t rb = (size_t)seq * S * 1024;
                const attn_body::bf16* Qp = (const attn_body::bf16*)(ws + WS_QA) + rb + (h8 * 2 + cmap) * 64;
                const attn_body::bf16* Kp = (const attn_body::bf16*)(ws + WS_KA) + rb + (h8 * 2 + cmap) * 64;
                const attn_body::bf16* Vp = (const attn_body::bf16*)(ws + WS_VA) + rb + h8 * 128;
                attn_body::bf16* Op = (attn_body::bf16*)(ws + (cmap ? WS_O2 : WS_O1)) + rb + h8 * 128;
#ifndef NO_ATT
                attn_body::attn_unit<8>(Qp, Kp, Vp, Op, qb * 256, NT, (char*)lds_raw);
#endif
            }
            __syncthreads();
            const int nb64 = S / 64, ndu = 3 * nseq * nb64;
            for (int rep_ = 0; rep_ < PROBE_DIL; ++rep_)
            for (int id = vcu; id < ndu; id += G) {
                const int rn = id % nb64; int t = id / nb64; const int seq = t % nseq, g = t / nseq;
                const int dil = (g == 0) ? 1 : (g == 1 ? 4 : 16), T = S / dil, nb = T / 64, r = rn / nb, n = rn % nb;
                const size_t rb = (size_t)seq * S * 512 + wave * 64;
                const bf16* Qg = (const bf16*)(ws + WS_G0 + (size_t)(g * 3 + 0) * 32 * MiB) + rb;
                const bf16* Kg = (const bf16*)(ws + WS_G0 + (size_t)(g * 3 + 1) * 32 * MiB) + rb;
                const bf16* Vg = (const bf16*)(ws + WS_G0 + (size_t)(g * 3 + 2) * 32 * MiB) + rb;
                bf16* Og = (bf16*)(ws + WS_OG + (size_t)g * 32 * MiB) + rb;
                float* Lg = (float*)(ws + WS_LSE) + ((size_t)g * CT + (size_t)seq * S) * 8 + wave;
#ifndef NO_DIL
                dil_unit(Qg, Kg, Vg, Og, Lg, r, n, dil, T, lds + wave * 8704, lane);
#endif
            }
        }
        GSYNC();
#ifndef NO_COMB
        for (int rep_ = 0; rep_ < PROBE_ROWS; ++rep_) rows_combine(gw, NGW, lane);
#endif
        GSYNC();
        {   FETCH();
            pg8::StaticOrder So; So.init(CT, 1024, G, bx);
            pg8::Gemm ga{(const pg8::bf16_t*)(ws + WS_OA), (const pg8::bf16_t*)(ws + WS_WA), CT, 1024, 1024};
            EpiGate Ea{(const bf16*)(ws + WS_G1), (bf16*)(ws + WS_MRG), 0};
#ifndef NO_GG
            pg8::gemm_phase<EpiGate, pg8::StaticOrder, PG8_ALIGN, PG8_SP2>(lds, ga, So, Ea);
#endif
            pg8::Gemm gb{(const pg8::bf16_t*)(ws + WS_OB), (const pg8::bf16_t*)(ws + WS_WB), CT, 1024, 512};
            EpiGate Eb{(const bf16*)(ws + WS_G2), (bf16*)(ws + WS_MRG), 1};
#ifndef NO_GG
            pg8::gemm_phase<EpiGate, pg8::StaticOrder, PG8_ALIGN, PG8_SP2>(lds, gb, So, Eb);
#endif
        }
        GSYNC();
        {   FETCH();
            pg8::StaticOrder So; So.init(CT, 1024, G, bx);
            pg8::Gemm g{(const pg8::bf16_t*)(ws + WS_MRG), (const pg8::bf16_t*)(ws + WS_WOUT), CT, 1024, 1024};
            EpiRes<false> E{XC(), (bf16*)(ws + WS_X1), mod, 2, S, b0};
#ifndef NO_GR
            pg8::gemm_phase<EpiRes<false>, pg8::StaticOrder, PG8_ALIGN, PG8_SP2>(lds, g, So, E);
#endif
        }
        GSYNC();
        for (int rep_ = 0; rep_ < PROBE_ROWS; ++rep_) { FETCH(); rows_norm_mod((const bf16*)(ws + WS_X1), (bf16*)(ws + WS_H), ap->g_ffn, mod, 3, 4, S, b0, gw, NGW, lane); }
        GSYNC();
        {   FETCH();
            pg8::StaticOrder So; So.init(CT, 2 * FFH, G, bx);
            pg8::Gemm g{(const pg8::bf16_t*)(ws + WS_H), (const pg8::bf16_t*)(ws + WS_WGU), CT, 2 * FFH, 1024};
            EpiGU E{(bf16*)(ws + WS_ACT)};
#ifndef NO_GU
            for (int rep_ = 0; rep_ < PROBE_GU; ++rep_)
            pg8::gemm_phase<EpiGU, pg8::StaticOrder, PG8_ALIGN, PG8_SP2>(lds, g, So, E);
#endif
        }
        GSYNC();
        {   FETCH();
            pg8::StaticOrder So; So.init(CT, 1024, G, bx);
            pg8::Gemm g{(const pg8::bf16_t*)(ws + WS_ACT), (const pg8::bf16_t*)(ws + WS_WDN), CT, 1024, FFH};
            EpiRes<true> E{(const bf16*)(ws + WS_X1), (bf16*)(ws + WS_X2), mod, 5, S, b0};
#ifndef NO_GR
            pg8::gemm_phase<EpiRes<true>, pg8::StaticOrder, PG8_ALIGN, PG8_SP2>(lds, g, So, E);
#endif
        }
        GSYNC();
        { FETCH(); rows_final_norm((const bf16*)(ws + WS_X2), OUTC(), ap->g_final, gw, NGW, lane); }
    }
}

extern "C" void kernel_launch(void* const* d_in, const int* in_sizes, int n_in, void* d_out, int out_size, void* d_ws, size_t ws_size, hipStream_t stream) {
    static int grid = 0;
    if (grid == 0) {
        if (n_in != 20 || ws_size < WS_END) { fprintf(stderr, "kernel_launch: unexpected n_in %d / ws_size %zu (need %zu)\n", n_in, ws_size, (size_t)WS_END); grid = -1; return; }
        int dev = 0, cus = 0, per_cu = 0;
        hipGetDevice(&dev); hipDeviceGetAttribute(&cus, hipDeviceAttributeMultiprocessorCount, dev);
        if (hipFuncSetAttribute((const void*)fwd_megakernel, hipFuncAttributeMaxDynamicSharedMemorySize, LDS_BYTES) != hipSuccess) { fprintf(stderr, "kernel_launch: hipFuncSetAttribute failed\n"); grid = -1; return; }
        if (hipOccupancyMaxActiveBlocksPerMultiprocessor(&per_cu, (const void*)fwd_megakernel, NWAVES * 64, LDS_BYTES) != hipSuccess || per_cu < 1) { fprintf(stderr, "kernel_launch: occupancy query says %d\n", per_cu); per_cu = 1; }
        (void)hipGetLastError();
        grid = cus * 1;
        fprintf(stderr, "kernel_launch: grid %d (cus %d, per_cu %d)\n", grid, cus, per_cu);
    }
    if (grid < 0) return;
    Args a{};
    a.x_prompt = (const float*)d_in[0]; a.x_sample = (const float*)d_in[1]; a.c_prompt = (const float*)d_in[2]; a.c_sample = (const float*)d_in[3];
    a.w_ada = (const float*)d_in[4]; a.b_ada = (const float*)d_in[5]; a.g_mix = (const float*)d_in[6]; a.w_in = (const float*)d_in[7];
    a.lq1 = (const float*)d_in[8]; a.lk1 = (const float*)d_in[9]; a.lq2 = (const float*)d_in[10]; a.lk2 = (const float*)d_in[11]; a.g_subln = (const float*)d_in[12];
    a.w_a = (const float*)d_in[13]; a.w_b = (const float*)d_in[14]; a.w_out = (const float*)d_in[15]; a.g_ffn = (const float*)d_in[16]; a.w_gu = (const float*)d_in[17];
    a.w_down = (const float*)d_in[18]; a.g_final = (const float*)d_in[19];
    a.out = (float*)d_out; a.ws = (unsigned char*)d_ws;
    if (hipMemsetAsync(d_ws, 0, 16384, stream) != hipSuccess) { fprintf(stderr, "kernel_launch: memset failed\n"); return; }
    void* args[] = {&a};
    hipError_t e = hipLaunchCooperativeKernel((const void*)fwd_megakernel, dim3(grid), dim3(NWAVES * 64), args, LDS_BYTES, stream);
    if (e != hipSuccess) fprintf(stderr, "kernel_launch: cooperative launch failed: %s (grid %d)\n", hipGetErrorString(e), grid);
}
```

```cpp
#include <hip/hip_runtime.h>
#include <hip/hip_bf16.h>
#include <hip/hip_cooperative_groups.h>
#include <cstdio>
#include <cstdint>
namespace cg = cooperative_groups;
namespace pg8 {
#define PG8_LAS __attribute__((address_space(3)))
typedef unsigned short bf16_t;
typedef short bf16x8 __attribute__((ext_vector_type(8)));
typedef float f32x4 __attribute__((ext_vector_type(4)));
typedef unsigned u32x4 __attribute__((ext_vector_type(4)));
constexpr int BM = 256, BK = 64, HALF = 128, HTB = HALF * BK * 2  , STAGE_BYTES = 8 * HTB, NXCD = 8, WGM = 8;

__host__ __device__ __forceinline__ int lds_byte(int r, int c) { const int st = (r >> 4) * 2 + (c >> 5), rr = r & 15, cc = c & 31, ob = rr * 64 + cc * 2; return st * 1024 + (ob ^ (((ob >> 9) & 1) << 5)); }
__host__ __device__ __forceinline__ void stage_rc(int b, int& R, int& C) { const int st = b / 1024, sb = b % 1024, swz = sb ^ (((sb >> 9) & 1) << 5); R = (st >> 1) * 16 + swz / 64; C = (st & 1) * 32 + (swz % 64) / 2; }
__host__ __device__ __forceinline__ int perm32(int rho) { const int n = rho >> 4, i = rho & 15; return 8 * (i >> 2) + 4 * n + (i & 3); }

struct Unit { int pm, pn; };
struct Gemm { const bf16_t* A; const bf16_t* Bt; int M, N, K; };

struct StaticOrder {
    int nM, nN, nwg, G, c;
    __host__ __device__ void init(int M, int N, int G_, int c_) { nM = M / BM; nN = N / BM; nwg = nM * nN; G = G_; c = c_; }
    __host__ __device__ bool next(int i, Unit& u) const {
        const long L = (long)i * G + c; if (L >= nwg) return false;
        int wgid = (int)L; { const int q = nwg / NXCD, r = nwg % NXCD, xcd = wgid % NXCD, off = wgid / NXCD; wgid = (xcd < r ? xcd * (q + 1) : r * (q + 1) + (xcd - r) * q) + off; }
        const int nig = WGM * nN, gid = wgid / nig, fm = gid * WGM, gsz = (nM - fm) < WGM ? (nM - fm) : WGM;
        u.pm = fm + ((wgid % nig) % gsz); u.pn = (wgid % nig) / gsz; return true;
    }
    __device__ __forceinline__ void a_ready(const Unit&) const {}
    __device__ __forceinline__ void done(const Unit&) const {}
};

__device__ __forceinline__ unsigned cvt_pk_bf16(float lo, float hi) { unsigned r; asm volatile("v_cvt_pk_bf16_f32 %0, %1, %2" : "=v"(r) : "v"(lo), "v"(hi)); return r; }
typedef float f32x2 __attribute__((ext_vector_type(2)));
template <class Epi, class Sched, bool ALIGN_EPI = false, bool SP2 = false>
__device__ __forceinline__ void gemm_phase(PG8_LAS unsigned char* lds, const Gemm g, const Sched& S, const Epi& E, const int wave_) {
    int tid_ = wave_ * 64 + (int)__builtin_amdgcn_mbcnt_hi(~0u, __builtin_amdgcn_mbcnt_lo(~0u, 0u)); asm volatile("" : "+v"(tid_));
    const int tid = tid_, wid = __builtin_amdgcn_readfirstlane(tid >> 6), lane = tid & 63, wr = wid >> 2, wc = wid & 3, fr = lane & 15, fq = lane >> 4;
    const int K = g.K, nt = K / BK;
    unsigned voffA[2], voffB[2];
#pragma unroll
    for (int i = 0; i < 2; ++i) { int R, C; stage_rc(tid * 16 + i * 8192, R, C); const int Rb = Epi::PERM ? ((R & ~31) + perm32(R & 31)) : R;
        voffA[i] = (unsigned)(R * K + C) * 2u; voffB[i] = (unsigned)(Rb * K + C) * 2u; }
    const size_t kstep = (size_t)(BK * 2);
    const size_t hstep = (size_t)HALF * K * 2;
    const size_t tstep = 2 * hstep;
    const unsigned ldsw = (unsigned)wid * 1024u;
    const int aoff = lds_byte(wr * 64 + fr, fq * 8), boff = lds_byte(wc * 32 + fr, fq * 8);
#define PG8_SA(b, h) (((b) * 2 + (h)) * HTB)
#define PG8_SB(b, h) ((4 + (b) * 2 + (h)) * HTB)
#define PG8_STAGE(bufoff, gbase, voff) do { _Pragma("unroll") for (int _i = 0; _i < 2; ++_i) \
        __builtin_amdgcn_global_load_lds((const unsigned*)((const char*)(gbase) + (voff)[_i]), (PG8_LAS unsigned*)(lds + (bufoff) + ldsw + _i * 8192), 16, 0, 0); } while (0)
#define PG8_LDA(dst, b, h) do { _Pragma("unroll") for (int m = 0; m < 4; ++m) _Pragma("unroll") for (int k = 0; k < 2; ++k) dst[m][k] = *(const PG8_LAS bf16x8*)(lds + PG8_SA(b, h) + aoff + m * 2048 + k * 1024); } while (0)
#define PG8_LDB(dst, b, h) do { _Pragma("unroll") for (int n = 0; n < 2; ++n) _Pragma("unroll") for (int k = 0; k < 2; ++k) dst[n][k] = *(const PG8_LAS bf16x8*)(lds + PG8_SB(b, h) + boff + n * 2048 + k * 1024); } while (0)
#define PG8_MMA(ai, bj, At, Bt) do { __builtin_amdgcn_s_setprio(1); _Pragma("unroll") for (int m = 0; m < 4; ++m) _Pragma("unroll") for (int n = 0; n < 2; ++n) _Pragma("unroll") for (int k = 0; k < 2; ++k) \
        acc[ai][bj][m][n] = __builtin_amdgcn_mfma_f32_16x16x32_bf16(Bt[n][k], At[m][k], acc[ai][bj][m][n], 0, 0, 0); __builtin_amdgcn_s_setprio(0); } while (0)
#define PG8_WAIT_V(n) asm volatile("s_waitcnt vmcnt(" #n ")" ::: "memory")
#define PG8_WAIT_L(n) asm volatile("s_waitcnt lgkmcnt(" #n ")" ::: "memory")
#define PG8_BAR __builtin_amdgcn_s_barrier()
#define PG8_SCHED __builtin_amdgcn_sched_barrier(0)
    Unit cur, nxt; int ui = 0;
    if (!S.next(0, cur)) return;
    f32x4 acc[2][2][4][2];
#pragma unroll
    for (int a = 0; a < 2; ++a)
#pragma unroll
        for (int b = 0; b < 2; ++b)
#pragma unroll
            for (int m = 0; m < 4; ++m)
#pragma unroll
                for (int n = 0; n < 2; ++n) acc[a][b][m][n] = (f32x4){0.f, 0.f, 0.f, 0.f};
    bf16x8 At[4][2], B0[2][2], B1[2][2];
    const char* cA = (const char*)g.A + (size_t)cur.pm * tstep; const char* cB = (const char*)g.Bt + (size_t)cur.pn * tstep;
    S.a_ready(cur);
    if constexpr (SP2) {
        PG8_STAGE(PG8_SB(0, 0), cB, voffB); PG8_STAGE(PG8_SB(0, 1), cB + hstep, voffB); PG8_STAGE(PG8_SA(0, 0), cA, voffA); PG8_STAGE(PG8_SA(0, 1), cA + hstep, voffA);
        if (wr == 1) PG8_BAR;
        PG8_WAIT_V(2); PG8_BAR;
        PG8_STAGE(PG8_SB(1, 0), cB + kstep, voffB); PG8_STAGE(PG8_SA(1, 0), cA + kstep, voffA); PG8_STAGE(PG8_SB(1, 1), cB + hstep + kstep, voffB);
        PG8_WAIT_V(6); PG8_BAR;
    } else {
        PG8_STAGE(PG8_SB(0, 0), cB, voffB); PG8_STAGE(PG8_SA(0, 0), cA, voffA); PG8_STAGE(PG8_SB(0, 1), cB + hstep, voffB); PG8_STAGE(PG8_SA(0, 1), cA + hstep, voffA);
        if (wr == 1) PG8_BAR;
        PG8_WAIT_V(4); PG8_BAR;
        PG8_STAGE(PG8_SB(1, 0), cB + kstep, voffB); PG8_STAGE(PG8_SA(1, 0), cA + kstep, voffA); PG8_STAGE(PG8_SB(1, 1), cB + hstep + kstep, voffB);
        PG8_WAIT_V(6); PG8_BAR;
    }
    for (;;) {
        const bool has_next = S.next(ui + 1, nxt);
        const char* nA = has_next ? (const char*)g.A + (size_t)nxt.pm * tstep : cA; const char* nB = has_next ? (const char*)g.Bt + (size_t)nxt.pn * tstep : cB;
        for (int t = 0; t < nt; t += 2) {
            const bool last = (t == nt - 2);
            const char* a1 = cA + (size_t)(t + 1) * kstep;
            const char* a2 = last ? nA : cA + (size_t)(t + 2) * kstep; const char* b2 = last ? nB : cB + (size_t)(t + 2) * kstep;
            const char* a3 = a2 + kstep; const char* b3 = b2 + kstep;
            if (last && has_next) S.a_ready(nxt);
            if constexpr (SP2) {
            PG8_LDB(B0, 0, 0); PG8_LDB(B1, 0, 1); PG8_SCHED; PG8_LDA(At, 0, 0); PG8_STAGE(PG8_SA(1, 1), a1 + hstep, voffA);
            PG8_WAIT_V(8); PG8_WAIT_L(0); PG8_BAR; PG8_MMA(0, 0, At, B0); PG8_MMA(0, 1, At, B1); PG8_BAR; PG8_SCHED;
            PG8_LDA(At, 0, 1); PG8_STAGE(PG8_SB(0, 0), b2, voffB); PG8_STAGE(PG8_SB(0, 1), b2 + hstep, voffB); PG8_STAGE(PG8_SA(0, 0), a2, voffA);
            PG8_WAIT_V(8); PG8_WAIT_L(0); PG8_BAR; PG8_MMA(1, 0, At, B0); PG8_MMA(1, 1, At, B1); PG8_BAR; PG8_SCHED;
            PG8_LDB(B0, 1, 0); PG8_LDB(B1, 1, 1); PG8_SCHED; PG8_LDA(At, 1, 0); PG8_STAGE(PG8_SA(0, 1), a2 + hstep, voffA);
            PG8_WAIT_V(8); PG8_WAIT_L(0); PG8_BAR; PG8_MMA(0, 0, At, B0); PG8_MMA(0, 1, At, B1); PG8_BAR; PG8_SCHED;
            PG8_LDA(At, 1, 1); PG8_STAGE(PG8_SB(1, 0), b3, voffB); PG8_STAGE(PG8_SB(1, 1), b3 + hstep, voffB); PG8_STAGE(PG8_SA(1, 0), a3, voffA);
            PG8_WAIT_V(8); PG8_WAIT_L(0); PG8_BAR; PG8_MMA(1, 0, At, B0); PG8_MMA(1, 1, At, B1); PG8_BAR; PG8_SCHED;
            } else {
            PG8_LDB(B0, 0, 0); PG8_SCHED; PG8_LDA(At, 0, 0); PG8_STAGE(PG8_SA(1, 1), a1 + hstep, voffA);
            PG8_WAIT_L(8); PG8_BAR; PG8_WAIT_L(0); PG8_MMA(0, 0, At, B0); PG8_BAR; PG8_SCHED;
            PG8_LDB(B1, 0, 1); PG8_STAGE(PG8_SB(0, 0), b2, voffB);
            PG8_BAR; PG8_WAIT_L(0); PG8_MMA(0, 1, At, B1); PG8_BAR;
            PG8_LDA(At, 0, 1); PG8_STAGE(PG8_SA(0, 0), a2, voffA);
            PG8_BAR; PG8_WAIT_L(0); PG8_MMA(1, 0, At, B0); PG8_BAR; PG8_SCHED;
            PG8_STAGE(PG8_SB(0, 1), b2 + hstep, voffB);
            PG8_WAIT_V(6); PG8_BAR; PG8_MMA(1, 1, At, B1); PG8_BAR;
            PG8_LDB(B0, 1, 0); PG8_SCHED; PG8_LDA(At, 1, 0); PG8_STAGE(PG8_SA(0, 1), a2 + hstep, voffA);
            PG8_WAIT_L(8); PG8_BAR; PG8_WAIT_L(0); PG8_MMA(0, 0, At, B0); PG8_BAR; PG8_SCHED;
            PG8_LDB(B1, 1, 1); PG8_STAGE(PG8_SB(1, 0), b3, voffB);
            PG8_BAR; PG8_WAIT_L(0); PG8_MMA(0, 1, At, B1); PG8_BAR;
            PG8_LDA(At, 1, 1); PG8_STAGE(PG8_SA(1, 0), a3, voffA);
            PG8_BAR; PG8_WAIT_L(0); PG8_MMA(1, 0, At, B0); PG8_BAR; PG8_SCHED;
            PG8_STAGE(PG8_SB(1, 1), b3 + hstep, voffB);
            PG8_WAIT_V(6); PG8_BAR; PG8_MMA(1, 1, At, B1); PG8_BAR;
            }
        }
        if constexpr (ALIGN_EPI) { if (wr == 0) PG8_BAR; }
        if constexpr (!Epi::AFTER_DRAIN) { E(acc, cur, wr, wc, fr, fq); S.done(cur); }
        if (!has_next) break;
#pragma unroll
        for (int a = 0; a < 2; ++a)
#pragma unroll
            for (int b = 0; b < 2; ++b)
#pragma unroll
                for (int m = 0; m < 4; ++m)
#pragma unroll
                    for (int n = 0; n < 2; ++n) acc[a][b][m][n] = (f32x4){0.f, 0.f, 0.f, 0.f};
        cur = nxt; cA = nA; cB = nB; ++ui;
        if constexpr (ALIGN_EPI) { if (wr == 1) PG8_BAR; }
    }
    PG8_WAIT_V(0);
    if constexpr (!ALIGN_EPI) { if (wr == 0) PG8_BAR; }
    PG8_BAR;
    if constexpr (Epi::AFTER_DRAIN) { E.fused(acc, cur, wr, wc, fr, fq, lds, wid, lane); S.done(cur); }
#undef PG8_SA
#undef PG8_SB
#undef PG8_STAGE
#undef PG8_LDA
#undef PG8_LDB
#undef PG8_MMA
#undef PG8_WAIT_V
#undef PG8_WAIT_L
#undef PG8_BAR
#undef PG8_SCHED
}
}
#ifndef PG8_SP2
#define PG8_SP2 true
#endif
#ifndef PG8_ALIGN
#define PG8_ALIGN true
#endif
#include <hip/hip_bf16.h>
#include <cmath>
namespace attn_body {
using bf16=__hip_bfloat16;
using bf16x8=__attribute__((ext_vector_type(8)))short;
using s16x4=__attribute__((ext_vector_type(4)))short;
using f32x16=__attribute__((ext_vector_type(16)))float;
using u32x4=__attribute__((ext_vector_type(4)))unsigned;
constexpr int D=64,DM=1024;
constexpr int NW=8,QBLK=32,QB=QBLK*NW,KVBLK=64;
__device__ __forceinline__ int crow(int r,int hi){return (r&3)+8*(r>>2)+4*hi;}
#define SBAR() __builtin_amdgcn_sched_barrier(0)
constexpr int NSLOT=3, SLOTB=8192;
constexpr int LDS_K=0, LDS_V=NSLOT*SLOTB, LDS_WS=3*NSLOT*SLOTB, LDS_OST=LDS_WS+NW*64*4, LDS_BYTES=LDS_OST+NW*8192;
constexpr float C2=0.125f*1.4426950408889634f;
__device__ __forceinline__ void glds16(const void*gsrc,unsigned lds_dst){unsigned keep;
  asm volatile("s_mov_b32 %0, m0\n\ts_mov_b32 m0, %2\n\ts_nop 0\n\tglobal_load_lds_dwordx4 %1, off\n\ts_mov_b32 m0, %0":"=&s"(keep):"v"(gsrc),"s"(lds_dst):"memory");}
__device__ __forceinline__ float max3f(float a,float b,float c){float r;asm("v_max3_f32 %0, %1, %2, %3":"=v"(r):"v"(a),"v"(b),"v"(c));return r;}
__device__ __forceinline__ float max2f(float a,float b){float r;asm("v_max_f32_e32 %0, %1, %2":"=v"(r):"v"(a),"v"(b));return r;}
__device__ __forceinline__ float fadd_s(float a,float b){float r;asm("v_add_f32_e32 %0, %1, %2":"=v"(r):"v"(a),"v"(b));return r;}
__device__ __forceinline__ float fsub_s(float a,float b){float r;asm("v_sub_f32_e32 %0, %1, %2":"=v"(r):"v"(a),"v"(b));return r;}
typedef float f32x2_t __attribute__((ext_vector_type(2))); typedef __bf16 bf16x2_t __attribute__((ext_vector_type(2)));
__device__ __forceinline__ unsigned cvtpk_s(float lo,float hi){f32x2_t v={lo,hi};bf16x2_t b=__builtin_convertvector(v,bf16x2_t);return __builtin_bit_cast(unsigned,b);}
#define WAIT_BAR(N) asm volatile("s_waitcnt vmcnt(" #N ") lgkmcnt(0)\n\ts_barrier":::"memory")

__device__ __forceinline__ void qkt(f32x16&p0,f32x16&p1,const char*Kslot,const bf16x8*qr,int r32,int hi){ const f32x16 negm=f32x16{};
  const char*kb=Kslot+hi*1024+r32*16;
  #pragma unroll
  for(int d0=0;d0<4;++d0){
    const bf16x8 b0=*reinterpret_cast<const bf16x8*>(kb+d0*2048);
    const bf16x8 b1=*reinterpret_cast<const bf16x8*>(kb+d0*2048+512);
    if(d0==0){p0=__builtin_amdgcn_mfma_f32_32x32x16_bf16(b0,qr[0],negm,0,0,0);p1=__builtin_amdgcn_mfma_f32_32x32x16_bf16(b1,qr[0],negm,0,0,0);}
    else{p0=__builtin_amdgcn_mfma_f32_32x32x16_bf16(b0,qr[d0],p0,0,0,0);p1=__builtin_amdgcn_mfma_f32_32x32x16_bf16(b1,qr[d0],p1,0,0,0);}}
}
typedef __attribute__((address_space(3))) const char* lds_cptr;
typedef short v4i16_t __attribute__((ext_vector_type(4)));
__device__ __forceinline__ void kload8(bf16x8*kf,lds_cptr kp){
  kf[0]=*(const __attribute__((address_space(3))) bf16x8*)(kp);      kf[1]=*(const __attribute__((address_space(3))) bf16x8*)(kp+512);
  kf[2]=*(const __attribute__((address_space(3))) bf16x8*)(kp+2048); kf[3]=*(const __attribute__((address_space(3))) bf16x8*)(kp+2560);
  kf[4]=*(const __attribute__((address_space(3))) bf16x8*)(kp+4096); kf[5]=*(const __attribute__((address_space(3))) bf16x8*)(kp+4608);
  kf[6]=*(const __attribute__((address_space(3))) bf16x8*)(kp+6144); kf[7]=*(const __attribute__((address_space(3))) bf16x8*)(kp+6656);
}
__device__ __forceinline__ void kload2(bf16x8*kf,lds_cptr kp,int j){ kf[2*j]=*(const __attribute__((address_space(3))) bf16x8*)(kp+j*2048); kf[2*j+1]=*(const __attribute__((address_space(3))) bf16x8*)(kp+j*2048+512); }
__device__ __forceinline__ s16x4 vtr(lds_cptr p){ return __builtin_bit_cast(s16x4,__builtin_amdgcn_ds_read_tr16_b64_v4i16((__attribute__((address_space(3))) v4i16_t*)p)); }
__device__ __forceinline__ float rowmax(const f32x16&p0,const f32x16&p1){
  float a=max3f(p0[0],p0[1],p1[0]),b=max3f(p0[2],p0[3],p1[1]);a=max3f(a,p1[2],p1[3]);
  #pragma unroll
  for(int r=4;r<16;r+=4){a=max3f(a,p0[r],p0[r+1]);b=max3f(b,p0[r+2],p0[r+3]);a=max3f(a,p1[r],p1[r+1]);b=max3f(b,p1[r+2],p1[r+3]);}
  const float m=max2f(a,b);
  auto rr=__builtin_amdgcn_permlane32_swap(__float_as_uint(m),__float_as_uint(m),false,false);
  return max2f(__uint_as_float(rr[0]),__uint_as_float(rr[1]));
}
__device__ __forceinline__ void pv(f32x16*o,int vb,bf16x8 pa0,bf16x8 pa1,bf16x8 pa2,bf16x8 pa3){
  #pragma unroll
  for(int d0=0;d0<4;++d0){s16x4 lo[4],hi[4];
    #pragma unroll
    for(int ks=0;ks<4;++ks){
      asm volatile("ds_read_b64_tr_b16 %0,%1 offset:%c2":"=&v"(lo[ks]):"v"(vb),"i"(d0*4096+ks*1024):"memory");
      asm volatile("ds_read_b64_tr_b16 %0,%1 offset:%c2":"=&v"(hi[ks]):"v"(vb),"i"(d0*4096+ks*1024+512):"memory");}
    asm volatile("s_waitcnt lgkmcnt(0)":::"memory");SBAR();
    #define PK(k) (bf16x8){lo[k][0],lo[k][1],lo[k][2],lo[k][3],hi[k][0],hi[k][1],hi[k][2],hi[k][3]}
    o[d0]=__builtin_amdgcn_mfma_f32_32x32x16_bf16(pa0,PK(0),o[d0],0,0,0);
    o[d0]=__builtin_amdgcn_mfma_f32_32x32x16_bf16(pa1,PK(1),o[d0],0,0,0);
    o[d0]=__builtin_amdgcn_mfma_f32_32x32x16_bf16(pa2,PK(2),o[d0],0,0,0);
    o[d0]=__builtin_amdgcn_mfma_f32_32x32x16_bf16(pa3,PK(3),o[d0],0,0,0);
    #undef PK
  }
}

#ifndef ATTN_STORE16
#define ATTN_STORE16(p,v) (*(u32x4*)(p)=(v))
#endif
template<int THRL,int MODE> __device__ __forceinline__ void attn_unit(const bf16*Qp,const bf16*__restrict__ Kh,const bf16*__restrict__ Vh,bf16*Op,const int q0,const int NT,char*shm,const float lam,const __attribute__((address_space(3))) float*gsub,const int wave_){
  int tid_=wave_*64+(int)__builtin_amdgcn_mbcnt_hi(~0u,__builtin_amdgcn_mbcnt_lo(~0u,0u)); asm volatile("":"+v"(tid_));
  const int tid=tid_,lane=tid&63,r32=lane&31,hi=lane>>5; const int wid=__builtin_amdgcn_readfirstlane(tid>>6);
  const bf16*Qw=Qp+(long)(q0+wid*QBLK)*DM;
  const unsigned lds0=(unsigned)(uintptr_t)shm;
  float*wsf=(float*)(shm+LDS_WS)+wid*64;
  const bf16*ksrc=Kh+(long)lane*DM+wid*8;
  const bf16*vsrc=Vh+(long)(16*(wid&3)+(lane>>2))*DM+(wid>>2)*32+(lane&3)*8;
  const unsigned kdst=lds0+LDS_K+wid*1024, vdst=lds0+LDS_V+wid*1024;
  #define DMA_K(t,slot) glds16(ksrc+(long)(t)*KVBLK*DM,(unsigned)__builtin_amdgcn_readfirstlane(kdst+(slot)))
  #define DMA_V(t,slot) do{ glds16(vsrc+(long)(t)*KVBLK*DM,(unsigned)__builtin_amdgcn_readfirstlane(vdst+2*(slot))); glds16(vsrc+(long)(t)*KVBLK*DM+64,(unsigned)__builtin_amdgcn_readfirstlane(vdst+2*(slot)+8192)); }while(0)
  const int vb0=(int)(lds0+LDS_V)+((lane>>4)&1)*32+(lane&3)*8+(4*hi+((lane&15)>>2))*64;
  const char*Kbase=shm+LDS_K; bf16x8 kf[8];
  const lds_cptr shm3=(lds_cptr)shm; const lds_cptr kp0=shm3+LDS_K+hi*1024+r32*16; const lds_cptr vp0=shm3+LDS_V+((lane>>4)&1)*32+(lane&3)*8+(4*hi+((lane&15)>>2))*64;
  DMA_K(0,0);DMA_V(0,0);DMA_K(1,SLOTB);
  bf16x8 qr[4];
  #pragma unroll
  for(int d0=0;d0<4;++d0)qr[d0]=*reinterpret_cast<const bf16x8*>(&Qw[(long)r32*DM+d0*16+hi*8]);
  float mhat=0.f,l_reg=0.f;f32x16 o[4];o[0]=f32x16{};o[1]=f32x16{};o[2]=f32x16{};o[3]=f32x16{};
  #define CMASK(P0,P1,t) do{}while(0)
  bool resc=false;
  #define START(P0,P1) do{ const float rm=rowmax(P0,P1); resc=false; \
    { const float dl=rm; mhat=fadd_s(mhat,dl); \
      _Pragma("unroll") for(int r=0;r<16;++r){P0[r]=fsub_s(P0[r],dl);P1[r]=fsub_s(P1[r],dl);} } \
    _Pragma("unroll") for(int r=0;r<16;++r)P0[r]=__builtin_amdgcn_exp2f(P0[r]); }while(0)
  #define RESC() do{ if(resc){ asm volatile("s_waitcnt lgkmcnt(0)":::"memory"); \
      _Pragma("unroll") for(int d_=0;d_<4;++d_) _Pragma("unroll") for(int r=0;r<16;++r)o[d_][r]*=wsf[crow(r,hi)]; } }while(0)
  f32x16 pA0,pA1,pB0,pB1;
  int sl_prev=0,sl_cur=0,sl_next=SLOTB;
  #define ROT() do{sl_prev=sl_cur;sl_cur=sl_next;sl_next=(sl_next==(NSLOT-1)*SLOTB)?0:sl_next+SLOTB;}while(0)
  DMA_K(2,2*SLOTB);
  WAIT_BAR(4);
  qkt(pA0,pA1,Kbase,qr,r32,hi);asm volatile("s_nop 15\n\ts_nop 7":"+v"(pA0),"+v"(pA1));CMASK(pA0,pA1,0);
  START(pA0,pA1);
  _Pragma("unroll") for(int r=0;r<16;++r)pA1[r]=__builtin_amdgcn_exp2f(pA1[r]);
  WAIT_BAR(0);
  DMA_K(3,0);DMA_V(1,SLOTB);
  ROT();
  kload8(kf,kp0+sl_cur);
  WAIT_BAR(3);
  s16x4 vlo[8],vhi[8]; u32x4 pw0,pw1,pw2,pw3;
  #define PKW(P,B) cvtpk_s(P[B],P[B+1])
  #define PAF(k) __builtin_bit_cast(bf16x8,pw##k)
  #define VFR(i) (bf16x8){vlo[i][0],vlo[i][1],vlo[i][2],vlo[i][3],vhi[i][0],vhi[i][1],vhi[i][2],vhi[i][3]}
  #define PIN(x) asm volatile("":"+v"(x))
  #define MX3(a,b,c) __builtin_fmaxf(__builtin_fmaxf((a),(b)),(c))
  #define GAPA(MF,A0,A1,A2,A3,W0,W1,PW) do{ MF; sacc+=A0; sacc+=A1; sacc+=A2; sacc+=A3; PIN(sacc); W0; W1; PIN(PW); SBAR(); }while(0)
  #define EX(v) __builtin_amdgcn_exp2f(v)
  #define GAPB(MF,X,B) do{ MF; X[B]=EX(X[B]-mhat); X[B+1]=EX(X[B+1]-mhat); PIN(X); SBAR(); }while(0)
  #define VRD2(i) do{ vlo[i]=vtr(vp_+(8192+((i)>>2)*4096+((i)&3)*1024)); vhi[i]=vtr(vp_+(8192+((i)>>2)*4096+((i)&3)*1024+512)); SBAR(); }while(0)
  #define VRD(i) do{ vlo[i]=vtr(vp_+(((i)>>2)*4096+((i)&3)*1024)); vhi[i]=vtr(vp_+(((i)>>2)*4096+((i)&3)*1024+512)); }while(0)
  #define KRD(G,j) do{ if(G){ kload2(kf,kp0+sl_next,j); SBAR(); } }while(0)
  #define STEP(C0,C1,P0,P1,t,GK,GV,GL) do{ SBAR(); \
    const lds_cptr vp_=vp0+2*sl_prev; \
    VRD(0); SBAR(); float sacc=(P0[0]+P0[1]); \
    GAPA(C0=__builtin_amdgcn_mfma_f32_32x32x16_bf16(kf[0],qr[0],f32x16{},0,0,0), P0[2],P0[3],P0[4],P0[5],     pw0[0]=PKW(P0,0), pw0[1]=PKW(P0,2), pw0); \
    VRD(4); SBAR(); GAPA(C1=__builtin_amdgcn_mfma_f32_32x32x16_bf16(kf[1],qr[0],f32x16{},0,0,0), P0[6],P0[7],P0[8],P0[9],     pw0[2]=PKW(P0,4), pw0[3]=PKW(P0,6), pw0); \
    VRD(1); SBAR(); GAPA(C0=__builtin_amdgcn_mfma_f32_32x32x16_bf16(kf[2],qr[1],C0,0,0,0),   P0[10],P0[11],P0[12],P0[13], pw1[0]=PKW(P0,8), pw1[1]=PKW(P0,10), pw1); \
    VRD(5); SBAR(); GAPA(C1=__builtin_amdgcn_mfma_f32_32x32x16_bf16(kf[3],qr[1],C1,0,0,0),   P0[14],P0[15],P1[0],P1[1],   pw1[2]=PKW(P0,12),pw1[3]=PKW(P0,14), pw1); \
    VRD(2); SBAR(); GAPA(C0=__builtin_amdgcn_mfma_f32_32x32x16_bf16(kf[4],qr[2],C0,0,0,0),   P1[2],P1[3],P1[4],P1[5],     pw2[0]=PKW(P1,0), pw2[1]=PKW(P1,2), pw2); \
    VRD(6); SBAR(); GAPA(C1=__builtin_amdgcn_mfma_f32_32x32x16_bf16(kf[5],qr[2],C1,0,0,0),   P1[6],P1[7],P1[8],P1[9],     pw2[2]=PKW(P1,4), pw2[3]=PKW(P1,6), pw2); \
    VRD(3); SBAR(); GAPA(C0=__builtin_amdgcn_mfma_f32_32x32x16_bf16(kf[6],qr[3],C0,0,0,0),   P1[10],P1[11],P1[12],P1[13], pw3[0]=PKW(P1,8), pw3[1]=PKW(P1,10), pw3); \
    VRD(7); SBAR(); GAPA(C1=__builtin_amdgcn_mfma_f32_32x32x16_bf16(kf[7],qr[3],C1,0,0,0),   P1[14],P1[15],0.f,0.f,       pw3[2]=PKW(P1,12),pw3[3]=PKW(P1,14), pw3); \
    l_reg+=sacc; \
    if(GK){DMA_K((t)+3,sl_cur);} if(GV){DMA_V((t)+1,sl_next);} \
    CMASK(C0,C1,t); \
    { float a=MX3(C0[0],C0[1],C1[0]),b=MX3(C0[2],C0[3],C1[1]); a=MX3(a,C1[2],C1[3]); \
      _Pragma("unroll") for(int r=4;r<16;r+=4){a=MX3(a,C0[r],C0[r+1]);b=MX3(b,C0[r+2],C0[r+3]);a=MX3(a,C1[r],C1[r+1]);b=MX3(b,C1[r+2],C1[r+3]);} \
      float rm=__builtin_fmaxf(a,b); { auto rr=__builtin_amdgcn_permlane32_swap(__float_as_uint(rm),__float_as_uint(rm),false,false); rm=__builtin_fmaxf(__uint_as_float(rr[0]),__uint_as_float(rr[1])); } \
      resc=false; \
      rm-=mhat; \
      if(__builtin_expect(__any(rm>(float)THRL),0)){ const float dl=__builtin_fmaxf(rm,0.f); mhat+=dl; \
        const float f=__builtin_amdgcn_exp2f(-dl); l_reg*=f; if(hi==0)wsf[r32]=f; resc=true; } } \
    SBAR(); \
    GAPB(o[0]=__builtin_amdgcn_mfma_f32_32x32x16_bf16(PAF(0),VFR(0),o[0],0,0,0), C0,0);  VRD2(0); \
    GAPB(o[1]=__builtin_amdgcn_mfma_f32_32x32x16_bf16(PAF(0),VFR(4),o[1],0,0,0), C0,2);  VRD2(4); \
    KRD(GL,0); GAPB(o[0]=__builtin_amdgcn_mfma_f32_32x32x16_bf16(PAF(1),VFR(1),o[0],0,0,0), C0,4);  VRD2(1); \
    KRD(GL,1); GAPB(o[1]=__builtin_amdgcn_mfma_f32_32x32x16_bf16(PAF(1),VFR(5),o[1],0,0,0), C0,6);  VRD2(5); \
    KRD(GL,2); GAPB(o[0]=__builtin_amdgcn_mfma_f32_32x32x16_bf16(PAF(2),VFR(2),o[0],0,0,0), C0,8);  VRD2(2); \
    KRD(GL,3); GAPB(o[1]=__builtin_amdgcn_mfma_f32_32x32x16_bf16(PAF(2),VFR(6),o[1],0,0,0), C0,10); VRD2(6); \
    GAPB(o[0]=__builtin_amdgcn_mfma_f32_32x32x16_bf16(PAF(3),VFR(3),o[0],0,0,0), C0,12); VRD2(3); \
    GAPB(o[1]=__builtin_amdgcn_mfma_f32_32x32x16_bf16(PAF(3),VFR(7),o[1],0,0,0), C0,14); VRD2(7); \
    GAPB(o[2]=__builtin_amdgcn_mfma_f32_32x32x16_bf16(PAF(0),VFR(0),o[2],0,0,0), C1,0); \
    GAPB(o[3]=__builtin_amdgcn_mfma_f32_32x32x16_bf16(PAF(0),VFR(4),o[3],0,0,0), C1,2); \
    GAPB(o[2]=__builtin_amdgcn_mfma_f32_32x32x16_bf16(PAF(1),VFR(1),o[2],0,0,0), C1,4); \
    GAPB(o[3]=__builtin_amdgcn_mfma_f32_32x32x16_bf16(PAF(1),VFR(5),o[3],0,0,0), C1,6); \
    GAPB(o[2]=__builtin_amdgcn_mfma_f32_32x32x16_bf16(PAF(2),VFR(2),o[2],0,0,0), C1,8); \
    GAPB(o[3]=__builtin_amdgcn_mfma_f32_32x32x16_bf16(PAF(2),VFR(6),o[3],0,0,0), C1,10); \
    GAPB(o[2]=__builtin_amdgcn_mfma_f32_32x32x16_bf16(PAF(3),VFR(3),o[2],0,0,0), C1,12); \
    GAPB(o[3]=__builtin_amdgcn_mfma_f32_32x32x16_bf16(PAF(3),VFR(7),o[3],0,0,0), C1,14); \
    }while(0)
  int t=1;
  #undef CMASK
  #define CMASK(P0,P1,t) do{}while(0)
  for(;t+5<NT;t+=2){
    STEP(pB0,pB1,pA0,pA1,t,true,true,true);     WAIT_BAR(3); RESC(); ROT();
    STEP(pA0,pA1,pB0,pB1,t+1,true,true,true);   WAIT_BAR(3); RESC(); ROT();
  }
  #undef CMASK
  #define CMASK(P0,P1,t) do{}while(0)
  #define ENDW(tt) do{ if((tt)+3<NT){WAIT_BAR(3);} else if((tt)+2<NT){WAIT_BAR(2);} else {WAIT_BAR(0);} }while(0)
  for(;t+1<NT;t+=2){
    STEP(pB0,pB1,pA0,pA1,t,(t+3<NT),(t+1<NT),(t+1<NT));       ENDW(t);   RESC(); ROT();
    STEP(pA0,pA1,pB0,pB1,t+1,(t+4<NT),(t+2<NT),(t+2<NT));     ENDW(t+1); RESC(); ROT();
  }
  STEP(pB0,pB1,pA0,pA1,NT-1,false,false,false); RESC();
  { float sacc=pB0[0]+pB0[1]; _Pragma("unroll") for(int r=2;r<16;++r)sacc+=pB0[r]; _Pragma("unroll") for(int r=0;r<16;++r)sacc+=pB1[r]; l_reg+=sacc;
    pw0=(u32x4){PKW(pB0,0),PKW(pB0,2),PKW(pB0,4),PKW(pB0,6)};pw1=(u32x4){PKW(pB0,8),PKW(pB0,10),PKW(pB0,12),PKW(pB0,14)};pw2=(u32x4){PKW(pB1,0),PKW(pB1,2),PKW(pB1,4),PKW(pB1,6)};pw3=(u32x4){PKW(pB1,8),PKW(pB1,10),PKW(pB1,12),PKW(pB1,14)};
    SBAR(); pv(o,vb0+2*sl_cur,PAF(0),PAF(1),PAF(2),PAF(3)); }
  #undef PKW
  #undef PAF
  #undef VFR
  #undef PIN
  #undef MX3
  #undef GAPA
  #undef GAPB
  #undef EX
  #undef VRD
  #undef VRD2
  #undef KRD
  #undef STEP
  #undef ENDW
  {auto rr=__builtin_amdgcn_permlane32_swap(__float_as_uint(l_reg),__float_as_uint(l_reg),false,false);l_reg=__uint_as_float(rr[0])+__uint_as_float(rr[1]);}
  if(hi==0)wsf[32+r32]=l_reg;asm volatile("s_waitcnt lgkmcnt(0)":::"memory");
  float rli[16];
  #pragma unroll
  for(int r=0;r<16;++r)rli[r]=__builtin_amdgcn_rcpf(wsf[32+crow(r,hi)]);
  bf16*Ow=Op+(long)(q0+wid*QBLK)*DM;
  { bf16*stg=(bf16*)(shm+LDS_OST)+wid*4096;
    if constexpr(MODE==1){
      #pragma unroll
      for(int r=0;r<16;++r){const int orow=crow(r,hi);
        #pragma unroll
        for(int d0=0;d0<4;++d0)stg[orow*128+d0*32+r32]=__float2bfloat16(o[d0][r]*rli[r]);}
    } else {
      float ss[16];
      #pragma unroll
      for(int r=0;r<16;++r){const int orow=crow(r,hi); float s=0.f;
        #pragma unroll
        for(int d0=0;d0<4;++d0){const float dd=__bfloat162float(stg[orow*128+d0*32+r32])-lam*(o[d0][r]*rli[r]); o[d0][r]=dd; s+=dd*dd;}
        ss[r]=s;}
      #pragma unroll
      for(int r=0;r<16;++r){float s=ss[r]; s+=__shfl_xor(s,1); s+=__shfl_xor(s,2); s+=__shfl_xor(s,4); s+=__shfl_xor(s,8); s+=__shfl_xor(s,16); ss[r]=1.f/sqrtf(s*(1.f/128.f)+1e-6f);}
      float gg[4];
      #pragma unroll
      for(int d0=0;d0<4;++d0)gg[d0]=gsub[d0*32+r32];
      #pragma unroll
      for(int r=0;r<16;++r){const int orow=crow(r,hi);
        #pragma unroll
        for(int d0=0;d0<4;++d0)stg[orow*128+d0*32+r32]=__float2bfloat16(o[d0][r]*ss[r]*gg[d0]);}
      asm volatile("s_waitcnt lgkmcnt(0)":::"memory");
      #pragma unroll
      for(int i=0;i<8;++i){const int row=i*4+(lane>>4),ch=lane&15; const u32x4 v=*(const u32x4*)(stg+row*128+ch*8); ATTN_STORE16(Ow+(long)row*DM+ch*8,v);}
    } }
  asm volatile("s_waitcnt lgkmcnt(0)\n\ts_barrier":::"memory");
  #undef DMA_K
  #undef DMA_V
  #undef CMASK
  #undef START
  #undef RESC
  #undef ROT
}
constexpr int ATTN_LDS_BYTES=LDS_BYTES;
#undef SBAR
#undef WAIT_BAR
}

#define GAS __attribute__((address_space(1)))
#define LAS __attribute__((address_space(3)))
typedef unsigned short bf16;
typedef unsigned v4u __attribute__((ext_vector_type(4)));
typedef unsigned v2u __attribute__((ext_vector_type(2)));
typedef float f32x4 __attribute__((ext_vector_type(4)));
typedef float f32x16 __attribute__((ext_vector_type(16)));
typedef short bf16x8 __attribute__((ext_vector_type(8)));
typedef short s16x4 __attribute__((ext_vector_type(4)));
#define LDS_WAIT() asm volatile("s_waitcnt lgkmcnt(0)" ::: "memory")

constexpr int DMODEL = 1024, NIN = 9728, FFH = 2816;
constexpr int S_P = 4096, S_S = 2048;
constexpr int CT = 32768, NCHUNK = 3;
constexpr float EPS = 1e-6f;
constexpr float C2 = 0.18033688011112042f;
constexpr int LDS_BYTES = 147456;
constexpr int NWAVES = 8;

constexpr size_t MiB = 1u << 20;
constexpr size_t WS_MOD = 1 * MiB, WS_ROPE = 2 * MiB;
constexpr size_t WS_WIN = 4 * MiB, WS_WA = 23 * MiB, WS_WB = 25 * MiB, WS_WOUT = 26 * MiB, WS_WGU = 28 * MiB, WS_WDN = 39 * MiB;
constexpr size_t WS_H = 48 * MiB;
constexpr size_t WS_QA = 112 * MiB, WS_KA = 176 * MiB, WS_VA = 240 * MiB, WS_G0 = 304 * MiB  , WS_G1 = 592 * MiB, WS_G2 = 656 * MiB;
constexpr size_t WS_O1 = 720 * MiB, WS_O2 = 784 * MiB, WS_OG = 848 * MiB  , WS_LSE = 944 * MiB  , WS_END = 948 * MiB;
constexpr size_t WS_OA = WS_O1  , WS_OB = WS_G0, WS_MRG = WS_KA, WS_ACT = WS_VA, WS_X1 = WS_QA  , WS_X2 = WS_KA  ;

struct Args {
    const float *x_prompt, *x_sample, *c_prompt, *c_sample, *w_ada, *b_ada, *g_mix, *w_in, *lq1, *lk1, *lq2, *lk2, *g_subln, *w_a, *w_b, *w_out, *g_ffn, *w_gu, *w_down, *g_final;
    float* out; unsigned char* ws;
};

typedef const __attribute__((address_space(4))) Args* CArgs;
__device__ __forceinline__ CArgs argp() { CArgs p = (CArgs)__builtin_amdgcn_kernarg_segment_ptr(); asm volatile("" : "+s"(p)); return p; }

__device__ __forceinline__ float wave_sum(float v) {
#pragma unroll
    for (int o = 1; o < 64; o <<= 1) v += __shfl_xor(v, o);
    return v;
}
__device__ __forceinline__ unsigned f2bf(float f) { unsigned u = __builtin_bit_cast(unsigned, f); return (u + 0x7fffu + ((u >> 16) & 1u)) >> 16; }
__device__ __forceinline__ unsigned pk2(float lo, float hi) { return f2bf(lo) | (f2bf(hi) << 16); }
__device__ __forceinline__ float bflo(unsigned w) { return __builtin_bit_cast(float, w << 16); }
__device__ __forceinline__ float bfhi(unsigned w) { return __builtin_bit_cast(float, w & 0xffff0000u); }

__device__ __forceinline__ int maprow(int mode, int n) {
    if (mode == 1) {
        const bool qk = (n < 2048) || (n >= 3072 && n < 7680 && ((n - 3072) % 1536) < 1024);
        const int i = n & 63;
        if (qk && i < 16) return n - i + ((i < 8) ? 2 * i : 2 * (i - 8) + 1);
        return n;
    }
    if (mode == 2) {
        const bool up = n >= FFH; const int j = up ? n - FFH : n;
        return 8 * (j >> 2) + (j & 3) + (up ? 4 : 0);
    }
    return n;
}
__device__ __forceinline__ void p0_transpose_item(const float* W, int K, int N, bf16* WT, int mode, LAS float* scr, int item, int lane) {
    const int nblk = N / 32, kb = item / nblk, nb = item % nblk, k0 = 64 * kb, n0 = 32 * nb;
#pragma unroll 8
    for (int i = 0; i < 32; ++i) { const int kk = 2 * i + (lane >> 5); scr[kk * 33 + (lane & 31)] = W[(size_t)(k0 + kk) * N + n0 + (lane & 31)]; }
    LDS_WAIT(); asm volatile("" ::: "memory");
    const int c = lane & 7;
#pragma unroll
    for (int j = 0; j < 4; ++j) { const int n = (lane >> 3) + 8 * j; const LAS float* s = scr + (8 * c) * 33 + n;
        v4u o; o.x = pk2(s[0 * 33], s[1 * 33]); o.y = pk2(s[2 * 33], s[3 * 33]); o.z = pk2(s[4 * 33], s[5 * 33]); o.w = pk2(s[6 * 33], s[7 * 33]);
        *(GAS v4u*)(WT + (size_t)maprow(mode, n0 + n) * K + k0 + 8 * c) = o; }
    LDS_WAIT(); asm volatile("" ::: "memory");
}
__constant__ double ROPE_INVREV[8] = {0.15915494309189535, 0.03086376340470123, 0.005985185712713705, 0.001160663641240061,
                                      0.00022507907903927653, 4.364795279280289e-05, 8.464330808241401e-06, 1.6414262627950345e-06};

__device__ __forceinline__ void p0_prologue(LAS unsigned char* lds, int tid, int lane, int wave, int vcu, int G) {
    CArgs ap = argp(); unsigned char* ws = ap->ws;
    LAS float* scr = (LAS float*)(lds + wave * 16384);
    const int gw = vcu * NWAVES + wave, NGW = G * NWAVES;
    constexpr int I_IN = 16 * (NIN / 32), I_A = 16 * 32, I_B = 8 * 32, I_O = 16 * 32, I_GU = 16 * (2 * FFH / 32), I_DN = (FFH / 64) * 32;
    constexpr int NITEMS = I_IN + I_A + I_B + I_O + I_GU + I_DN;
    for (int it = gw; it < NITEMS; it += NGW) {
        int r = it;
        if (r < I_IN) { p0_transpose_item(ap->w_in, 1024, NIN, (bf16*)(ws + WS_WIN), 1, scr, r, lane); continue; } r -= I_IN;
        if (r < I_A) { p0_transpose_item(ap->w_a, 1024, 1024, (bf16*)(ws + WS_WA), 0, scr, r, lane); continue; } r -= I_A;
        if (r < I_B) { p0_transpose_item(ap->w_b, 512, 1024, (bf16*)(ws + WS_WB), 0, scr, r, lane); continue; } r -= I_B;
        if (r < I_O) { p0_transpose_item(ap->w_out, 1024, 1024, (bf16*)(ws + WS_WOUT), 0, scr, r, lane); continue; } r -= I_O;
        if (r < I_GU) { p0_transpose_item(ap->w_gu, 1024, 2 * FFH, (bf16*)(ws + WS_WGU), 2, scr, r, lane); continue; } r -= I_GU;
        p0_transpose_item(ap->w_down, FFH, 1024, (bf16*)(ws + WS_WDN), 0, scr, r, lane);
    }
    for (int idx = blockIdx.x * 512 + tid; idx < 4096 * 8; idx += G * 512) {
        const int pos = idx >> 3, i = idx & 7;
        const double rev = (double)pos * ROPE_INVREV[i]; const float fr = (float)(rev - __builtin_floor(rev));
        float2 cs; cs.x = __builtin_amdgcn_cosf(fr); cs.y = __builtin_amdgcn_sinf(fr);
        ((float2*)(ws + WS_ROPE))[idx] = cs;
    }
    __syncthreads();
    const int bx = blockIdx.x;
    if (bx < 192) {
        const int n0 = bx * 32, b = lane & 31, h = lane >> 5;
        const float* crow_ = (b < 16) ? ap->c_prompt + (size_t)b * 1024 : ap->c_sample + (size_t)(b - 16) * 1024;
        f32x16 acc = {};
#pragma unroll 4
        for (int i = 0; i < 16; ++i) {
            const int k = 128 * wave + 8 * i + 4 * h;
            const f32x4 c4 = *(const f32x4*)(crow_ + k);
#pragma unroll
            for (int e = 0; e < 4; ++e) {
                const float cv = c4[e], sv = cv / (1.f + __expf(-cv));
                const float wv = ap->w_ada[(size_t)(k + e) * 6144 + n0 + (lane & 31)];
                acc = __builtin_amdgcn_mfma_f32_32x32x2f32(sv, wv, acc, 0, 0, 0);
            }
        }
        LAS float* red = (LAS float*)lds;
#pragma unroll
        for (int r = 0; r < 16; ++r) red[(wave * 16 + r) * 64 + lane] = acc[r];
        __syncthreads();
#pragma unroll
        for (int j = 0; j < 2; ++j) {
            const int o = tid + 512 * j, nn = o & 31, bb = o >> 5;
            const int hh = (bb >> 2) & 1, r = (bb & 3) + 4 * (bb >> 3), ln = nn + 32 * hh;
            float s = ap->b_ada[n0 + nn];
#pragma unroll
            for (int w = 0; w < 8; ++w) s += red[(w * 16 + r) * 64 + ln];
            ((float*)(ws + WS_MOD))[(size_t)bb * 6144 + n0 + nn] = s;
        }
    }
    __syncthreads();
}

__device__ __forceinline__ f32x4 ld4(const float* p) { return *(const GAS f32x4*)p; }
__device__ __forceinline__ f32x4 ld4(const bf16* p) { const v2u w = *(const GAS v2u*)p; return (f32x4){bflo(w.x), bfhi(w.x), bflo(w.y), bfhi(w.y)}; }
template <class T> __device__ __forceinline__ void rows_norm_mod(const T* xsrc, bf16* dst, const float* gain, const float* mod, int sh_idx, int sc_idx, int S, int b0, int gw, int NGW, int lane) {
    f32x4 g[4];
#pragma unroll
    for (int j = 0; j < 4; ++j) g[j] = *(const f32x4*)(gain + 4 * lane + 256 * j);
    for (int row = gw; row < CT; row += NGW) {
        const int b = b0 + row / S;
        const T* xr = xsrc + (size_t)row * 1024 + 4 * lane;
        f32x4 v[4]; float ss = 0.f;
#pragma unroll
        for (int j = 0; j < 4; ++j) { v[j] = ld4(xr + 256 * j); ss += (v[j].x * v[j].x + v[j].y * v[j].y) + (v[j].z * v[j].z + v[j].w * v[j].w); }
        const float rstd = 1.f / sqrtf(wave_sum(ss) * (1.f / 1024.f) + EPS);
        const float* mb = mod + (size_t)b * 6144;
        GAS unsigned long long* o8 = (GAS unsigned long long*)(dst + (size_t)row * 1024) + lane;
#pragma unroll
        for (int j = 0; j < 4; ++j) {
            const f32x4 sc = *(const f32x4*)(mb + sc_idx * 1024 + 4 * lane + 256 * j), sh = *(const f32x4*)(mb + sh_idx * 1024 + 4 * lane + 256 * j);
            const f32x4 h = v[j] * rstd * g[j] * (1.f + sc) + sh;
            o8[64 * j] = (unsigned long long)pk2(h.x, h.y) | ((unsigned long long)pk2(h.z, h.w) << 32);
        }
    }
}
__device__ __forceinline__ void rows_final_norm(const bf16* x2, float* out, const float* gain, int gw, int NGW, int lane) {
    f32x4 g[4];
#pragma unroll
    for (int j = 0; j < 4; ++j) g[j] = *(const f32x4*)(gain + 4 * lane + 256 * j);
    for (int row = gw; row < CT; row += NGW) {
        const bf16* xr = x2 + (size_t)row * 1024 + 4 * lane;
        GAS f32x4* orow = (GAS f32x4*)(out + (size_t)row * 1024) + lane;
        f32x4 v[4]; float ss = 0.f;
#pragma unroll
        for (int j = 0; j < 4; ++j) { v[j] = ld4(xr + 256 * j); ss += (v[j].x * v[j].x + v[j].y * v[j].y) + (v[j].z * v[j].z + v[j].w * v[j].w); }
        const float rstd = 1.f / sqrtf(wave_sum(ss) * (1.f / 1024.f) + EPS);
#pragma unroll
        for (int j = 0; j < 4; ++j) orow[64 * j] = v[j] * rstd * g[j];
    }
}
__device__ __forceinline__ void rows_combine(int gw, int NGW, int lane) {
    CArgs ap = argp(); unsigned char* ws = ap->ws;
    const bf16* OG = (const bf16*)(ws + WS_OG); const float* LSE = (const float*)(ws + WS_LSE); bf16* OB = (bf16*)(ws + WS_OB);
    for (int row = gw; row < CT; row += NGW) {
        const int hd = lane >> 3;
        const float l0 = LSE[((size_t)0 * CT + row) * 8 + hd], l1 = LSE[((size_t)1 * CT + row) * 8 + hd], l2 = LSE[((size_t)2 * CT + row) * 8 + hd];
        const float mx = fmaxf(l0, fmaxf(l1, l2));
        float w0 = __builtin_amdgcn_exp2f(l0 - mx), w1 = __builtin_amdgcn_exp2f(l1 - mx), w2 = __builtin_amdgcn_exp2f(l2 - mx);
        const float inv = 1.f / (w0 + w1 + w2); w0 *= inv; w1 *= inv; w2 *= inv;
        const v4u g0 = *(const v4u*)(OG + ((size_t)0 * CT + row) * 512 + 8 * lane), g1 = *(const v4u*)(OG + ((size_t)1 * CT + row) * 512 + 8 * lane), g2 = *(const v4u*)(OG + ((size_t)2 * CT + row) * 512 + 8 * lane);
        v4u ob;
#pragma unroll
        for (int i = 0; i < 4; ++i) ob[i] = pk2(w0 * bflo(g0[i]) + w1 * bflo(g1[i]) + w2 * bflo(g2[i]), w0 * bfhi(g0[i]) + w1 * bfhi(g1[i]) + w2 * bfhi(g2[i]));
        *(v4u*)(OB + (size_t)row * 512 + 8 * lane) = ob;
    }
}

using pg8::Unit;
typedef pg8::f32x4 pf4;
__device__ __forceinline__ v4u pack8(const pf4 v0, const pf4 v1) { v4u w; w.x = pg8::cvt_pk_bf16(v0[0], v0[1]); w.y = pg8::cvt_pk_bf16(v0[2], v0[3]); w.z = pg8::cvt_pk_bf16(v1[0], v1[1]); w.w = pg8::cvt_pk_bf16(v1[2], v1[3]); return w; }
__device__ __forceinline__ float sigm(float x) { return __builtin_amdgcn_rcpf(1.f + __expf(-x)); }

struct EpiIn {
    static constexpr bool PERM = true, AFTER_DRAIN = false;
    unsigned char* ws; int S;
    __device__ __forceinline__ void operator()(const pf4 (&acc)[2][2][4][2], const Unit& u, int wr, int wc, int fr, int fq) const {
        int pm_ = u.pm, pn_ = u.pn; asm volatile("" : "+s"(pm_), "+s"(pn_)); const Unit uu{pm_, pn_};
        const int pn = uu.pn; int kind, ldc = 1024, ct; size_t base;
        if (pn < 4) { kind = 1; base = WS_QA; ct = pn; }
        else if (pn < 8) { kind = 2; base = WS_KA; ct = pn - 4; }
        else if (pn < 12) { kind = 0; base = WS_VA; ct = pn - 8; }
        else if (pn < 30) { const int q = pn - 12, g = q / 6, r = q % 6, part = r >> 1; ct = r & 1; ldc = 512; base = WS_G0 + (size_t)(g * 3 + part) * 32 * MiB; kind = part == 0 ? 1 : (part == 1 ? 2 : 0); }
        else if (pn < 34) { kind = 3; base = WS_G1; ct = pn - 30; }
        else { kind = 3; base = WS_G2; ct = pn - 34; }
        bf16* O = (bf16*)(ws + base);
        const int row0 = uu.pm * 256 + wr * 64 + fr, col0 = ct * 256 + wc * 32 + 8 * fq;
        const bool ropew = (kind == 1 || kind == 2) && ((wc & 1) == 0); const bool ropel = fq < 2;
        const float sc = kind == 1 ? C2 : 1.f;
        const float* rope = (const float*)(ws + WS_ROPE);
        if (ropew) {
#pragma unroll
            for (int ai = 0; ai < 2; ++ai) {
            pf4 cs0[4], cs1[4];
#pragma unroll
            for (int q = 0; q < 4; ++q) { const int row = row0 + ai * 128 + q * 16; const float* rp = rope + ((size_t)(row % S) * 8 + 4 * (fq & 1)) * 2; cs0[q] = *(const pf4*)rp; cs1[q] = *(const pf4*)(rp + 4); }
            asm volatile("" ::: "memory");
#pragma unroll
            for (int q = 0; q < 4; ++q) {
                const int m = q, row = row0 + ai * 128 + m * 16;
                bf16* rowp = O + (size_t)row * ldc + col0;
#pragma unroll
                for (int bj = 0; bj < 2; ++bj) {
                    pf4 v0 = acc[ai][bj][m][0], v1 = acc[ai][bj][m][1];
                    pf4 r0, r1;
                    r0[0] = v0[0] * cs0[q][0] - v0[1] * cs0[q][1]; r0[1] = v0[1] * cs0[q][0] + v0[0] * cs0[q][1];
                    r0[2] = v0[2] * cs0[q][2] - v0[3] * cs0[q][3]; r0[3] = v0[3] * cs0[q][2] + v0[2] * cs0[q][3];
                    r1[0] = v1[0] * cs1[q][0] - v1[1] * cs1[q][1]; r1[1] = v1[1] * cs1[q][0] + v1[0] * cs1[q][1];
                    r1[2] = v1[2] * cs1[q][2] - v1[3] * cs1[q][3]; r1[3] = v1[3] * cs1[q][2] + v1[2] * cs1[q][3];
                    if (ropel) { v0 = r0; v1 = r1; }
                    v0 = v0 * sc; v1 = v1 * sc;
                    *(v4u*)(rowp + bj * 128) = pack8(v0, v1);
                }
            }
            asm volatile("" ::: "memory");
            }
        } else {
#pragma unroll
            for (int ai = 0; ai < 2; ++ai)
#pragma unroll
                for (int m = 0; m < 4; ++m) {
                    const int row = row0 + ai * 128 + m * 16;
                    bf16* rowp = O + (size_t)row * ldc + col0;
#pragma unroll
                    for (int bj = 0; bj < 2; ++bj) {
                        pf4 v0 = acc[ai][bj][m][0], v1 = acc[ai][bj][m][1];
                        if (kind == 3) {
#pragma unroll
                            for (int e = 0; e < 4; ++e) { v0[e] = sigm(v0[e]); v1[e] = sigm(v1[e]); }
                        }
                        v0 = v0 * sc; v1 = v1 * sc;
                        *(v4u*)(rowp + bj * 128) = pack8(v0, v1);
                    }
                }
        }
    }
};
struct EpiGate {
    static constexpr bool PERM = true, AFTER_DRAIN = false;
    const bf16* gate; bf16* O; int mode;
    __device__ __forceinline__ void operator()(const pf4 (&acc)[2][2][4][2], const Unit& u, int wr, int wc, int fr, int fq) const {
        int pm_ = u.pm, pn_ = u.pn; asm volatile("" : "+s"(pm_), "+s"(pn_)); const Unit uu{pm_, pn_};
        const int row0 = uu.pm * 256 + wr * 64 + fr, col0 = uu.pn * 256 + wc * 32 + 8 * fq;
#pragma unroll
        for (int ai = 0; ai < 2; ++ai) {
            v4u gv[4][2], pv[4][2];
#pragma unroll
            for (int m = 0; m < 4; ++m)
#pragma unroll
                for (int bj = 0; bj < 2; ++bj) { const size_t off = (size_t)(row0 + ai * 128 + m * 16) * 1024 + col0 + bj * 128;
                    gv[m][bj] = *(const v4u*)(gate + off); pv[m][bj] = mode ? *(const v4u*)(O + off) : (v4u){0u, 0u, 0u, 0u}; }
            asm volatile("" ::: "memory");
#pragma unroll
            for (int m = 0; m < 4; ++m)
#pragma unroll
                for (int bj = 0; bj < 2; ++bj) { const size_t off = (size_t)(row0 + ai * 128 + m * 16) * 1024 + col0 + bj * 128;
                    const v4u g = gv[m][bj], p = pv[m][bj];
                    pf4 v0 = acc[ai][bj][m][0], v1 = acc[ai][bj][m][1];
                    v0[0] = v0[0] * bflo(g.x) + bflo(p.x); v0[1] = v0[1] * bfhi(g.x) + bfhi(p.x); v0[2] = v0[2] * bflo(g.y) + bflo(p.y); v0[3] = v0[3] * bfhi(g.y) + bfhi(p.y);
                    v1[0] = v1[0] * bflo(g.z) + bflo(p.z); v1[1] = v1[1] * bfhi(g.z) + bfhi(p.z); v1[2] = v1[2] * bflo(g.w) + bflo(p.w); v1[3] = v1[3] * bfhi(g.w) + bfhi(p.w);
                    *(v4u*)(O + off) = pack8(v0, v1); }
            asm volatile("" ::: "memory");
        }
    }
};
template <bool IN_BF16> struct EpiRes {
    static constexpr bool PERM = true, AFTER_DRAIN = false;
    const void* base; bf16* out; const float* mod; int gidx, S, b0;
    __device__ __forceinline__ void operator()(const pf4 (&acc)[2][2][4][2], const Unit& u, int wr, int wc, int fr, int fq) const {
        int pm_ = u.pm, pn_ = u.pn; asm volatile("" : "+s"(pm_), "+s"(pn_)); const Unit uu{pm_, pn_};
        const int row0 = uu.pm * 256 + wr * 64 + fr, col0 = uu.pn * 256 + wc * 32 + 8 * fq;
        const float* gp = mod + (size_t)(b0 + (uu.pm * 256) / S) * 6144 + gidx * 1024 + col0;
        pf4 gt[2][2];
#pragma unroll
        for (int bj = 0; bj < 2; ++bj) { gt[bj][0] = *(const pf4*)(gp + bj * 128); gt[bj][1] = *(const pf4*)(gp + bj * 128 + 4); }
#pragma unroll
        for (int q = 0; q < 4; ++q) {
            pf4 xb[2][2][2];
#pragma unroll
            for (int mm = 0; mm < 2; ++mm)
#pragma unroll
                for (int bj = 0; bj < 2; ++bj) { const size_t off = (size_t)(row0 + (q >> 1) * 128 + ((q & 1) * 2 + mm) * 16) * 1024 + col0 + bj * 128;
                    if (IN_BF16) { const v4u w = *(const v4u*)((const bf16*)base + off);
                        xb[mm][bj][0] = (pf4){bflo(w.x), bfhi(w.x), bflo(w.y), bfhi(w.y)}; xb[mm][bj][1] = (pf4){bflo(w.z), bfhi(w.z), bflo(w.w), bfhi(w.w)}; }
                    else { xb[mm][bj][0] = *(const pf4*)((const float*)base + off); xb[mm][bj][1] = *(const pf4*)((const float*)base + off + 4); } }
            asm volatile("" ::: "memory");
#pragma unroll
            for (int mm = 0; mm < 2; ++mm)
#pragma unroll
                for (int bj = 0; bj < 2; ++bj) { const int ai = q >> 1, m = (q & 1) * 2 + mm; const size_t off = (size_t)(row0 + ai * 128 + m * 16) * 1024 + col0 + bj * 128;
                    *(v4u*)(out + off) = pack8(xb[mm][bj][0] + gt[bj][0] * acc[ai][bj][m][0], xb[mm][bj][1] + gt[bj][1] * acc[ai][bj][m][1]); }
            asm volatile("" ::: "memory");
        }
    }
};
struct EpiGU {
    static constexpr bool PERM = true, AFTER_DRAIN = false;
    bf16* act;
    __device__ __forceinline__ void operator()(const pf4 (&acc)[2][2][4][2], const Unit& u, int wr, int wc, int fr, int fq) const {
        int pm_ = u.pm, pn_ = u.pn; asm volatile("" : "+s"(pm_), "+s"(pn_)); const Unit uu{pm_, pn_};
        const int row0 = uu.pm * 256 + wr * 64 + fr, col0 = uu.pn * 128 + wc * 16 + 4 * fq;
#pragma unroll
        for (int ai = 0; ai < 2; ++ai)
#pragma unroll
            for (int m = 0; m < 4; ++m) {
                bf16* rowp = act + (size_t)(row0 + ai * 128 + m * 16) * FFH + col0;
#pragma unroll
                for (int bj = 0; bj < 2; ++bj) {
                    const pf4 g = acc[ai][bj][m][0], up = acc[ai][bj][m][1]; pf4 r;
#pragma unroll
                    for (int e = 0; e < 4; ++e) r[e] = g[e] * sigm(g[e]) * up[e];
                    v2u w; w.x = pg8::cvt_pk_bf16(r[0], r[1]); w.y = pg8::cvt_pk_bf16(r[2], r[3]);
                    *(v2u*)(rowp + bj * 64) = w;
                }
                asm volatile("" ::: "memory");
            }
    }
};

__device__ __forceinline__ float halfmax(float m) { auto rr = __builtin_amdgcn_permlane32_swap(__float_as_uint(m), __float_as_uint(m), false, false); return fmaxf(__uint_as_float(rr[0]), __uint_as_float(rr[1])); }
__device__ __forceinline__ float halfsum(float m) { auto rr = __builtin_amdgcn_permlane32_swap(__float_as_uint(m), __float_as_uint(m), false, false); return __uint_as_float(rr[0]) + __uint_as_float(rr[1]); }
typedef short v4i16_t __attribute__((ext_vector_type(4)));
__device__ __forceinline__ s16x4 trrd(LAS unsigned char* p) { return __builtin_bit_cast(s16x4, __builtin_amdgcn_ds_read_tr16_b64_v4i16((LAS v4i16_t*)p)); }
__device__ __forceinline__ void dil_unit(const bf16* Qg, const bf16* Kg, const bf16* Vg, bf16* Og, float* Lg, int r, int n, int dil, int T, LAS unsigned char* wl, int lane) {
    const int r32 = lane & 31, hi = lane >> 5;
    LAS unsigned char* vimg = wl;
    LAS bf16* stg = (LAS bf16*)(wl + 4096);
    LAS float* wsf = (LAS float*)(wl + 8192);
    const int vwr = ((lane & 7) >> 2) * 2048 + (lane >> 3) * 64 + (lane & 3) * 16;
    const int vrd = ((lane >> 4) & 1) * 32 + (lane & 3) * 8 + (4 * hi + ((lane & 15) >> 2)) * 64;
    for (int qi = 0; qi < 2; ++qi) {
        const int tq0 = 64 * n + 32 * qi;
        const bf16* qp = Qg + (size_t)(r + dil * (tq0 + r32)) * 512 + 8 * hi;
        bf16x8 qf[4];
#pragma unroll
        for (int d0 = 0; d0 < 4; ++d0) qf[d0] = *(const bf16x8*)(qp + 16 * d0);
        f32x16 s[5];
#pragma unroll
        for (int kb = 0; kb < 5; ++kb) {
            const int tk0 = tq0 - 64 + 32 * kb; int tk = tk0 + r32; tk = tk < 0 ? 0 : (tk >= T ? T - 1 : tk);
            const bf16* kp = Kg + (size_t)(r + dil * tk) * 512 + 8 * hi;
            bf16x8 kf[4];
#pragma unroll
            for (int d0 = 0; d0 < 4; ++d0) kf[d0] = *(const bf16x8*)(kp + 16 * d0);
            f32x16 acc = {};
#pragma unroll
            for (int d0 = 0; d0 < 4; ++d0) acc = __builtin_amdgcn_mfma_f32_32x32x16_bf16(kf[d0], qf[d0], acc, 0, 0, 0);
#pragma unroll
            for (int rr = 0; rr < 16; ++rr) {
                const int cr = (rr & 3) + 8 * (rr >> 2) + 4 * hi; const int rel = -64 + 32 * kb + cr - r32; const int kt = tk0 + cr;
                const bool ok = (rel >= -64) && (rel <= 64) && (kt >= 0) && (kt < T);
                acc[rr] = ok ? acc[rr] : -INFINITY;
            }
            s[kb] = acc;
        }
        float mx = -INFINITY;
#pragma unroll
        for (int kb = 0; kb < 5; ++kb)
#pragma unroll
            for (int rr = 0; rr < 16; ++rr) mx = fmaxf(mx, s[kb][rr]);
        mx = halfmax(mx);
        float lsum = 0.f;
#pragma unroll
        for (int kb = 0; kb < 5; ++kb)
#pragma unroll
            for (int rr = 0; rr < 16; ++rr) { const float p = __builtin_amdgcn_exp2f(s[kb][rr] - mx); s[kb][rr] = p; lsum += p; }
        lsum = halfsum(lsum);
        f32x16 o[2]; o[0] = f32x16{}; o[1] = f32x16{};
#pragma unroll
        for (int kb = 0; kb < 5; ++kb) {
            const int tk0 = tq0 - 64 + 32 * kb;
            bf16x8 vv[4];
#pragma unroll
            for (int j = 0; j < 4; ++j) { int tk = tk0 + 8 * j + (lane >> 3); tk = tk < 0 ? 0 : (tk >= T ? T - 1 : tk);
                vv[j] = *(const bf16x8*)(Vg + (size_t)(r + dil * tk) * 512 + 8 * (lane & 7)); }
#pragma unroll
            for (int j = 0; j < 4; ++j) *(LAS bf16x8*)(vimg + vwr + j * 512) = vv[j];
#pragma unroll
            for (int ks = 0; ks < 2; ++ks) {
                v4u pw;
#pragma unroll
                for (int e = 0; e < 4; ++e) pw[e] = pg8::cvt_pk_bf16(s[kb][8 * ks + 2 * e], s[kb][8 * ks + 2 * e + 1]);
                const bf16x8 pa = __builtin_bit_cast(bf16x8, pw);
#pragma unroll
                for (int d0 = 0; d0 < 2; ++d0) {
                    const s16x4 lo = trrd(vimg + vrd + d0 * 2048 + ks * 1024), hh = trrd(vimg + vrd + d0 * 2048 + ks * 1024 + 512);
                    const bf16x8 vb = (bf16x8){lo[0], lo[1], lo[2], lo[3], hh[0], hh[1], hh[2], hh[3]};
                    o[d0] = __builtin_amdgcn_mfma_f32_32x32x16_bf16(pa, vb, o[d0], 0, 0, 0);
                }
            }
        }
        if (hi == 0) wsf[r32] = lsum;
#pragma unroll
        for (int rr = 0; rr < 16; ++rr) {
            const int orow = (rr & 3) + 8 * (rr >> 2) + 4 * hi; const float rl = __builtin_amdgcn_rcpf(wsf[orow]);
#pragma unroll
            for (int d0 = 0; d0 < 2; ++d0) stg[orow * 64 + d0 * 32 + r32] = (bf16)f2bf(o[d0][rr] * rl);
        }
#pragma unroll
        for (int i = 0; i < 4; ++i) { const int row = i * 8 + (lane >> 3), ch = lane & 7; const v4u v = *(const LAS v4u*)(stg + row * 64 + ch * 8);
            *(v4u*)(Og + (size_t)(r + dil * (tq0 + row)) * 512 + ch * 8) = v; }
        if (hi == 0) Lg[(size_t)(r + dil * (tq0 + r32)) * 8] = mx + __builtin_amdgcn_logf(lsum);
    }
}

#define XB_TMO      128
#define XB_XCNT(j)  (256  + 64 * (j))
#define XB_XSUB(j)  (1280 + 64 * (j))
#define XB_XGEN(j)  (2304 + 64 * (j))
#define XB_TOP      3328
#define XB_TOPGEN   3392
#define XCD_BAR_WORDS 3456
#define XB_SPIN_CAP (1u << 18)

__device__ __forceinline__ unsigned xb_ld(unsigned* p)              { return __hip_atomic_load(p, __ATOMIC_RELAXED, __HIP_MEMORY_SCOPE_AGENT); }
__device__ __forceinline__ unsigned xb_add(unsigned* p, unsigned v) { return __hip_atomic_fetch_add(p, v, __ATOMIC_RELAXED, __HIP_MEMORY_SCOPE_AGENT); }
__device__ __forceinline__ unsigned xb_xcc_id() { return (unsigned)__builtin_amdgcn_s_getreg((3 << 11) | 20) & 0xFu; }
#define XB_SPIN(cond, bar) do { unsigned _sp = 0; while (cond) { __builtin_amdgcn_s_sleep(1); \
    if ((++_sp & 255u) == 0u) { if (xb_ld(&(bar)[XB_TMO])) break; if (_sp > XB_SPIN_CAP) { atomicAdd(&(bar)[XB_TMO], 1u); break; } } } } while (0)

struct XcdBarrier {
    unsigned* bar; unsigned x;
    volatile LAS unsigned* st;
};

__device__ __forceinline__ XcdBarrier xcd_barrier_post(unsigned* bar, volatile LAS unsigned* st, const bool lead) {
    XcdBarrier b; b.bar = bar; b.x = xb_xcc_id(); b.st = st;
    if (lead) (void)xb_add(&bar[XB_XCNT(b.x)], 1u);
    return b;
}
__device__ __forceinline__ void xcd_barrier_complete(unsigned* bar, unsigned x, unsigned& nloc, unsigned& nx) {
    const unsigned G = gridDim.x * gridDim.y * gridDim.z;
    unsigned sum, cnt, mine, sp = 0u;
    for (;;) {
        sum = 0u; cnt = 0u; mine = 0u;
#pragma unroll
        for (unsigned j = 0; j < 16; ++j) { const unsigned c = xb_ld(&bar[XB_XCNT(j)]); sum += c; cnt += (c > 0u) ? 1u : 0u; mine = (j == x) ? c : mine; }
        if (sum == G) break;
        __builtin_amdgcn_s_sleep(1);
        if ((++sp & 255u) == 0u) { if (xb_ld(&bar[XB_TMO])) break; if (sp > XB_SPIN_CAP) { atomicAdd(&bar[XB_TMO], 1u); break; } }
    }
    nloc = mine > 0u ? mine : 1u; nx = cnt > 0u ? cnt : 1u;
}

__device__ __forceinline__ void xcd_barrier(const XcdBarrier& b, const bool lead) {
    asm volatile("s_waitcnt vmcnt(0)" ::: "memory");
    __syncthreads();
    if (lead) {
        unsigned* bar = b.bar;
        __builtin_amdgcn_s_waitcnt(0);
        unsigned nloc = b.st[0], nx = b.st[1];
        if (nloc == 0u) { xcd_barrier_complete(bar, b.x, nloc, nx); b.st[0] = nloc; b.st[1] = nx; }
        const unsigned old = xb_add(&bar[XB_XSUB(b.x)], 1u);
        const unsigned gen = old / nloc;
        if (old + 1u == (gen + 1u) * nloc) {
            __builtin_amdgcn_fence(__ATOMIC_RELEASE, "agent");
            asm volatile("s_waitcnt vmcnt(0)" ::: "memory");
            const unsigned og = xb_add(&bar[XB_TOP], 1u);
            const unsigned tg = og / nx;
            if (og + 1u == (tg + 1u) * nx) xb_add(&bar[XB_TOPGEN], 1u);
            else XB_SPIN(xb_ld(&bar[XB_TOPGEN]) == tg, bar);
            __builtin_amdgcn_fence(__ATOMIC_ACQUIRE, "agent");
            xb_add(&bar[XB_XGEN(b.x)], 1u);
            asm volatile("s_waitcnt vmcnt(0)" ::: "memory");
        } else {
            XB_SPIN(xb_ld(&bar[XB_XGEN(b.x)]) == gen, bar);
            __builtin_amdgcn_fence(__ATOMIC_ACQUIRE, "agent");
            asm volatile("s_waitcnt vmcnt(0)" ::: "memory");
        }
    }
    __syncthreads();
}

#ifndef PROBE_GIN
#define PROBE_GIN 1
#endif
#ifndef PROBE_GU
#define PROBE_GU 1
#endif
#ifndef PROBE_DIL
#define PROBE_DIL 1
#endif
#ifndef PROBE_ATT
#define PROBE_ATT 1
#endif
#ifndef PROBE_ROWS
#define PROBE_ROWS 1
#endif
#ifndef PROBE_SYNC
#define PROBE_SYNC 1
#endif
#define GSYNC() do { MKLANE(); for (int s_ = 0; s_ < PROBE_SYNC; ++s_) xcd_barrier(bar, tid == 0); } while (0)
__global__ void __launch_bounds__(NWAVES * 64, 2) fwd_megakernel(Args a) {
    extern __shared__ __attribute__((aligned(16))) unsigned char lds_raw[];
    cg::grid_group grid = cg::this_grid();
    LAS unsigned char* lds = (LAS unsigned char*)lds_raw;
    const int wave = __builtin_amdgcn_readfirstlane((int)threadIdx.x >> 6);
#define MKLANE() int lane = (int)__builtin_amdgcn_mbcnt_hi(~0u, __builtin_amdgcn_mbcnt_lo(~0u, 0u)); asm volatile("" : "+v"(lane)); const int tid = wave * 64 + lane; (void)tid
#define MKIDS() int G = gridDim.x, bx = blockIdx.x; asm volatile("" : "+s"(G), "+s"(bx)); const int vcu = (G % 8 == 0) ? (bx % 8) * (G / 8) + bx / 8 : bx; const int gw = vcu * NWAVES + wave, NGW = G * NWAVES; (void)gw; (void)NGW; (void)vcu

#ifndef NO_P0
    volatile LAS unsigned* MISC = (volatile LAS unsigned*)(lds + LDS_BYTES - 256);
    { MKLANE(); if (tid < 32) MISC[tid] = 0u; }
    __syncthreads();
    XcdBarrier bar; { MKLANE(); bar = xcd_barrier_post((unsigned*)argp()->ws, MISC + 8, tid == 0); }
    { MKIDS(); MKLANE(); p0_prologue(lds, tid, lane, wave, vcu, G); }
#endif
    grid.sync();

    for (int c = 0; c < NCHUNK; ++c) {
        const int S = (c < 2) ? S_P : S_S, nseq = CT / S, b0 = (c < 2) ? c * 8 : 16;
#define FETCH() MKIDS(); MKLANE(); CArgs ap = argp(); unsigned char* ws = ap->ws; const float* mod = (const float*)(ws + WS_MOD); (void)mod
#define XC() ((c < 2) ? ap->x_prompt + (size_t)c * CT * 1024 : ap->x_sample)
#define OUTC() (ap->out + (size_t)c * CT * 1024)
        for (int rep_ = 0; rep_ < PROBE_ROWS; ++rep_) { FETCH(); rows_norm_mod(XC(), (bf16*)(ws + WS_H), ap->g_mix, mod, 0, 1, S, b0, gw, NGW, lane); }
        GSYNC();
        {   FETCH();
            pg8::Gemm g{(const pg8::bf16_t*)(ws + WS_H), (const pg8::bf16_t*)(ws + WS_WIN), CT, NIN, 1024}; pg8::StaticOrder So; So.init(CT, NIN, G, bx);
            EpiIn E{ws, S};
#ifndef NO_GIN
            for (int rep_ = 0; rep_ < PROBE_GIN; ++rep_)
            pg8::gemm_phase<EpiIn, pg8::StaticOrder, PG8_ALIGN, PG8_SP2>(lds, g, So, E, wave);
#endif
        }
        GSYNC();
        {   FETCH();
            const int NQB = S / 256, NT = S / 64, nunits = nseq * 8 * NQB;
            const float lam_v = __expf(wave_sum(ap->lq1[lane] * ap->lk1[lane])) - __expf(wave_sum(ap->lq2[lane] * ap->lk2[lane])) + 0.2f;
            const float lam = __builtin_bit_cast(float, __builtin_amdgcn_readfirstlane(__builtin_bit_cast(int, lam_v)));
            LAS float* gsl = (LAS float*)(lds + LDS_BYTES - 1024);
            if (tid < 128) gsl[tid] = ap->g_subln[tid] * 0.8f;
            __syncthreads();
            for (int rep_ = 0; rep_ < PROBE_ATT; ++rep_)
            for (int id = vcu; id < nunits; id += G) {
                const int qb = id % NQB; int t = id / NQB; const int h8 = t & 7, seq = t >> 3;
                const size_t rb = (size_t)seq * S * 1024;
                const attn_body::bf16* Qp = (const attn_body::bf16*)(ws + WS_QA) + rb + h8 * 128;
                const attn_body::bf16* Kp = (const attn_body::bf16*)(ws + WS_KA) + rb + h8 * 128;
                const attn_body::bf16* Vp = (const attn_body::bf16*)(ws + WS_VA) + rb + h8 * 128;
                attn_body::bf16* Op = (attn_body::bf16*)(ws + WS_OA) + rb + h8 * 128;
#ifndef NO_ATT
                attn_body::attn_unit<8, 1>(Qp, Kp, Vp, Op, qb * 256, NT, (char*)lds_raw, lam, gsl, wave);
                attn_body::attn_unit<8, 2>(Qp + 64, Kp + 64, Vp, Op, qb * 256, NT, (char*)lds_raw, lam, gsl, wave);
#endif
            }
            __syncthreads();
            const int nb64 = S / 64, ndu = 3 * nseq * nb64;
            for (int rep_ = 0; rep_ < PROBE_DIL; ++rep_)
            for (int id = vcu; id < ndu; id += G) {
                const int rn = id % nb64; int t = id / nb64; const int seq = t % nseq, g = t / nseq;
                const int dil = (g == 0) ? 1 : (g == 1 ? 4 : 16), T = S / dil, nb = T / 64, r = rn / nb, n = rn % nb;
                const size_t rb = (size_t)seq * S * 512 + wave * 64;
                const bf16* Qg = (const bf16*)(ws + WS_G0 + (size_t)(g * 3 + 0) * 32 * MiB) + rb;
                const bf16* Kg = (const bf16*)(ws + WS_G0 + (size_t)(g * 3 + 1) * 32 * MiB) + rb;
                const bf16* Vg = (const bf16*)(ws + WS_G0 + (size_t)(g * 3 + 2) * 32 * MiB) + rb;
                bf16* Og = (bf16*)(ws + WS_OG + (size_t)g * 32 * MiB) + rb;
                float* Lg = (float*)(ws + WS_LSE) + ((size_t)g * CT + (size_t)seq * S) * 8 + wave;
#ifndef NO_DIL
                dil_unit(Qg, Kg, Vg, Og, Lg, r, n, dil, T, lds + wave * 8704, lane);
#endif
            }
        }
        GSYNC();
#ifndef NO_COMB
        for (int rep_ = 0; rep_ < PROBE_ROWS; ++rep_) { MKIDS(); MKLANE(); rows_combine(gw, NGW, lane); }
#endif
        GSYNC();
        {   FETCH();
            pg8::StaticOrder So; So.init(CT, 1024, G, bx);
            pg8::Gemm ga{(const pg8::bf16_t*)(ws + WS_OA), (const pg8::bf16_t*)(ws + WS_WA), CT, 1024, 1024};
            EpiGate Ea{(const bf16*)(ws + WS_G1), (bf16*)(ws + WS_MRG), 0};
#ifndef NO_GG
            pg8::gemm_phase<EpiGate, pg8::StaticOrder, PG8_ALIGN, PG8_SP2>(lds, ga, So, Ea, wave);
#endif
            pg8::Gemm gb{(const pg8::bf16_t*)(ws + WS_OB), (const pg8::bf16_t*)(ws + WS_WB), CT, 1024, 512};
            EpiGate Eb{(const bf16*)(ws + WS_G2), (bf16*)(ws + WS_MRG), 1};
#ifndef NO_GG
            pg8::gemm_phase<EpiGate, pg8::StaticOrder, PG8_ALIGN, PG8_SP2>(lds, gb, So, Eb, wave);
#endif
        }
        GSYNC();
        {   FETCH();
            pg8::StaticOrder So; So.init(CT, 1024, G, bx);
            pg8::Gemm g{(const pg8::bf16_t*)(ws + WS_MRG), (const pg8::bf16_t*)(ws + WS_WOUT), CT, 1024, 1024};
            EpiRes<false> E{XC(), (bf16*)(ws + WS_X1), mod, 2, S, b0};
#ifndef NO_GR
            pg8::gemm_phase<EpiRes<false>, pg8::StaticOrder, PG8_ALIGN, PG8_SP2>(lds, g, So, E, wave);
#endif
        }
        GSYNC();
        for (int rep_ = 0; rep_ < PROBE_ROWS; ++rep_) { FETCH(); rows_norm_mod((const bf16*)(ws + WS_X1), (bf16*)(ws + WS_H), ap->g_ffn, mod, 3, 4, S, b0, gw, NGW, lane); }
        GSYNC();
        {   FETCH();
            pg8::StaticOrder So; So.init(CT, 2 * FFH, G, bx);
            pg8::Gemm g{(const pg8::bf16_t*)(ws + WS_H), (const pg8::bf16_t*)(ws + WS_WGU), CT, 2 * FFH, 1024};
            EpiGU E{(bf16*)(ws + WS_ACT)};
#ifndef NO_GU
            for (int rep_ = 0; rep_ < PROBE_GU; ++rep_)
            pg8::gemm_phase<EpiGU, pg8::StaticOrder, PG8_ALIGN, PG8_SP2>(lds, g, So, E, wave);
#endif
        }
        GSYNC();
        {   FETCH();
            pg8::StaticOrder So; So.init(CT, 1024, G, bx);
            pg8::Gemm g{(const pg8::bf16_t*)(ws + WS_ACT), (const pg8::bf16_t*)(ws + WS_WDN), CT, 1024, FFH};
            EpiRes<true> E{(const bf16*)(ws + WS_X1), (bf16*)(ws + WS_X2), mod, 5, S, b0};
#ifndef NO_GR
            pg8::gemm_phase<EpiRes<true>, pg8::StaticOrder, PG8_ALIGN, PG8_SP2>(lds, g, So, E, wave);
#endif
        }
        GSYNC();
        { FETCH(); rows_final_norm((const bf16*)(ws + WS_X2), OUTC(), ap->g_final, gw, NGW, lane); }
    }
}

extern "C" void kernel_launch(void* const* d_in, const int* in_sizes, int n_in, void* d_out, int out_size, void* d_ws, size_t ws_size, hipStream_t stream) {
    static int grid = 0;
    if (grid == 0) {
        if (n_in != 20 || ws_size < WS_END) { fprintf(stderr, "kernel_launch: unexpected n_in %d / ws_size %zu (need %zu)\n", n_in, ws_size, (size_t)WS_END); grid = -1; return; }
        int dev = 0, cus = 0, per_cu = 0;
        hipGetDevice(&dev); hipDeviceGetAttribute(&cus, hipDeviceAttributeMultiprocessorCount, dev);
        if (hipFuncSetAttribute((const void*)fwd_megakernel, hipFuncAttributeMaxDynamicSharedMemorySize, LDS_BYTES) != hipSuccess) { fprintf(stderr, "kernel_launch: hipFuncSetAttribute failed\n"); grid = -1; return; }
        if (hipOccupancyMaxActiveBlocksPerMultiprocessor(&per_cu, (const void*)fwd_megakernel, NWAVES * 64, LDS_BYTES) != hipSuccess || per_cu < 1) { fprintf(stderr, "kernel_launch: occupancy query says %d\n", per_cu); per_cu = 1; }
        (void)hipGetLastError();
        grid = cus * 1;
        fprintf(stderr, "kernel_launch: grid %d (cus %d, per_cu %d)\n", grid, cus, per_cu);
    }
    if (grid < 0) return;
    Args a{};
    a.x_prompt = (const float*)d_in[0]; a.x_sample = (const float*)d_in[1]; a.c_prompt = (const float*)d_in[2]; a.c_sample = (const float*)d_in[3];
    a.w_ada = (const float*)d_in[4]; a.b_ada = (const float*)d_in[5]; a.g_mix = (const float*)d_in[6]; a.w_in = (const float*)d_in[7];
    a.lq1 = (const float*)d_in[8]; a.lk1 = (const float*)d_in[9]; a.lq2 = (const float*)d_in[10]; a.lk2 = (const float*)d_in[11]; a.g_subln = (const float*)d_in[12];
    a.w_a = (const float*)d_in[13]; a.w_b = (const float*)d_in[14]; a.w_out = (const float*)d_in[15]; a.g_ffn = (const float*)d_in[16]; a.w_gu = (const float*)d_in[17];
    a.w_down = (const float*)d_in[18]; a.g_final = (const float*)d_in[19];
    a.out = (float*)d_out; a.ws = (unsigned char*)d_ws;
    if (hipMemsetAsync(d_ws, 0, 16384, stream) != hipSuccess) { fprintf(stderr, "kernel_launch: memset failed\n"); return; }
    void* args[] = {&a};
    hipError_t e = hipLaunchCooperativeKernel((const void*)fwd_megakernel, dim3(grid), dim3(NWAVES * 64), args, LDS_BYTES, stream);
    if (e != hipSuccess) fprintf(stderr, "kernel_launch: cooperative launch failed: %s (grid %d)\n", hipGetErrorString(e), grid);
}
```

```cpp
#include <hip/hip_runtime.h>
#include <hip/hip_bf16.h>
#include <hip/hip_cooperative_groups.h>
#include <cstdio>
#include <cstdint>
namespace cg = cooperative_groups;
namespace pg8 {
#define PG8_LAS __attribute__((address_space(3)))
typedef unsigned short bf16_t;
typedef short bf16x8 __attribute__((ext_vector_type(8)));
typedef float f32x4 __attribute__((ext_vector_type(4)));
typedef unsigned u32x4 __attribute__((ext_vector_type(4)));
constexpr int BM = 256, BK = 64, HALF = 128, HTB = HALF * BK * 2  , STAGE_BYTES = 8 * HTB, NXCD = 8, WGM = 8;

__host__ __device__ __forceinline__ int lds_byte(int r, int c) { const int st = (r >> 4) * 2 + (c >> 5), rr = r & 15, cc = c & 31, ob = rr * 64 + cc * 2; return st * 1024 + (ob ^ (((ob >> 9) & 1) << 5)); }
__host__ __device__ __forceinline__ void stage_rc(int b, int& R, int& C) { const int st = b / 1024, sb = b % 1024, swz = sb ^ (((sb >> 9) & 1) << 5); R = (st >> 1) * 16 + swz / 64; C = (st & 1) * 32 + (swz % 64) / 2; }
__host__ __device__ __forceinline__ int perm32(int rho) { const int n = rho >> 4, i = rho & 15; return 8 * (i >> 2) + 4 * n + (i & 3); }

struct Unit { int pm, pn; };
struct Gemm { const bf16_t* A; const bf16_t* Bt; int M, N, K; };

struct StaticOrder {
    int nM, nN, nwg, G, c;
    __host__ __device__ void init(int M, int N, int G_, int c_) { nM = M / BM; nN = N / BM; nwg = nM * nN; G = G_; c = c_; }
    __host__ __device__ bool next(int i, Unit& u) const {
        const long L = (long)i * G + c; if (L >= nwg) return false;
        int wgid = (int)L; { const int q = nwg / NXCD, r = nwg % NXCD, xcd = wgid % NXCD, off = wgid / NXCD; wgid = (xcd < r ? xcd * (q + 1) : r * (q + 1) + (xcd - r) * q) + off; }
        const int nig = WGM * nN, gid = wgid / nig, fm = gid * WGM, gsz = (nM - fm) < WGM ? (nM - fm) : WGM;
        u.pm = fm + ((wgid % nig) % gsz); u.pn = (wgid % nig) / gsz; return true;
    }
    __device__ __forceinline__ void a_ready(const Unit&) const {}
    __device__ __forceinline__ void done(const Unit&) const {}
};

__device__ __forceinline__ unsigned cvt_pk_bf16(float lo, float hi) { unsigned r; asm volatile("v_cvt_pk_bf16_f32 %0, %1, %2" : "=v"(r) : "v"(lo), "v"(hi)); return r; }
typedef float f32x2 __attribute__((ext_vector_type(2)));
template <class Epi, class Sched, bool ALIGN_EPI = false, bool SP2 = false>
__device__ __forceinline__ void gemm_phase(PG8_LAS unsigned char* lds, const Gemm g, const Sched& S, const Epi& E, const int wave_) {
    int tid_ = wave_ * 64 + (int)__builtin_amdgcn_mbcnt_hi(~0u, __builtin_amdgcn_mbcnt_lo(~0u, 0u)); asm volatile("" : "+v"(tid_));
    const int tid = tid_, wid = __builtin_amdgcn_readfirstlane(tid >> 6), lane = tid & 63, wr = wid >> 2, wc = wid & 3, fr = lane & 15, fq = lane >> 4;
    const int K = g.K, nt = K / BK;
    unsigned voffA[2], voffB[2];
#pragma unroll
    for (int i = 0; i < 2; ++i) { int R, C; stage_rc(tid * 16 + i * 8192, R, C); const int Rb = Epi::PERM ? ((R & ~31) + perm32(R & 31)) : R;
        voffA[i] = (unsigned)(R * K + C) * 2u; voffB[i] = (unsigned)(Rb * K + C) * 2u; }
    const size_t kstep = (size_t)(BK * 2);
    const size_t hstep = (size_t)HALF * K * 2;
    const size_t tstep = 2 * hstep;
    const unsigned ldsw = (unsigned)wid * 1024u;
    const int aoff = lds_byte(wr * 64 + fr, fq * 8), boff = lds_byte(wc * 32 + fr, fq * 8);
#define PG8_SA(b, h) (((b) * 2 + (h)) * HTB)
#define PG8_SB(b, h) ((4 + (b) * 2 + (h)) * HTB)
#define PG8_STAGE(bufoff, gbase, voff) do { _Pragma("unroll") for (int _i = 0; _i < 2; ++_i) \
        __builtin_amdgcn_global_load_lds((const unsigned*)((const char*)(gbase) + (voff)[_i]), (PG8_LAS unsigned*)(lds + (bufoff) + ldsw + _i * 8192), 16, 0, 0); } while (0)
#define PG8_LDA(dst, b, h) do { _Pragma("unroll") for (int m = 0; m < 4; ++m) _Pragma("unroll") for (int k = 0; k < 2; ++k) dst[m][k] = *(const PG8_LAS bf16x8*)(lds + PG8_SA(b, h) + aoff + m * 2048 + k * 1024); } while (0)
#define PG8_LDB(dst, b, h) do { _Pragma("unroll") for (int n = 0; n < 2; ++n) _Pragma("unroll") for (int k = 0; k < 2; ++k) dst[n][k] = *(const PG8_LAS bf16x8*)(lds + PG8_SB(b, h) + boff + n * 2048 + k * 1024); } while (0)
#define PG8_MMA(ai, bj, At, Bt) do { __builtin_amdgcn_s_setprio(1); _Pragma("unroll") for (int m = 0; m < 4; ++m) _Pragma("unroll") for (int n = 0; n < 2; ++n) _Pragma("unroll") for (int k = 0; k < 2; ++k) \
        acc[ai][bj][m][n] = __builtin_amdgcn_mfma_f32_16x16x32_bf16(Bt[n][k], At[m][k], acc[ai][bj][m][n], 0, 0, 0); __builtin_amdgcn_s_setprio(0); } while (0)
#define PG8_WAIT_V(n) asm volatile("s_waitcnt vmcnt(" #n ")" ::: "memory")
#define PG8_WAIT_L(n) asm volatile("s_waitcnt lgkmcnt(" #n ")" ::: "memory")
#define PG8_BAR __builtin_amdgcn_s_barrier()
#define PG8_SCHED __builtin_amdgcn_sched_barrier(0)
    Unit cur, nxt; int ui = 0;
    if (!S.next(0, cur)) return;
    f32x4 acc[2][2][4][2];
#pragma unroll
    for (int a = 0; a < 2; ++a)
#pragma unroll
        for (int b = 0; b < 2; ++b)
#pragma unroll
            for (int m = 0; m < 4; ++m)
#pragma unroll
                for (int n = 0; n < 2; ++n) acc[a][b][m][n] = (f32x4){0.f, 0.f, 0.f, 0.f};
    bf16x8 At[4][2], B0[2][2], B1[2][2];
    const char* cA = (const char*)g.A + (size_t)cur.pm * tstep; const char* cB = (const char*)g.Bt + (size_t)cur.pn * tstep;
    S.a_ready(cur);
    if constexpr (SP2) {
        PG8_STAGE(PG8_SB(0, 0), cB, voffB); PG8_STAGE(PG8_SB(0, 1), cB + hstep, voffB); PG8_STAGE(PG8_SA(0, 0), cA, voffA); PG8_STAGE(PG8_SA(0, 1), cA + hstep, voffA);
        if (wr == 1) PG8_BAR;
        PG8_WAIT_V(2); PG8_BAR;
        PG8_STAGE(PG8_SB(1, 0), cB + kstep, voffB); PG8_STAGE(PG8_SA(1, 0), cA + kstep, voffA); PG8_STAGE(PG8_SB(1, 1), cB + hstep + kstep, voffB);
        PG8_WAIT_V(6); PG8_BAR;
    } else {
        PG8_STAGE(PG8_SB(0, 0), cB, voffB); PG8_STAGE(PG8_SA(0, 0), cA, voffA); PG8_STAGE(PG8_SB(0, 1), cB + hstep, voffB); PG8_STAGE(PG8_SA(0, 1), cA + hstep, voffA);
        if (wr == 1) PG8_BAR;
        PG8_WAIT_V(4); PG8_BAR;
        PG8_STAGE(PG8_SB(1, 0), cB + kstep, voffB); PG8_STAGE(PG8_SA(1, 0), cA + kstep, voffA); PG8_STAGE(PG8_SB(1, 1), cB + hstep + kstep, voffB);
        PG8_WAIT_V(6); PG8_BAR;
    }
    for (;;) {
        const bool has_next = S.next(ui + 1, nxt);
        const char* nA = has_next ? (const char*)g.A + (size_t)nxt.pm * tstep : cA; const char* nB = has_next ? (const char*)g.Bt + (size_t)nxt.pn * tstep : cB;
        for (int t = 0; t < nt; t += 2) {
            const bool last = (t == nt - 2);
            const char* a1 = cA + (size_t)(t + 1) * kstep;
            const char* a2 = last ? nA : cA + (size_t)(t + 2) * kstep; const char* b2 = last ? nB : cB + (size_t)(t + 2) * kstep;
            const char* a3 = a2 + kstep; const char* b3 = b2 + kstep;
            if (last && has_next) S.a_ready(nxt);
            if constexpr (SP2) {
            PG8_LDB(B0, 0, 0); PG8_LDB(B1, 0, 1); PG8_SCHED; PG8_LDA(At, 0, 0); PG8_STAGE(PG8_SA(1, 1), a1 + hstep, voffA);
            PG8_WAIT_V(8); PG8_WAIT_L(0); PG8_BAR; PG8_MMA(0, 0, At, B0); PG8_MMA(0, 1, At, B1); PG8_BAR; PG8_SCHED;
            PG8_LDA(At, 0, 1); PG8_STAGE(PG8_SB(0, 0), b2, voffB); PG8_STAGE(PG8_SB(0, 1), b2 + hstep, voffB); PG8_STAGE(PG8_SA(0, 0), a2, voffA);
            PG8_WAIT_V(8); PG8_WAIT_L(0); PG8_BAR; PG8_MMA(1, 0, At, B0); PG8_MMA(1, 1, At, B1); PG8_BAR; PG8_SCHED;
            PG8_LDB(B0, 1, 0); PG8_LDB(B1, 1, 1); PG8_SCHED; PG8_LDA(At, 1, 0); PG8_STAGE(PG8_SA(0, 1), a2 + hstep, voffA);
            PG8_WAIT_V(8); PG8_WAIT_L(0); PG8_BAR; PG8_MMA(0, 0, At, B0); PG8_MMA(0, 1, At, B1); PG8_BAR; PG8_SCHED;
            PG8_LDA(At, 1, 1); PG8_STAGE(PG8_SB(1, 0), b3, voffB); PG8_STAGE(PG8_SB(1, 1), b3 + hstep, voffB); PG8_STAGE(PG8_SA(1, 0), a3, voffA);
            PG8_WAIT_V(8); PG8_WAIT_L(0); PG8_BAR; PG8_MMA(1, 0, At, B0); PG8_MMA(1, 1, At, B1); PG8_BAR; PG8_SCHED;
            } else {
            PG8_LDB(B0, 0, 0); PG8_SCHED; PG8_LDA(At, 0, 0); PG8_STAGE(PG8_SA(1, 1), a1 + hstep, voffA);
            PG8_WAIT_L(8); PG8_BAR; PG8_WAIT_L(0); PG8_MMA(0, 0, At, B0); PG8_BAR; PG8_SCHED;
            PG8_LDB(B1, 0, 1); PG8_STAGE(PG8_SB(0, 0), b2, voffB);
            PG8_BAR; PG8_WAIT_L(0); PG8_MMA(0, 1, At, B1); PG8_BAR;
            PG8_LDA(At, 0, 1); PG8_STAGE(PG8_SA(0, 0), a2, voffA);
            PG8_BAR; PG8_WAIT_L(0); PG8_MMA(1, 0, At, B0); PG8_BAR; PG8_SCHED;
            PG8_STAGE(PG8_SB(0, 1), b2 + hstep, voffB);
            PG8_WAIT_V(6); PG8_BAR; PG8_MMA(1, 1, At, B1); PG8_BAR;
            PG8_LDB(B0, 1, 0); PG8_SCHED; PG8_LDA(At, 1, 0); PG8_STAGE(PG8_SA(0, 1), a2 + hstep, voffA);
            PG8_WAIT_L(8); PG8_BAR; PG8_WAIT_L(0); PG8_MMA(0, 0, At, B0); PG8_BAR; PG8_SCHED;
            PG8_LDB(B1, 1, 1); PG8_STAGE(PG8_SB(1, 0), b3, voffB);
            PG8_BAR; PG8_WAIT_L(0); PG8_MMA(0, 1, At, B1); PG8_BAR;
            PG8_LDA(At, 1, 1); PG8_STAGE(PG8_SA(1, 0), a3, voffA);
            PG8_BAR; PG8_WAIT_L(0); PG8_MMA(1, 0, At, B0); PG8_BAR; PG8_SCHED;
            PG8_STAGE(PG8_SB(1, 1), b3 + hstep, voffB);
            PG8_WAIT_V(6); PG8_BAR; PG8_MMA(1, 1, At, B1); PG8_BAR;
            }
        }
        if constexpr (ALIGN_EPI) { if (wr == 0) PG8_BAR; }
        if constexpr (!Epi::AFTER_DRAIN) { E(acc, cur, wr, wc, fr, fq); S.done(cur); }
        if (!has_next) break;
#pragma unroll
        for (int a = 0; a < 2; ++a)
#pragma unroll
            for (int b = 0; b < 2; ++b)
#pragma unroll
                for (int m = 0; m < 4; ++m)
#pragma unroll
                    for (int n = 0; n < 2; ++n) acc[a][b][m][n] = (f32x4){0.f, 0.f, 0.f, 0.f};
        cur = nxt; cA = nA; cB = nB; ++ui;
        if constexpr (ALIGN_EPI) { if (wr == 1) PG8_BAR; }
    }
    PG8_WAIT_V(0);
    if constexpr (!ALIGN_EPI) { if (wr == 0) PG8_BAR; }
    PG8_BAR;
    if constexpr (Epi::AFTER_DRAIN) { E.fused(acc, cur, wr, wc, fr, fq, lds, wid, lane); S.done(cur); }
#undef PG8_SA
#undef PG8_SB
#undef PG8_STAGE
#undef PG8_LDA
#undef PG8_LDB
#undef PG8_MMA
#undef PG8_WAIT_V
#undef PG8_WAIT_L
#undef PG8_BAR
#undef PG8_SCHED
}
}
#ifndef PG8_SP2
#define PG8_SP2 true
#endif
#ifndef PG8_ALIGN
#define PG8_ALIGN true
#endif
#include <hip/hip_bf16.h>
#include <cmath>
namespace attn_body {
using bf16=__hip_bfloat16;
using bf16x8=__attribute__((ext_vector_type(8)))short;
using s16x4=__attribute__((ext_vector_type(4)))short;
using f32x16=__attribute__((ext_vector_type(16)))float;
using u32x4=__attribute__((ext_vector_type(4)))unsigned;
constexpr int D=64,DM=1024;
constexpr int NW=8,QBLK=32,QB=QBLK*NW,KVBLK=64;
__device__ __forceinline__ int crow(int r,int hi){return (r&3)+8*(r>>2)+4*hi;}
#define SBAR() __builtin_amdgcn_sched_barrier(0)
constexpr int NSLOT=3, SLOTB=8192;
constexpr int LDS_K=0, LDS_V=NSLOT*SLOTB, LDS_WS=3*NSLOT*SLOTB, LDS_OST=LDS_WS+NW*64*4, LDS_BYTES=LDS_OST+NW*8192;
constexpr float C2=0.125f*1.4426950408889634f;
__device__ __forceinline__ void glds16(const void*gsrc,unsigned lds_dst){unsigned keep;
  asm volatile("s_mov_b32 %0, m0\n\ts_mov_b32 m0, %2\n\ts_nop 0\n\tglobal_load_lds_dwordx4 %1, off\n\ts_mov_b32 m0, %0":"=&s"(keep):"v"(gsrc),"s"(lds_dst):"memory");}
__device__ __forceinline__ float max3f(float a,float b,float c){float r;asm("v_max3_f32 %0, %1, %2, %3":"=v"(r):"v"(a),"v"(b),"v"(c));return r;}
__device__ __forceinline__ float max2f(float a,float b){float r;asm("v_max_f32_e32 %0, %1, %2":"=v"(r):"v"(a),"v"(b));return r;}
__device__ __forceinline__ float fadd_s(float a,float b){float r;asm("v_add_f32_e32 %0, %1, %2":"=v"(r):"v"(a),"v"(b));return r;}
__device__ __forceinline__ float fsub_s(float a,float b){float r;asm("v_sub_f32_e32 %0, %1, %2":"=v"(r):"v"(a),"v"(b));return r;}
typedef float f32x2_t __attribute__((ext_vector_type(2))); typedef __bf16 bf16x2_t __attribute__((ext_vector_type(2)));
__device__ __forceinline__ unsigned cvtpk_s(float lo,float hi){f32x2_t v={lo,hi};bf16x2_t b=__builtin_convertvector(v,bf16x2_t);return __builtin_bit_cast(unsigned,b);}
#define WAIT_BAR(N) asm volatile("s_waitcnt vmcnt(" #N ") lgkmcnt(0)\n\ts_barrier":::"memory")

__device__ __forceinline__ void qkt(f32x16&p0,f32x16&p1,const char*Kslot,const bf16x8*qr,int r32,int hi){ const f32x16 negm=f32x16{};
  const char*kb=Kslot+hi*1024+r32*16;
  #pragma unroll
  for(int d0=0;d0<4;++d0){
    const bf16x8 b0=*reinterpret_cast<const bf16x8*>(kb+d0*2048);
    const bf16x8 b1=*reinterpret_cast<const bf16x8*>(kb+d0*2048+512);
    if(d0==0){p0=__builtin_amdgcn_mfma_f32_32x32x16_bf16(b0,qr[0],negm,0,0,0);p1=__builtin_amdgcn_mfma_f32_32x32x16_bf16(b1,qr[0],negm,0,0,0);}
    else{p0=__builtin_amdgcn_mfma_f32_32x32x16_bf16(b0,qr[d0],p0,0,0,0);p1=__builtin_amdgcn_mfma_f32_32x32x16_bf16(b1,qr[d0],p1,0,0,0);}}
}
typedef __attribute__((address_space(3))) const char* lds_cptr;
typedef short v4i16_t __attribute__((ext_vector_type(4)));
__device__ __forceinline__ void kload8(bf16x8*kf,lds_cptr kp){
  kf[0]=*(const __attribute__((address_space(3))) bf16x8*)(kp);      kf[1]=*(const __attribute__((address_space(3))) bf16x8*)(kp+512);
  kf[2]=*(const __attribute__((address_space(3))) bf16x8*)(kp+2048); kf[3]=*(const __attribute__((address_space(3))) bf16x8*)(kp+2560);
  kf[4]=*(const __attribute__((address_space(3))) bf16x8*)(kp+4096); kf[5]=*(const __attribute__((address_space(3))) bf16x8*)(kp+4608);
  kf[6]=*(const __attribute__((address_space(3))) bf16x8*)(kp+6144); kf[7]=*(const __attribute__((address_space(3))) bf16x8*)(kp+6656);
}
__device__ __forceinline__ void kload2(bf16x8*kf,lds_cptr kp,int j){ kf[2*j]=*(const __attribute__((address_space(3))) bf16x8*)(kp+j*2048); kf[2*j+1]=*(const __attribute__((address_space(3))) bf16x8*)(kp+j*2048+512); }
__device__ __forceinline__ s16x4 vtr(lds_cptr p){ return __builtin_bit_cast(s16x4,__builtin_amdgcn_ds_read_tr16_b64_v4i16((__attribute__((address_space(3))) v4i16_t*)p)); }
__device__ __forceinline__ float rowmax(const f32x16&p0,const f32x16&p1){
  float a=max3f(p0[0],p0[1],p1[0]),b=max3f(p0[2],p0[3],p1[1]);a=max3f(a,p1[2],p1[3]);
  #pragma unroll
  for(int r=4;r<16;r+=4){a=max3f(a,p0[r],p0[r+1]);b=max3f(b,p0[r+2],p0[r+3]);a=max3f(a,p1[r],p1[r+1]);b=max3f(b,p1[r+2],p1[r+3]);}
  const float m=max2f(a,b);
  auto rr=__builtin_amdgcn_permlane32_swap(__float_as_uint(m),__float_as_uint(m),false,false);
  return max2f(__uint_as_float(rr[0]),__uint_as_float(rr[1]));
}
__device__ __forceinline__ void pv(f32x16*o,int vb,bf16x8 pa0,bf16x8 pa1,bf16x8 pa2,bf16x8 pa3){
  #pragma unroll
  for(int d0=0;d0<4;++d0){s16x4 lo[4],hi[4];
    #pragma unroll
    for(int ks=0;ks<4;++ks){
      asm volatile("ds_read_b64_tr_b16 %0,%1 offset:%c2":"=&v"(lo[ks]):"v"(vb),"i"(d0*4096+ks*1024):"memory");
      asm volatile("ds_read_b64_tr_b16 %0,%1 offset:%c2":"=&v"(hi[ks]):"v"(vb),"i"(d0*4096+ks*1024+512):"memory");}
    asm volatile("s_waitcnt lgkmcnt(0)":::"memory");SBAR();
    #define PK(k) (bf16x8){lo[k][0],lo[k][1],lo[k][2],lo[k][3],hi[k][0],hi[k][1],hi[k][2],hi[k][3]}
    o[d0]=__builtin_amdgcn_mfma_f32_32x32x16_bf16(pa0,PK(0),o[d0],0,0,0);
    o[d0]=__builtin_amdgcn_mfma_f32_32x32x16_bf16(pa1,PK(1),o[d0],0,0,0);
    o[d0]=__builtin_amdgcn_mfma_f32_32x32x16_bf16(pa2,PK(2),o[d0],0,0,0);
    o[d0]=__builtin_amdgcn_mfma_f32_32x32x16_bf16(pa3,PK(3),o[d0],0,0,0);
    #undef PK
  }
}

#ifndef ATTN_STORE16
#define ATTN_STORE16(p,v) (*(u32x4*)(p)=(v))
#endif
template<int THRL,int MODE> __device__ __forceinline__ void attn_unit(const bf16*Qp,const bf16*__restrict__ Kh,const bf16*__restrict__ Vh,bf16*Op,const int q0,const int NT,char*shm,const float lam,const __attribute__((address_space(3))) float*gsub,const int wave_){
  int tid_=wave_*64+(int)__builtin_amdgcn_mbcnt_hi(~0u,__builtin_amdgcn_mbcnt_lo(~0u,0u)); asm volatile("":"+v"(tid_));
  const int tid=tid_,lane=tid&63,r32=lane&31,hi=lane>>5; const int wid=__builtin_amdgcn_readfirstlane(tid>>6);
  const bf16*Qw=Qp+(long)(q0+wid*QBLK)*DM;
  const unsigned lds0=(unsigned)(uintptr_t)shm;
  float*wsf=(float*)(shm+LDS_WS)+wid*64;
  const bf16*ksrc=Kh+(long)lane*DM+wid*8;
  const bf16*vsrc=Vh+(long)(16*(wid&3)+(lane>>2))*DM+(wid>>2)*32+(lane&3)*8;
  const unsigned kdst=lds0+LDS_K+wid*1024, vdst=lds0+LDS_V+wid*1024;
  #define DMA_K(t,slot) glds16(ksrc+(long)(t)*KVBLK*DM,(unsigned)__builtin_amdgcn_readfirstlane(kdst+(slot)))
  #define DMA_V(t,slot) do{ glds16(vsrc+(long)(t)*KVBLK*DM,(unsigned)__builtin_amdgcn_readfirstlane(vdst+2*(slot))); glds16(vsrc+(long)(t)*KVBLK*DM+64,(unsigned)__builtin_amdgcn_readfirstlane(vdst+2*(slot)+8192)); }while(0)
  const int vb0=(int)(lds0+LDS_V)+((lane>>4)&1)*32+(lane&3)*8+(4*hi+((lane&15)>>2))*64;
  const char*Kbase=shm+LDS_K; bf16x8 kf[8];
  const lds_cptr shm3=(lds_cptr)shm; const lds_cptr kp0=shm3+LDS_K+hi*1024+r32*16; const lds_cptr vp0=shm3+LDS_V+((lane>>4)&1)*32+(lane&3)*8+(4*hi+((lane&15)>>2))*64;
  DMA_K(0,0);DMA_V(0,0);DMA_K(1,SLOTB);
  bf16x8 qr[4];
  #pragma unroll
  for(int d0=0;d0<4;++d0)qr[d0]=*reinterpret_cast<const bf16x8*>(&Qw[(long)r32*DM+d0*16+hi*8]);
  float mhat=0.f,l_reg=0.f;f32x16 o[4];o[0]=f32x16{};o[1]=f32x16{};o[2]=f32x16{};o[3]=f32x16{};
  #define CMASK(P0,P1,t) do{}while(0)
  bool resc=false;
  #define START(P0,P1) do{ const float rm=rowmax(P0,P1); resc=false; \
    { const float dl=rm; mhat=fadd_s(mhat,dl); \
      _Pragma("unroll") for(int r=0;r<16;++r){P0[r]=fsub_s(P0[r],dl);P1[r]=fsub_s(P1[r],dl);} } \
    _Pragma("unroll") for(int r=0;r<16;++r)P0[r]=__builtin_amdgcn_exp2f(P0[r]); }while(0)
  #define RESC() do{ if(resc){ asm volatile("s_waitcnt lgkmcnt(0)":::"memory"); \
      _Pragma("unroll") for(int d_=0;d_<4;++d_) _Pragma("unroll") for(int r=0;r<16;++r)o[d_][r]*=wsf[crow(r,hi)]; } }while(0)
  f32x16 pA0,pA1,pB0,pB1;
  int sl_prev=0,sl_cur=0,sl_next=SLOTB;
  #define ROT() do{sl_prev=sl_cur;sl_cur=sl_next;sl_next=(sl_next==(NSLOT-1)*SLOTB)?0:sl_next+SLOTB;}while(0)
  DMA_K(2,2*SLOTB);
  WAIT_BAR(4);
  qkt(pA0,pA1,Kbase,qr,r32,hi);asm volatile("s_nop 15\n\ts_nop 7":"+v"(pA0),"+v"(pA1));CMASK(pA0,pA1,0);
  START(pA0,pA1);
  _Pragma("unroll") for(int r=0;r<16;++r)pA1[r]=__builtin_amdgcn_exp2f(pA1[r]);
  WAIT_BAR(0);
  DMA_K(3,0);DMA_V(1,SLOTB);
  ROT();
  kload8(kf,kp0+sl_cur);
  WAIT_BAR(3);
  s16x4 vlo[8],vhi[8]; u32x4 pw0,pw1,pw2,pw3;
  #define PKW(P,B) cvtpk_s(P[B],P[B+1])
  #define PAF(k) __builtin_bit_cast(bf16x8,pw##k)
  #define VFR(i) (bf16x8){vlo[i][0],vlo[i][1],vlo[i][2],vlo[i][3],vhi[i][0],vhi[i][1],vhi[i][2],vhi[i][3]}
  #define PIN(x) asm volatile("":"+v"(x))
  #define MX3(a,b,c) __builtin_fmaxf(__builtin_fmaxf((a),(b)),(c))
  #define GAPA(MF,A0,A1,A2,A3,W0,W1,PW) do{ MF; sacc+=A0; sacc+=A1; sacc+=A2; sacc+=A3; PIN(sacc); W0; W1; PIN(PW); SBAR(); }while(0)
  #define EX(v) __builtin_amdgcn_exp2f(v)
  #define GAPB(MF,X,B) do{ MF; X[B]=EX(X[B]-mhat); X[B+1]=EX(X[B+1]-mhat); PIN(X); SBAR(); }while(0)
  #define VRD2(i) do{ vlo[i]=vtr(vp_+(8192+((i)>>2)*4096+((i)&3)*1024)); vhi[i]=vtr(vp_+(8192+((i)>>2)*4096+((i)&3)*1024+512)); SBAR(); }while(0)
  #define VRD(i) do{ vlo[i]=vtr(vp_+(((i)>>2)*4096+((i)&3)*1024)); vhi[i]=vtr(vp_+(((i)>>2)*4096+((i)&3)*1024+512)); }while(0)
  #define KRD(G,j) do{ if(G){ kload2(kf,kp0+sl_next,j); SBAR(); } }while(0)
  #define STEP(C0,C1,P0,P1,t,GK,GV,GL) do{ SBAR(); \
    const lds_cptr vp_=vp0+2*sl_prev; \
    VRD(0); SBAR(); float sacc=(P0[0]+P0[1]); \
    GAPA(C0=__builtin_amdgcn_mfma_f32_32x32x16_bf16(kf[0],qr[0],f32x16{},0,0,0), P0[2],P0[3],P0[4],P0[5],     pw0[0]=PKW(P0,0), pw0[1]=PKW(P0,2), pw0); \
    VRD(4); SBAR(); GAPA(C1=__builtin_amdgcn_mfma_f32_32x32x16_bf16(kf[1],qr[0],f32x16{},0,0,0), P0[6],P0[7],P0[8],P0[9],     pw0[2]=PKW(P0,4), pw0[3]=PKW(P0,6), pw0); \
    VRD(1); SBAR(); GAPA(C0=__builtin_amdgcn_mfma_f32_32x32x16_bf16(kf[2],qr[1],C0,0,0,0),   P0[10],P0[11],P0[12],P0[13], pw1[0]=PKW(P0,8), pw1[1]=PKW(P0,10), pw1); \
    VRD(5); SBAR(); GAPA(C1=__builtin_amdgcn_mfma_f32_32x32x16_bf16(kf[3],qr[1],C1,0,0,0),   P0[14],P0[15],P1[0],P1[1],   pw1[2]=PKW(P0,12),pw1[3]=PKW(P0,14), pw1); \
    VRD(2); SBAR(); GAPA(C0=__builtin_amdgcn_mfma_f32_32x32x16_bf16(kf[4],qr[2],C0,0,0,0),   P1[2],P1[3],P1[4],P1[5],     pw2[0]=PKW(P1,0), pw2[1]=PKW(P1,2), pw2); \
    VRD(6); SBAR(); GAPA(C1=__builtin_amdgcn_mfma_f32_32x32x16_bf16(kf[5],qr[2],C1,0,0,0),   P1[6],P1[7],P1[8],P1[9],     pw2[2]=PKW(P1,4), pw2[3]=PKW(P1,6), pw2); \
    VRD(3); SBAR(); GAPA(C0=__builtin_amdgcn_mfma_f32_32x32x16_bf16(kf[6],qr[3],C0,0,0,0),   P1[10],P1[11],P1[12],P1[13], pw3[0]=PKW(P1,8), pw3[1]=PKW(P1,10), pw3); \
    VRD(7); SBAR(); GAPA(C1=__builtin_amdgcn_mfma_f32_32x32x16_bf16(kf[7],qr[3],C1,0,0,0),   P1[14],P1[15],0.f,0.f,       pw3[2]=PKW(P1,12),pw3[3]=PKW(P1,14), pw3); \
    l_reg+=sacc; \
    if(GK){DMA_K((t)+3,sl_cur);} if(GV){DMA_V((t)+1,sl_next);} \
    CMASK(C0,C1,t); \
    { float a=MX3(C0[0],C0[1],C1[0]),b=MX3(C0[2],C0[3],C1[1]); a=MX3(a,C1[2],C1[3]); \
      _Pragma("unroll") for(int r=4;r<16;r+=4){a=MX3(a,C0[r],C0[r+1]);b=MX3(b,C0[r+2],C0[r+3]);a=MX3(a,C1[r],C1[r+1]);b=MX3(b,C1[r+2],C1[r+3]);} \
      float rm=__builtin_fmaxf(a,b); { auto rr=__builtin_amdgcn_permlane32_swap(__float_as_uint(rm),__float_as_uint(rm),false,false); rm=__builtin_fmaxf(__uint_as_float(rr[0]),__uint_as_float(rr[1])); } \
      resc=false; \
      rm-=mhat; \
      if(__builtin_expect(__any(rm>(float)THRL),0)){ const float dl=__builtin_fmaxf(rm,0.f); mhat+=dl; \
        const float f=__builtin_amdgcn_exp2f(-dl); l_reg*=f; if(hi==0)wsf[r32]=f; resc=true; } } \
    SBAR(); \
    GAPB(o[0]=__builtin_amdgcn_mfma_f32_32x32x16_bf16(PAF(0),VFR(0),o[0],0,0,0), C0,0);  VRD2(0); \
    GAPB(o[1]=__builtin_amdgcn_mfma_f32_32x32x16_bf16(PAF(0),VFR(4),o[1],0,0,0), C0,2);  VRD2(4); \
    KRD(GL,0); GAPB(o[0]=__builtin_amdgcn_mfma_f32_32x32x16_bf16(PAF(1),VFR(1),o[0],0,0,0), C0,4);  VRD2(1); \
    KRD(GL,1); GAPB(o[1]=__builtin_amdgcn_mfma_f32_32x32x16_bf16(PAF(1),VFR(5),o[1],0,0,0), C0,6);  VRD2(5); \
    KRD(GL,2); GAPB(o[0]=__builtin_amdgcn_mfma_f32_32x32x16_bf16(PAF(2),VFR(2),o[0],0,0,0), C0,8);  VRD2(2); \
    KRD(GL,3); GAPB(o[1]=__builtin_amdgcn_mfma_f32_32x32x16_bf16(PAF(2),VFR(6),o[1],0,0,0), C0,10); VRD2(6); \
    GAPB(o[0]=__builtin_amdgcn_mfma_f32_32x32x16_bf16(PAF(3),VFR(3),o[0],0,0,0), C0,12); VRD2(3); \
    GAPB(o[1]=__builtin_amdgcn_mfma_f32_32x32x16_bf16(PAF(3),VFR(7),o[1],0,0,0), C0,14); VRD2(7); \
    GAPB(o[2]=__builtin_amdgcn_mfma_f32_32x32x16_bf16(PAF(0),VFR(0),o[2],0,0,0), C1,0); \
    GAPB(o[3]=__builtin_amdgcn_mfma_f32_32x32x16_bf16(PAF(0),VFR(4),o[3],0,0,0), C1,2); \
    GAPB(o[2]=__builtin_amdgcn_mfma_f32_32x32x16_bf16(PAF(1),VFR(1),o[2],0,0,0), C1,4); \
    GAPB(o[3]=__builtin_amdgcn_mfma_f32_32x32x16_bf16(PAF(1),VFR(5),o[3],0,0,0), C1,6); \
    GAPB(o[2]=__builtin_amdgcn_mfma_f32_32x32x16_bf16(PAF(2),VFR(2),o[2],0,0,0), C1,8); \
    GAPB(o[3]=__builtin_amdgcn_mfma_f32_32x32x16_bf16(PAF(2),VFR(6),o[3],0,0,0), C1,10); \
    GAPB(o[2]=__builtin_amdgcn_mfma_f32_32x32x16_bf16(PAF(3),VFR(3),o[2],0,0,0), C1,12); \
    GAPB(o[3]=__builtin_amdgcn_mfma_f32_32x32x16_bf16(PAF(3),VFR(7),o[3],0,0,0), C1,14); \
    }while(0)
  int t=1;
  #undef CMASK
  #define CMASK(P0,P1,t) do{}while(0)
  for(;t+5<NT;t+=2){
    STEP(pB0,pB1,pA0,pA1,t,true,true,true);     WAIT_BAR(3); RESC(); ROT();
    STEP(pA0,pA1,pB0,pB1,t+1,true,true,true);   WAIT_BAR(3); RESC(); ROT();
  }
  #undef CMASK
  #define CMASK(P0,P1,t) do{}while(0)
  #define ENDW(tt) do{ if((tt)+3<NT){WAIT_BAR(3);} else if((tt)+2<NT){WAIT_BAR(2);} else {WAIT_BAR(0);} }while(0)
  for(;t+1<NT;t+=2){
    STEP(pB0,pB1,pA0,pA1,t,(t+3<NT),(t+1<NT),(t+1<NT));       ENDW(t);   RESC(); ROT();
    STEP(pA0,pA1,pB0,pB1,t+1,(t+4<NT),(t+2<NT),(t+2<NT));     ENDW(t+1); RESC(); ROT();
  }
  STEP(pB0,pB1,pA0,pA1,NT-1,false,false,false); RESC();
  { float sacc=pB0[0]+pB0[1]; _Pragma("unroll") for(int r=2;r<16;++r)sacc+=pB0[r]; _Pragma("unroll") for(int r=0;r<16;++r)sacc+=pB1[r]; l_reg+=sacc;
    pw0=(u32x4){PKW(pB0,0),PKW(pB0,2),PKW(pB0,4),PKW(pB0,6)};pw1=(u32x4){PKW(pB0,8),PKW(pB0,10),PKW(pB0,12),PKW(pB0,14)};pw2=(u32x4){PKW(pB1,0),PKW(pB1,2),PKW(pB1,4),PKW(pB1,6)};pw3=(u32x4){PKW(pB1,8),PKW(pB1,10),PKW(pB1,12),PKW(pB1,14)};
    SBAR(); pv(o,vb0+2*sl_cur,PAF(0),PAF(1),PAF(2),PAF(3)); }
  #undef PKW
  #undef PAF
  #undef VFR
  #undef PIN
  #undef MX3
  #undef GAPA
  #undef GAPB
  #undef EX
  #undef VRD
  #undef VRD2
  #undef KRD
  #undef STEP
  #undef ENDW
  {auto rr=__builtin_amdgcn_permlane32_swap(__float_as_uint(l_reg),__float_as_uint(l_reg),false,false);l_reg=__uint_as_float(rr[0])+__uint_as_float(rr[1]);}
  if(hi==0)wsf[32+r32]=l_reg;asm volatile("s_waitcnt lgkmcnt(0)":::"memory");
  float rli[16];
  #pragma unroll
  for(int r=0;r<16;++r)rli[r]=__builtin_amdgcn_rcpf(wsf[32+crow(r,hi)]);
  bf16*Ow=Op+(long)(q0+wid*QBLK)*DM;
  { bf16*stg=(bf16*)(shm+LDS_OST)+wid*4096;
    if constexpr(MODE==1){
      #pragma unroll
      for(int r=0;r<16;++r){const int orow=crow(r,hi);
        #pragma unroll
        for(int d0=0;d0<4;++d0)stg[orow*128+d0*32+r32]=__float2bfloat16(o[d0][r]*rli[r]);}
    } else {
      float ss[16];
      #pragma unroll
      for(int r=0;r<16;++r){const int orow=crow(r,hi); float s=0.f;
        #pragma unroll
        for(int d0=0;d0<4;++d0){const float dd=__bfloat162float(stg[orow*128+d0*32+r32])-lam*(o[d0][r]*rli[r]); o[d0][r]=dd; s+=dd*dd;}
        ss[r]=s;}
      #pragma unroll
      for(int r=0;r<16;++r){float s=ss[r]; s+=__shfl_xor(s,1); s+=__shfl_xor(s,2); s+=__shfl_xor(s,4); s+=__shfl_xor(s,8); s+=__shfl_xor(s,16); ss[r]=1.f/sqrtf(s*(1.f/128.f)+1e-6f);}
      float gg[4];
      #pragma unroll
      for(int d0=0;d0<4;++d0)gg[d0]=gsub[d0*32+r32];
      #pragma unroll
      for(int r=0;r<16;++r){const int orow=crow(r,hi);
        #pragma unroll
        for(int d0=0;d0<4;++d0)stg[orow*128+d0*32+r32]=__float2bfloat16(o[d0][r]*ss[r]*gg[d0]);}
      asm volatile("s_waitcnt lgkmcnt(0)":::"memory");
      #pragma unroll
      for(int i=0;i<8;++i){const int row=i*4+(lane>>4),ch=lane&15; const u32x4 v=*(const u32x4*)(stg+row*128+ch*8); ATTN_STORE16(Ow+(long)row*DM+ch*8,v);}
    } }
  asm volatile("s_waitcnt lgkmcnt(0)\n\ts_barrier":::"memory");
  #undef DMA_K
  #undef DMA_V
  #undef CMASK
  #undef START
  #undef RESC
  #undef ROT
}
constexpr int ATTN_LDS_BYTES=LDS_BYTES;
#undef SBAR
#undef WAIT_BAR
}

#define GAS __attribute__((address_space(1)))
#define LAS __attribute__((address_space(3)))
typedef unsigned short bf16;
typedef unsigned v4u __attribute__((ext_vector_type(4)));
typedef unsigned v2u __attribute__((ext_vector_type(2)));
typedef float f32x4 __attribute__((ext_vector_type(4)));
typedef float f32x16 __attribute__((ext_vector_type(16)));
typedef short bf16x8 __attribute__((ext_vector_type(8)));
typedef short s16x4 __attribute__((ext_vector_type(4)));
#define LDS_WAIT() asm volatile("s_waitcnt lgkmcnt(0)" ::: "memory")

constexpr int DMODEL = 1024, NIN = 9728, FFH = 2816;
constexpr int S_P = 4096, S_S = 2048;
constexpr int CT = 32768, NCHUNK = 3;
constexpr float EPS = 1e-6f;
constexpr float C2 = 0.18033688011112042f;
constexpr int LDS_BYTES = 147456;
constexpr int NWAVES = 8;

constexpr size_t MiB = 1u << 20;
constexpr size_t WS_MOD = 1 * MiB, WS_ROPE = 2 * MiB;
constexpr size_t WS_WIN = 4 * MiB, WS_WA = 23 * MiB, WS_WB = 25 * MiB, WS_WOUT = 26 * MiB, WS_WGU = 28 * MiB, WS_WDN = 39 * MiB;
constexpr size_t WS_H = 48 * MiB;
constexpr size_t WS_QA = 112 * MiB, WS_KA = 176 * MiB, WS_VA = 240 * MiB, WS_G0 = 304 * MiB  , WS_G1 = 592 * MiB, WS_G2 = 656 * MiB;
constexpr size_t WS_O1 = 720 * MiB, WS_O2 = 784 * MiB, WS_OG = 848 * MiB  , WS_LSE = 944 * MiB  , WS_END = 948 * MiB;
constexpr size_t WS_OA = WS_O1  , WS_OB = WS_G0, WS_MRG = WS_KA, WS_ACT = WS_VA, WS_X1 = WS_QA  , WS_X2 = WS_KA  ;

struct Args {
    const float *x_prompt, *x_sample, *c_prompt, *c_sample, *w_ada, *b_ada, *g_mix, *w_in, *lq1, *lk1, *lq2, *lk2, *g_subln, *w_a, *w_b, *w_out, *g_ffn, *w_gu, *w_down, *g_final;
    float* out; unsigned char* ws;
};

typedef const __attribute__((address_space(4))) Args* CArgs;
__device__ __forceinline__ CArgs argp() { CArgs p = (CArgs)__builtin_amdgcn_kernarg_segment_ptr(); asm volatile("" : "+s"(p)); return p; }

__device__ __forceinline__ float wave_sum(float v) {
#pragma unroll
    for (int o = 1; o < 64; o <<= 1) v += __shfl_xor(v, o);
    return v;
}
__device__ __forceinline__ unsigned f2bf(float f) { unsigned u = __builtin_bit_cast(unsigned, f); return (u + 0x7fffu + ((u >> 16) & 1u)) >> 16; }
__device__ __forceinline__ unsigned pk2(float lo, float hi) { return f2bf(lo) | (f2bf(hi) << 16); }
__device__ __forceinline__ float bflo(unsigned w) { return __builtin_bit_cast(float, w << 16); }
__device__ __forceinline__ float bfhi(unsigned w) { return __builtin_bit_cast(float, w & 0xffff0000u); }

__device__ __forceinline__ int maprow(int mode, int n) {
    if (mode == 1) {
        const bool qk = (n < 2048) || (n >= 3072 && n < 7680 && ((n - 3072) % 1536) < 1024);
        const int i = n & 63;
        if (qk && i < 16) return n - i + ((i < 8) ? 2 * i : 2 * (i - 8) + 1);
        return n;
    }
    if (mode == 2) {
        const bool up = n >= FFH; const int j = up ? n - FFH : n;
        return 8 * (j >> 2) + (j & 3) + (up ? 4 : 0);
    }
    return n;
}
__device__ __forceinline__ void p0_transpose_item(const float* W, int K, int N, bf16* WT, int mode, LAS float* scr, int item, int lane) {
    const int nblk = N / 32, kb = item / nblk, nb = item % nblk, k0 = 64 * kb, n0 = 32 * nb;
#pragma unroll 8
    for (int i = 0; i < 32; ++i) { const int kk = 2 * i + (lane >> 5); scr[kk * 33 + (lane & 31)] = W[(size_t)(k0 + kk) * N + n0 + (lane & 31)]; }
    LDS_WAIT(); asm volatile("" ::: "memory");
    const int c = lane & 7;
#pragma unroll
    for (int j = 0; j < 4; ++j) { const int n = (lane >> 3) + 8 * j; const LAS float* s = scr + (8 * c) * 33 + n;
        v4u o; o.x = pk2(s[0 * 33], s[1 * 33]); o.y = pk2(s[2 * 33], s[3 * 33]); o.z = pk2(s[4 * 33], s[5 * 33]); o.w = pk2(s[6 * 33], s[7 * 33]);
        *(GAS v4u*)(WT + (size_t)maprow(mode, n0 + n) * K + k0 + 8 * c) = o; }
    LDS_WAIT(); asm volatile("" ::: "memory");
}
__constant__ double ROPE_INVREV[8] = {0.15915494309189535, 0.03086376340470123, 0.005985185712713705, 0.001160663641240061,
                                      0.00022507907903927653, 4.364795279280289e-05, 8.464330808241401e-06, 1.6414262627950345e-06};

__device__ __forceinline__ void p0_prologue(LAS unsigned char* lds, int tid, int lane, int wave, int vcu, int G) {
    CArgs ap = argp(); unsigned char* ws = ap->ws;
    LAS float* scr = (LAS float*)(lds + wave * 16384);
    const int gw = vcu * NWAVES + wave, NGW = G * NWAVES;
    constexpr int I_IN = 16 * (NIN / 32), I_A = 16 * 32, I_B = 8 * 32, I_O = 16 * 32, I_GU = 16 * (2 * FFH / 32), I_DN = (FFH / 64) * 32;
    constexpr int NITEMS = I_IN + I_A + I_B + I_O + I_GU + I_DN;
    for (int it = gw; it < NITEMS; it += NGW) {
        int r = it;
        if (r < I_IN) { p0_transpose_item(ap->w_in, 1024, NIN, (bf16*)(ws + WS_WIN), 1, scr, r, lane); continue; } r -= I_IN;
        if (r < I_A) { p0_transpose_item(ap->w_a, 1024, 1024, (bf16*)(ws + WS_WA), 0, scr, r, lane); continue; } r -= I_A;
        if (r < I_B) { p0_transpose_item(ap->w_b, 512, 1024, (bf16*)(ws + WS_WB), 0, scr, r, lane); continue; } r -= I_B;
        if (r < I_O) { p0_transpose_item(ap->w_out, 1024, 1024, (bf16*)(ws + WS_WOUT), 0, scr, r, lane); continue; } r -= I_O;
        if (r < I_GU) { p0_transpose_item(ap->w_gu, 1024, 2 * FFH, (bf16*)(ws + WS_WGU), 2, scr, r, lane); continue; } r -= I_GU;
        p0_transpose_item(ap->w_down, FFH, 1024, (bf16*)(ws + WS_WDN), 0, scr, r, lane);
    }
    for (int idx = blockIdx.x * 512 + tid; idx < 4096 * 8; idx += G * 512) {
        const int pos = idx >> 3, i = idx & 7;
        const double rev = (double)pos * ROPE_INVREV[i]; const float fr = (float)(rev - __builtin_floor(rev));
        float2 cs; cs.x = __builtin_amdgcn_cosf(fr); cs.y = __builtin_amdgcn_sinf(fr);
        ((float2*)(ws + WS_ROPE))[idx] = cs;
    }
    __syncthreads();
    const int bx = blockIdx.x;
    if (bx < 192) {
        const int n0 = bx * 32, b = lane & 31, h = lane >> 5;
        const float* crow_ = (b < 16) ? ap->c_prompt + (size_t)b * 1024 : ap->c_sample + (size_t)(b - 16) * 1024;
        f32x16 acc = {};
#pragma unroll 4
        for (int i = 0; i < 16; ++i) {
            const int k = 128 * wave + 8 * i + 4 * h;
            const f32x4 c4 = *(const f32x4*)(crow_ + k);
#pragma unroll
            for (int e = 0; e < 4; ++e) {
                const float cv = c4[e], sv = cv / (1.f + __expf(-cv));
                const float wv = ap->w_ada[(size_t)(k + e) * 6144 + n0 + (lane & 31)];
                acc = __builtin_amdgcn_mfma_f32_32x32x2f32(sv, wv, acc, 0, 0, 0);
            }
        }
        LAS float* red = (LAS float*)lds;
#pragma unroll
        for (int r = 0; r < 16; ++r) red[(wave * 16 + r) * 64 + lane] = acc[r];
        __syncthreads();
#pragma unroll
        for (int j = 0; j < 2; ++j) {
            const int o = tid + 512 * j, nn = o & 31, bb = o >> 5;
            const int hh = (bb >> 2) & 1, r = (bb & 3) + 4 * (bb >> 3), ln = nn + 32 * hh;
            float s = ap->b_ada[n0 + nn];
#pragma unroll
            for (int w = 0; w < 8; ++w) s += red[(w * 16 + r) * 64 + ln];
            ((float*)(ws + WS_MOD))[(size_t)bb * 6144 + n0 + nn] = s;
        }
    }
    __syncthreads();
}

__device__ __forceinline__ f32x4 ld4(const float* p) { return *(const GAS f32x4*)p; }
__device__ __forceinline__ f32x4 ld4(const bf16* p) { const v2u w = *(const GAS v2u*)p; return (f32x4){bflo(w.x), bfhi(w.x), bflo(w.y), bfhi(w.y)}; }
template <class T> __device__ __forceinline__ void rows_norm_mod(const T* xsrc, bf16* dst, const float* gain, const float* mod, int sh_idx, int sc_idx, int S, int b0, int gw, int NGW, int lane) {
    constexpr int RB = 4;
    for (int row0 = gw; row0 < CT; row0 += RB * NGW) {
        f32x4 v[RB][4]; float ss[RB];
#pragma unroll
        for (int q = 0; q < RB; ++q) { const int row = row0 + q * NGW; const T* xr = xsrc + (size_t)(row < CT ? row : row0) * 1024 + 4 * lane;
#pragma unroll
            for (int j = 0; j < 4; ++j) v[q][j] = ld4(xr + 256 * j); }
#pragma unroll
        for (int q = 0; q < RB; ++q) { float s = 0.f;
#pragma unroll
            for (int j = 0; j < 4; ++j) s += (v[q][j].x * v[q][j].x + v[q][j].y * v[q][j].y) + (v[q][j].z * v[q][j].z + v[q][j].w * v[q][j].w);
            ss[q] = s; }
#pragma unroll
        for (int o = 1; o < 64; o <<= 1)
#pragma unroll
            for (int q = 0; q < RB; ++q) ss[q] += __shfl_xor(ss[q], o);
#pragma unroll
        for (int q = 0; q < RB; ++q) { const int row = row0 + q * NGW; if (row < CT) {
            const float rstd = 1.f / sqrtf(ss[q] * (1.f / 1024.f) + EPS);
            const float* mb = mod + (size_t)(b0 + row / S) * 6144;
            GAS unsigned long long* o8 = (GAS unsigned long long*)(dst + (size_t)row * 1024) + lane;
#pragma unroll
            for (int j = 0; j < 4; ++j) {
                const f32x4 g = *(const f32x4*)(gain + 4 * lane + 256 * j);
                const f32x4 sc = *(const f32x4*)(mb + sc_idx * 1024 + 4 * lane + 256 * j), sh = *(const f32x4*)(mb + sh_idx * 1024 + 4 * lane + 256 * j);
                const f32x4 h = v[q][j] * rstd * g * (1.f + sc) + sh;
                o8[64 * j] = (unsigned long long)pk2(h.x, h.y) | ((unsigned long long)pk2(h.z, h.w) << 32);
            } } }
    }
}
__device__ __forceinline__ void rows_final_norm(const bf16* x2, float* out, const float* gain, int gw, int NGW, int lane) {
    constexpr int RB = 4;
    f32x4 g[4];
#pragma unroll
    for (int j = 0; j < 4; ++j) g[j] = *(const f32x4*)(gain + 4 * lane + 256 * j);
    for (int row0 = gw; row0 < CT; row0 += RB * NGW) {
        f32x4 v[RB][4]; float ss[RB];
#pragma unroll
        for (int q = 0; q < RB; ++q) { const int row = row0 + q * NGW; const bf16* xr = x2 + (size_t)(row < CT ? row : row0) * 1024 + 4 * lane;
#pragma unroll
            for (int j = 0; j < 4; ++j) v[q][j] = ld4(xr + 256 * j); }
#pragma unroll
        for (int q = 0; q < RB; ++q) { float s = 0.f;
#pragma unroll
            for (int j = 0; j < 4; ++j) s += (v[q][j].x * v[q][j].x + v[q][j].y * v[q][j].y) + (v[q][j].z * v[q][j].z + v[q][j].w * v[q][j].w);
            ss[q] = s; }
#pragma unroll
        for (int o = 1; o < 64; o <<= 1)
#pragma unroll
            for (int q = 0; q < RB; ++q) ss[q] += __shfl_xor(ss[q], o);
#pragma unroll
        for (int q = 0; q < RB; ++q) { const int row = row0 + q * NGW; if (row < CT) {
            const float rstd = 1.f / sqrtf(ss[q] * (1.f / 1024.f) + EPS);
            GAS f32x4* orow = (GAS f32x4*)(out + (size_t)row * 1024) + lane;
#pragma unroll
            for (int j = 0; j < 4; ++j) orow[64 * j] = v[q][j] * rstd * g[j];
        } }
    }
}
__device__ __forceinline__ void rows_combine(int gw, int NGW, int lane) {
    CArgs ap = argp(); unsigned char* ws = ap->ws;
    const bf16* OG = (const bf16*)(ws + WS_OG); const float* LSE = (const float*)(ws + WS_LSE); bf16* OB = (bf16*)(ws + WS_OB);
    constexpr int RB = 4;
    const int hd = lane >> 3;
    for (int row0 = gw; row0 < CT; row0 += RB * NGW) {
        float l[RB][3]; v4u g[RB][3];
#pragma unroll
        for (int q = 0; q < RB; ++q) { const int row = (row0 + q * NGW < CT) ? row0 + q * NGW : row0;
#pragma unroll
            for (int k = 0; k < 3; ++k) { l[q][k] = LSE[((size_t)k * CT + row) * 8 + hd]; g[q][k] = *(const v4u*)(OG + ((size_t)k * CT + row) * 512 + 8 * lane); } }
#pragma unroll
        for (int q = 0; q < RB; ++q) { const int row = row0 + q * NGW; if (row < CT) {
            const float mx = fmaxf(l[q][0], fmaxf(l[q][1], l[q][2]));
            float w0 = __builtin_amdgcn_exp2f(l[q][0] - mx), w1 = __builtin_amdgcn_exp2f(l[q][1] - mx), w2 = __builtin_amdgcn_exp2f(l[q][2] - mx);
            const float inv = 1.f / (w0 + w1 + w2); w0 *= inv; w1 *= inv; w2 *= inv;
            v4u ob;
#pragma unroll
            for (int i = 0; i < 4; ++i) ob[i] = pk2(w0 * bflo(g[q][0][i]) + w1 * bflo(g[q][1][i]) + w2 * bflo(g[q][2][i]), w0 * bfhi(g[q][0][i]) + w1 * bfhi(g[q][1][i]) + w2 * bfhi(g[q][2][i]));
            *(v4u*)(OB + (size_t)row * 512 + 8 * lane) = ob;
        } }
    }
}

using pg8::Unit;
typedef pg8::f32x4 pf4;
__device__ __forceinline__ v4u pack8(const pf4 v0, const pf4 v1) { v4u w; w.x = pg8::cvt_pk_bf16(v0[0], v0[1]); w.y = pg8::cvt_pk_bf16(v0[2], v0[3]); w.z = pg8::cvt_pk_bf16(v1[0], v1[1]); w.w = pg8::cvt_pk_bf16(v1[2], v1[3]); return w; }
__device__ __forceinline__ float sigm(float x) { return __builtin_amdgcn_rcpf(1.f + __expf(-x)); }

struct EpiIn {
    static constexpr bool PERM = true, AFTER_DRAIN = false;
    unsigned char* ws; int S;
    __device__ __forceinline__ void operator()(const pf4 (&acc)[2][2][4][2], const Unit& u, int wr, int wc, int fr, int fq) const {
        int pm_ = u.pm, pn_ = u.pn; asm volatile("" : "+s"(pm_), "+s"(pn_)); const Unit uu{pm_, pn_};
        const int pn = uu.pn; int kind, ldc = 1024, ct; size_t base;
        if (pn < 4) { kind = 1; base = WS_QA; ct = pn; }
        else if (pn < 8) { kind = 2; base = WS_KA; ct = pn - 4; }
        else if (pn < 12) { kind = 0; base = WS_VA; ct = pn - 8; }
        else if (pn < 30) { const int q = pn - 12, g = q / 6, r = q % 6, part = r >> 1; ct = r & 1; ldc = 512; base = WS_G0 + (size_t)(g * 3 + part) * 32 * MiB; kind = part == 0 ? 1 : (part == 1 ? 2 : 0); }
        else if (pn < 34) { kind = 3; base = WS_G1; ct = pn - 30; }
        else { kind = 3; base = WS_G2; ct = pn - 34; }
        bf16* O = (bf16*)(ws + base);
        const int row0 = uu.pm * 256 + wr * 64 + fr, col0 = ct * 256 + wc * 32 + 8 * fq;
        const bool ropew = (kind == 1 || kind == 2) && ((wc & 1) == 0); const bool ropel = fq < 2;
        const float sc = kind == 1 ? C2 : 1.f;
        const float* rope = (const float*)(ws + WS_ROPE);
        if (ropew) {
#pragma unroll
            for (int ai = 0; ai < 2; ++ai) {
            pf4 cs0[4], cs1[4];
#pragma unroll
            for (int q = 0; q < 4; ++q) { const int row = row0 + ai * 128 + q * 16; const float* rp = rope + ((size_t)(row % S) * 8 + 4 * (fq & 1)) * 2; cs0[q] = *(const pf4*)rp; cs1[q] = *(const pf4*)(rp + 4); }
            asm volatile("" ::: "memory");
#pragma unroll
            for (int q = 0; q < 4; ++q) {
                const int m = q, row = row0 + ai * 128 + m * 16;
                bf16* rowp = O + (size_t)row * ldc + col0;
#pragma unroll
                for (int bj = 0; bj < 2; ++bj) {
                    pf4 v0 = acc[ai][bj][m][0], v1 = acc[ai][bj][m][1];
                    pf4 r0, r1;
                    r0[0] = v0[0] * cs0[q][0] - v0[1] * cs0[q][1]; r0[1] = v0[1] * cs0[q][0] + v0[0] * cs0[q][1];
                    r0[2] = v0[2] * cs0[q][2] - v0[3] * cs0[q][3]; r0[3] = v0[3] * cs0[q][2] + v0[2] * cs0[q][3];
                    r1[0] = v1[0] * cs1[q][0] - v1[1] * cs1[q][1]; r1[1] = v1[1] * cs1[q][0] + v1[0] * cs1[q][1];
                    r1[2] = v1[2] * cs1[q][2] - v1[3] * cs1[q][3]; r1[3] = v1[3] * cs1[q][2] + v1[2] * cs1[q][3];
                    if (ropel) { v0 = r0; v1 = r1; }
                    v0 = v0 * sc; v1 = v1 * sc;
                    *(v4u*)(rowp + bj * 128) = pack8(v0, v1);
                }
            }
            asm volatile("" ::: "memory");
            }
        } else {
#pragma unroll
            for (int ai = 0; ai < 2; ++ai)
#pragma unroll
                for (int m = 0; m < 4; ++m) {
                    const int row = row0 + ai * 128 + m * 16;
                    bf16* rowp = O + (size_t)row * ldc + col0;
#pragma unroll
                    for (int bj = 0; bj < 2; ++bj) {
                        pf4 v0 = acc[ai][bj][m][0], v1 = acc[ai][bj][m][1];
                        if (kind == 3) {
#pragma unroll
                            for (int e = 0; e < 4; ++e) { v0[e] = sigm(v0[e]); v1[e] = sigm(v1[e]); }
                        }
                        v0 = v0 * sc; v1 = v1 * sc;
                        *(v4u*)(rowp + bj * 128) = pack8(v0, v1);
                    }
                }
        }
    }
};
struct EpiGate {
    static constexpr bool PERM = true, AFTER_DRAIN = false;
    const bf16* gate; bf16* O; int mode;
    __device__ __forceinline__ void operator()(const pf4 (&acc)[2][2][4][2], const Unit& u, int wr, int wc, int fr, int fq) const {
        int pm_ = u.pm, pn_ = u.pn; asm volatile("" : "+s"(pm_), "+s"(pn_)); const Unit uu{pm_, pn_};
        const int row0 = uu.pm * 256 + wr * 64 + fr, col0 = uu.pn * 256 + wc * 32 + 8 * fq;
#pragma unroll
        for (int ai = 0; ai < 2; ++ai) {
            v4u gv[4][2], pv[4][2];
#pragma unroll
            for (int m = 0; m < 4; ++m)
#pragma unroll
                for (int bj = 0; bj < 2; ++bj) { const size_t off = (size_t)(row0 + ai * 128 + m * 16) * 1024 + col0 + bj * 128;
                    gv[m][bj] = *(const v4u*)(gate + off); pv[m][bj] = mode ? *(const v4u*)(O + off) : (v4u){0u, 0u, 0u, 0u}; }
            asm volatile("" ::: "memory");
#pragma unroll
            for (int m = 0; m < 4; ++m)
#pragma unroll
                for (int bj = 0; bj < 2; ++bj) { const size_t off = (size_t)(row0 + ai * 128 + m * 16) * 1024 + col0 + bj * 128;
                    const v4u g = gv[m][bj], p = pv[m][bj];
                    pf4 v0 = acc[ai][bj][m][0], v1 = acc[ai][bj][m][1];
                    v0[0] = v0[0] * bflo(g.x) + bflo(p.x); v0[1] = v0[1] * bfhi(g.x) + bfhi(p.x); v0[2] = v0[2] * bflo(g.y) + bflo(p.y); v0[3] = v0[3] * bfhi(g.y) + bfhi(p.y);
                    v1[0] = v1[0] * bflo(g.z) + bflo(p.z); v1[1] = v1[1] * bfhi(g.z) + bfhi(p.z); v1[2] = v1[2] * bflo(g.w) + bflo(p.w); v1[3] = v1[3] * bfhi(g.w) + bfhi(p.w);
                    *(v4u*)(O + off) = pack8(v0, v1); }
            asm volatile("" ::: "memory");
        }
    }
};
template <bool IN_BF16> struct EpiRes {
    static constexpr bool PERM = true, AFTER_DRAIN = false;
    const void* base; bf16* out; const float* mod; int gidx, S, b0;
    __device__ __forceinline__ void operator()(const pf4 (&acc)[2][2][4][2], const Unit& u, int wr, int wc, int fr, int fq) const {
        int pm_ = u.pm, pn_ = u.pn; asm volatile("" : "+s"(pm_), "+s"(pn_)); const Unit uu{pm_, pn_};
        const int row0 = uu.pm * 256 + wr * 64 + fr, col0 = uu.pn * 256 + wc * 32 + 8 * fq;
        const float* gp = mod + (size_t)(b0 + (uu.pm * 256) / S) * 6144 + gidx * 1024 + col0;
        pf4 gt[2][2];
#pragma unroll
        for (int bj = 0; bj < 2; ++bj) { gt[bj][0] = *(const pf4*)(gp + bj * 128); gt[bj][1] = *(const pf4*)(gp + bj * 128 + 4); }
#pragma unroll
        for (int q = 0; q < 4; ++q) {
            pf4 xb[2][2][2];
#pragma unroll
            for (int mm = 0; mm < 2; ++mm)
#pragma unroll
                for (int bj = 0; bj < 2; ++bj) { const size_t off = (size_t)(row0 + (q >> 1) * 128 + ((q & 1) * 2 + mm) * 16) * 1024 + col0 + bj * 128;
                    if (IN_BF16) { const v4u w = *(const v4u*)((const bf16*)base + off);
                        xb[mm][bj][0] = (pf4){bflo(w.x), bfhi(w.x), bflo(w.y), bfhi(w.y)}; xb[mm][bj][1] = (pf4){bflo(w.z), bfhi(w.z), bflo(w.w), bfhi(w.w)}; }
                    else { xb[mm][bj][0] = *(const pf4*)((const float*)base + off); xb[mm][bj][1] = *(const pf4*)((const float*)base + off + 4); } }
            asm volatile("" ::: "memory");
#pragma unroll
            for (int mm = 0; mm < 2; ++mm)
#pragma unroll
                for (int bj = 0; bj < 2; ++bj) { const int ai = q >> 1, m = (q & 1) * 2 + mm; const size_t off = (size_t)(row0 + ai * 128 + m * 16) * 1024 + col0 + bj * 128;
                    *(v4u*)(out + off) = pack8(xb[mm][bj][0] + gt[bj][0] * acc[ai][bj][m][0], xb[mm][bj][1] + gt[bj][1] * acc[ai][bj][m][1]); }
            asm volatile("" ::: "memory");
        }
    }
};
struct EpiGU {
    static constexpr bool PERM = true, AFTER_DRAIN = false;
    bf16* act;
    __device__ __forceinline__ void operator()(const pf4 (&acc)[2][2][4][2], const Unit& u, int wr, int wc, int fr, int fq) const {
        int pm_ = u.pm, pn_ = u.pn; asm volatile("" : "+s"(pm_), "+s"(pn_)); const Unit uu{pm_, pn_};
        const int row0 = uu.pm * 256 + wr * 64 + fr, col0 = uu.pn * 128 + wc * 16 + 4 * fq;
#pragma unroll
        for (int ai = 0; ai < 2; ++ai)
#pragma unroll
            for (int m = 0; m < 4; ++m) {
                bf16* rowp = act + (size_t)(row0 + ai * 128 + m * 16) * FFH + col0;
#pragma unroll
                for (int bj = 0; bj < 2; ++bj) {
                    const pf4 g = acc[ai][bj][m][0], up = acc[ai][bj][m][1]; pf4 r;
#pragma unroll
                    for (int e = 0; e < 4; ++e) r[e] = g[e] * sigm(g[e]) * up[e];
                    v2u w; w.x = pg8::cvt_pk_bf16(r[0], r[1]); w.y = pg8::cvt_pk_bf16(r[2], r[3]);
                    *(v2u*)(rowp + bj * 64) = w;
                }
                asm volatile("" ::: "memory");
            }
    }
};

__device__ __forceinline__ float halfmax(float m) { auto rr = __builtin_amdgcn_permlane32_swap(__float_as_uint(m), __float_as_uint(m), false, false); return fmaxf(__uint_as_float(rr[0]), __uint_as_float(rr[1])); }
__device__ __forceinline__ float halfsum(float m) { auto rr = __builtin_amdgcn_permlane32_swap(__float_as_uint(m), __float_as_uint(m), false, false); return __uint_as_float(rr[0]) + __uint_as_float(rr[1]); }
typedef short v4i16_t __attribute__((ext_vector_type(4)));
__device__ __forceinline__ s16x4 trrd(LAS unsigned char* p) { return __builtin_bit_cast(s16x4, __builtin_amdgcn_ds_read_tr16_b64_v4i16((LAS v4i16_t*)p)); }
__device__ __forceinline__ void dil_unit(const bf16* Qg, const bf16* Kg, const bf16* Vg, bf16* Og, float* Lg, int r, int n, int dil, int T, LAS unsigned char* wl, int lane) {
    const int r32 = lane & 31, hi = lane >> 5;
    LAS unsigned char* vimg = wl;
    LAS bf16* stg = (LAS bf16*)(wl + 4096);
    LAS float* wsf = (LAS float*)(wl + 8192);
    const int vwr = ((lane & 7) >> 2) * 2048 + (lane >> 3) * 64 + (lane & 3) * 16;
    const int vrd = ((lane >> 4) & 1) * 32 + (lane & 3) * 8 + (4 * hi + ((lane & 15) >> 2)) * 64;
    for (int qi = 0; qi < 2; ++qi) {
        const int tq0 = 64 * n + 32 * qi;
        const bf16* qp = Qg + (size_t)(r + dil * (tq0 + r32)) * 512 + 8 * hi;
        bf16x8 qf[4];
#pragma unroll
        for (int d0 = 0; d0 < 4; ++d0) qf[d0] = *(const bf16x8*)(qp + 16 * d0);
        bf16x8 kf[5][4];
#pragma unroll
        for (int kb = 0; kb < 5; ++kb) {
            int tk = tq0 - 64 + 32 * kb + r32; tk = tk < 0 ? 0 : (tk >= T ? T - 1 : tk);
            const bf16* kp = Kg + (size_t)(r + dil * tk) * 512 + 8 * hi;
#pragma unroll
            for (int d0 = 0; d0 < 4; ++d0) kf[kb][d0] = *(const bf16x8*)(kp + 16 * d0);
        }
        f32x16 s[5];
#pragma unroll
        for (int kb = 0; kb < 5; ++kb) {
            f32x16 acc = {};
#pragma unroll
            for (int d0 = 0; d0 < 4; ++d0) acc = __builtin_amdgcn_mfma_f32_32x32x16_bf16(kf[kb][d0], qf[d0], acc, 0, 0, 0);
            s[kb] = acc;
        }
        bf16x8 vv[5][4];
#pragma unroll
        for (int kb = 0; kb < 5; ++kb)
#pragma unroll
            for (int j = 0; j < 4; ++j) { int tk = tq0 - 64 + 32 * kb + 8 * j + (lane >> 3); tk = tk < 0 ? 0 : (tk >= T ? T - 1 : tk);
                vv[kb][j] = *(const bf16x8*)(Vg + (size_t)(r + dil * tk) * 512 + 8 * (lane & 7)); }
#pragma unroll
        for (int kb = 0; kb < 5; ++kb) {
            const int tk0 = tq0 - 64 + 32 * kb;
#pragma unroll
            for (int rr = 0; rr < 16; ++rr) {
                const int cr = (rr & 3) + 8 * (rr >> 2) + 4 * hi; const int rel = -64 + 32 * kb + cr - r32; const int kt = tk0 + cr;
                const bool ok = (rel >= -64) && (rel <= 64) && (kt >= 0) && (kt < T);
                s[kb][rr] = ok ? s[kb][rr] : -INFINITY;
            }
        }
        float mx = -INFINITY;
#pragma unroll
        for (int kb = 0; kb < 5; ++kb)
#pragma unroll
            for (int rr = 0; rr < 16; ++rr) mx = fmaxf(mx, s[kb][rr]);
        mx = halfmax(mx);
        float lsum = 0.f;
#pragma unroll
        for (int kb = 0; kb < 5; ++kb)
#pragma unroll
            for (int rr = 0; rr < 16; ++rr) { const float p = __builtin_amdgcn_exp2f(s[kb][rr] - mx); s[kb][rr] = p; lsum += p; }
        lsum = halfsum(lsum);
        f32x16 o[2]; o[0] = f32x16{}; o[1] = f32x16{};
#pragma unroll
        for (int kb = 0; kb < 5; ++kb) {
#pragma unroll
            for (int j = 0; j < 4; ++j) *(LAS bf16x8*)(vimg + vwr + j * 512) = vv[kb][j];
#pragma unroll
            for (int ks = 0; ks < 2; ++ks) {
                v4u pw;
#pragma unroll
                for (int e = 0; e < 4; ++e) pw[e] = pg8::cvt_pk_bf16(s[kb][8 * ks + 2 * e], s[kb][8 * ks + 2 * e + 1]);
                const bf16x8 pa = __builtin_bit_cast(bf16x8, pw);
#pragma unroll
                for (int d0 = 0; d0 < 2; ++d0) {
                    const s16x4 lo = trrd(vimg + vrd + d0 * 2048 + ks * 1024), hh = trrd(vimg + vrd + d0 * 2048 + ks * 1024 + 512);
                    const bf16x8 vb = (bf16x8){lo[0], lo[1], lo[2], lo[3], hh[0], hh[1], hh[2], hh[3]};
                    o[d0] = __builtin_amdgcn_mfma_f32_32x32x16_bf16(pa, vb, o[d0], 0, 0, 0);
                }
            }
        }
        if (hi == 0) wsf[r32] = lsum;
#pragma unroll
        for (int rr = 0; rr < 16; ++rr) {
            const int orow = (rr & 3) + 8 * (rr >> 2) + 4 * hi; const float rl = __builtin_amdgcn_rcpf(wsf[orow]);
#pragma unroll
            for (int d0 = 0; d0 < 2; ++d0) stg[orow * 64 + d0 * 32 + r32] = (bf16)f2bf(o[d0][rr] * rl);
        }
#pragma unroll
        for (int i = 0; i < 4; ++i) { const int row = i * 8 + (lane >> 3), ch = lane & 7; const v4u v = *(const LAS v4u*)(stg + row * 64 + ch * 8);
            *(v4u*)(Og + (size_t)(r + dil * (tq0 + row)) * 512 + ch * 8) = v; }
        if (hi == 0) Lg[(size_t)(r + dil * (tq0 + r32)) * 8] = mx + __builtin_amdgcn_logf(lsum);
    }
}

#define XB_TMO      128
#define XB_XCNT(j)  (256  + 64 * (j))
#define XB_XSUB(j)  (1280 + 64 * (j))
#define XB_XGEN(j)  (2304 + 64 * (j))
#define XB_TOP      3328
#define XB_TOPGEN   3392
#define XCD_BAR_WORDS 3456
#define XB_SPIN_CAP (1u << 18)

__device__ __forceinline__ unsigned xb_ld(unsigned* p)              { return __hip_atomic_load(p, __ATOMIC_RELAXED, __HIP_MEMORY_SCOPE_AGENT); }
__device__ __forceinline__ unsigned xb_add(unsigned* p, unsigned v) { return __hip_atomic_fetch_add(p, v, __ATOMIC_RELAXED, __HIP_MEMORY_SCOPE_AGENT); }
__device__ __forceinline__ unsigned xb_xcc_id() { return (unsigned)__builtin_amdgcn_s_getreg((3 << 11) | 20) & 0xFu; }
#define XB_SPIN(cond, bar) do { unsigned _sp = 0; while (cond) { __builtin_amdgcn_s_sleep(1); \
    if ((++_sp & 255u) == 0u) { if (xb_ld(&(bar)[XB_TMO])) break; if (_sp > XB_SPIN_CAP) { atomicAdd(&(bar)[XB_TMO], 1u); break; } } } } while (0)

struct XcdBarrier {
    unsigned* bar; unsigned x;
    volatile LAS unsigned* st;
};

__device__ __forceinline__ XcdBarrier xcd_barrier_post(unsigned* bar, volatile LAS unsigned* st, const bool lead) {
    XcdBarrier b; b.bar = bar; b.x = xb_xcc_id(); b.st = st;
    if (lead) (void)xb_add(&bar[XB_XCNT(b.x)], 1u);
    return b;
}
__device__ __forceinline__ void xcd_barrier_complete(unsigned* bar, unsigned x, unsigned& nloc, unsigned& nx) {
    const unsigned G = gridDim.x * gridDim.y * gridDim.z;
    unsigned sum, cnt, mine, sp = 0u;
    for (;;) {
        sum = 0u; cnt = 0u; mine = 0u;
#pragma unroll
        for (unsigned j = 0; j < 16; ++j) { const unsigned c = xb_ld(&bar[XB_XCNT(j)]); sum += c; cnt += (c > 0u) ? 1u : 0u; mine = (j == x) ? c : mine; }
        if (sum == G) break;
        __builtin_amdgcn_s_sleep(1);
        if ((++sp & 255u) == 0u) { if (xb_ld(&bar[XB_TMO])) break; if (sp > XB_SPIN_CAP) { atomicAdd(&bar[XB_TMO], 1u); break; } }
    }
    nloc = mine > 0u ? mine : 1u; nx = cnt > 0u ? cnt : 1u;
}

__device__ __forceinline__ void xcd_barrier(const XcdBarrier& b, const bool lead) {
    asm volatile("s_waitcnt vmcnt(0)" ::: "memory");
    __syncthreads();
    if (lead) {
        unsigned* bar = b.bar;
        __builtin_amdgcn_s_waitcnt(0);
        unsigned nloc = b.st[0], nx = b.st[1];
        if (nloc == 0u) { xcd_barrier_complete(bar, b.x, nloc, nx); b.st[0] = nloc; b.st[1] = nx; }
        const unsigned old = xb_add(&bar[XB_XSUB(b.x)], 1u);
        const unsigned gen = old / nloc;
        if (old + 1u == (gen + 1u) * nloc) {
            __builtin_amdgcn_fence(__ATOMIC_RELEASE, "agent");
            asm volatile("s_waitcnt vmcnt(0)" ::: "memory");
            const unsigned og = xb_add(&bar[XB_TOP], 1u);
            const unsigned tg = og / nx;
            if (og + 1u == (tg + 1u) * nx) xb_add(&bar[XB_TOPGEN], 1u);
            else XB_SPIN(xb_ld(&bar[XB_TOPGEN]) == tg, bar);
            __builtin_amdgcn_fence(__ATOMIC_ACQUIRE, "agent");
            xb_add(&bar[XB_XGEN(b.x)], 1u);
            asm volatile("s_waitcnt vmcnt(0)" ::: "memory");
        } else {
            XB_SPIN(xb_ld(&bar[XB_XGEN(b.x)]) == gen, bar);
            __builtin_amdgcn_fence(__ATOMIC_ACQUIRE, "agent");
            asm volatile("s_waitcnt vmcnt(0)" ::: "memory");
        }
    }
    __syncthreads();
}

#ifndef PROBE_GIN
#define PROBE_GIN 1
#endif
#ifndef PROBE_GU
#define PROBE_GU 1
#endif
#ifndef PROBE_P9
#define PROBE_P9 1
#endif
#ifndef PROBE_P6
#define PROBE_P6 1
#endif
#ifndef PROBE_P5
#define PROBE_P5 1
#endif
#ifndef PROBE_P0
#define PROBE_P0 1
#endif
#ifndef PROBE_DIL
#define PROBE_DIL 1
#endif
#ifndef PROBE_ATT
#define PROBE_ATT 1
#endif
#ifndef PROBE_ROWS
#define PROBE_ROWS 1
#endif
#ifndef PROBE_SYNC
#define PROBE_SYNC 1
#endif
#define GSYNC() do { MKLANE(); for (int s_ = 0; s_ < PROBE_SYNC; ++s_) xcd_barrier(bar, tid == 0); } while (0)
__global__ void __launch_bounds__(NWAVES * 64, 2) fwd_megakernel(Args a) {
    extern __shared__ __attribute__((aligned(16))) unsigned char lds_raw[];
    cg::grid_group grid = cg::this_grid();
    LAS unsigned char* lds = (LAS unsigned char*)lds_raw;
    const int wave = __builtin_amdgcn_readfirstlane((int)threadIdx.x >> 6);
#define MKLANE() int lane = (int)__builtin_amdgcn_mbcnt_hi(~0u, __builtin_amdgcn_mbcnt_lo(~0u, 0u)); asm volatile("" : "+v"(lane)); const int tid = wave * 64 + lane; (void)tid
#define MKIDS() int G = gridDim.x, bx = blockIdx.x; asm volatile("" : "+s"(G), "+s"(bx)); const int vcu = (G % 8 == 0) ? (bx % 8) * (G / 8) + bx / 8 : bx; const int gw = vcu * NWAVES + wave, NGW = G * NWAVES; (void)gw; (void)NGW; (void)vcu

#ifndef NO_P0
    volatile LAS unsigned* MISC = (volatile LAS unsigned*)(lds + LDS_BYTES - 256);
    { MKLANE(); if (tid < 32) MISC[tid] = 0u; }
    __syncthreads();
    XcdBarrier bar; { MKLANE(); bar = xcd_barrier_post((unsigned*)argp()->ws, MISC + 8, tid == 0); }
    for (int rep_ = 0; rep_ < PROBE_P0; ++rep_) { MKIDS(); MKLANE(); p0_prologue(lds, tid, lane, wave, vcu, G); }
#endif
    grid.sync();

    for (int c = 0; c < NCHUNK; ++c) {
        const int S = (c < 2) ? S_P : S_S, nseq = CT / S, b0 = (c < 2) ? c * 8 : 16;
#define FETCH() MKIDS(); MKLANE(); CArgs ap = argp(); unsigned char* ws = ap->ws; const float* mod = (const float*)(ws + WS_MOD); (void)mod
#define XC() ((c < 2) ? ap->x_prompt + (size_t)c * CT * 1024 : ap->x_sample)
#define OUTC() (ap->out + (size_t)c * CT * 1024)
        for (int rep_ = 0; rep_ < PROBE_ROWS; ++rep_) { FETCH(); rows_norm_mod(XC(), (bf16*)(ws + WS_H), ap->g_mix, mod, 0, 1, S, b0, gw, NGW, lane); }
        GSYNC();
        {   FETCH();
            pg8::Gemm g{(const pg8::bf16_t*)(ws + WS_H), (const pg8::bf16_t*)(ws + WS_WIN), CT, NIN, 1024}; pg8::StaticOrder So; So.init(CT, NIN, G, bx);
            EpiIn E{ws, S};
#ifndef NO_GIN
            for (int rep_ = 0; rep_ < PROBE_GIN; ++rep_)
            pg8::gemm_phase<EpiIn, pg8::StaticOrder, PG8_ALIGN, PG8_SP2>(lds, g, So, E, wave);
#endif
        }
        GSYNC();
        {   FETCH();
            const int NQB = S / 256, NT = S / 64, nunits = nseq * 8 * NQB;
            const float lam_v = __expf(wave_sum(ap->lq1[lane] * ap->lk1[lane])) - __expf(wave_sum(ap->lq2[lane] * ap->lk2[lane])) + 0.2f;
            const float lam = __builtin_bit_cast(float, __builtin_amdgcn_readfirstlane(__builtin_bit_cast(int, lam_v)));
            LAS float* gsl = (LAS float*)(lds + LDS_BYTES - 1024);
            if (tid < 128) gsl[tid] = ap->g_subln[tid] * 0.8f;
            __syncthreads();
            for (int rep_ = 0; rep_ < PROBE_ATT; ++rep_)
            for (int id = vcu; id < nunits; id += G) {
                const int qb = id % NQB; int t = id / NQB; const int h8 = t & 7, seq = t >> 3;
                const size_t rb = (size_t)seq * S * 1024;
                const attn_body::bf16* Qp = (const attn_body::bf16*)(ws + WS_QA) + rb + h8 * 128;
                const attn_body::bf16* Kp = (const attn_body::bf16*)(ws + WS_KA) + rb + h8 * 128;
                const attn_body::bf16* Vp = (const attn_body::bf16*)(ws + WS_VA) + rb + h8 * 128;
                attn_body::bf16* Op = (attn_body::bf16*)(ws + WS_OA) + rb + h8 * 128;
#ifndef NO_ATT
                attn_body::attn_unit<8, 1>(Qp, Kp, Vp, Op, qb * 256, NT, (char*)lds_raw, lam, gsl, wave);
                attn_body::attn_unit<8, 2>(Qp + 64, Kp + 64, Vp, Op, qb * 256, NT, (char*)lds_raw, lam, gsl, wave);
#endif
            }
            __syncthreads();
            const int nb64 = S / 64, ndu = 3 * nseq * nb64;
            for (int rep_ = 0; rep_ < PROBE_DIL; ++rep_)
            for (int id = vcu; id < ndu; id += G) {
                const int rn = id % nb64; int t = id / nb64; const int seq = t % nseq, g = t / nseq;
                const int dil = (g == 0) ? 1 : (g == 1 ? 4 : 16), T = S / dil, nb = T / 64, r = rn / nb, n = rn % nb;
                const size_t rb = (size_t)seq * S * 512 + wave * 64;
                const bf16* Qg = (const bf16*)(ws + WS_G0 + (size_t)(g * 3 + 0) * 32 * MiB) + rb;
                const bf16* Kg = (const bf16*)(ws + WS_G0 + (size_t)(g * 3 + 1) * 32 * MiB) + rb;
                const bf16* Vg = (const bf16*)(ws + WS_G0 + (size_t)(g * 3 + 2) * 32 * MiB) + rb;
                bf16* Og = (bf16*)(ws + WS_OG + (size_t)g * 32 * MiB) + rb;
                float* Lg = (float*)(ws + WS_LSE) + ((size_t)g * CT + (size_t)seq * S) * 8 + wave;
#ifndef NO_DIL
                dil_unit(Qg, Kg, Vg, Og, Lg, r, n, dil, T, lds + wave * 8704, lane);
#endif
            }
        }
        GSYNC();
#ifndef NO_COMB
        for (int rep_ = 0; rep_ < PROBE_ROWS; ++rep_) { MKIDS(); MKLANE(); rows_combine(gw, NGW, lane); }
#endif
        GSYNC();
        {   FETCH();
            for (int rep_ = 0; rep_ < PROBE_P5; ++rep_) {
            pg8::StaticOrder So; So.init(CT, 1024, G, bx);
            pg8::Gemm ga{(const pg8::bf16_t*)(ws + WS_OA), (const pg8::bf16_t*)(ws + WS_WA), CT, 1024, 1024};
            EpiGate Ea{(const bf16*)(ws + WS_G1), (bf16*)(ws + WS_MRG), 0};
#ifndef NO_GG
            pg8::gemm_phase<EpiGate, pg8::StaticOrder, PG8_ALIGN, PG8_SP2>(lds, ga, So, Ea, wave);
#endif
            pg8::Gemm gb{(const pg8::bf16_t*)(ws + WS_OB), (const pg8::bf16_t*)(ws + WS_WB), CT, 1024, 512};
            EpiGate Eb{(const bf16*)(ws + WS_G2), (bf16*)(ws + WS_MRG), 1};
#ifndef NO_GG
            pg8::gemm_phase<EpiGate, pg8::StaticOrder, PG8_ALIGN, PG8_SP2>(lds, gb, So, Eb, wave);
#endif
            }
        }
        GSYNC();
        {   FETCH();
            pg8::StaticOrder So; So.init(CT, 1024, G, bx);
            pg8::Gemm g{(const pg8::bf16_t*)(ws + WS_MRG), (const pg8::bf16_t*)(ws + WS_WOUT), CT, 1024, 1024};
            EpiRes<false> E{XC(), (bf16*)(ws + WS_X1), mod, 2, S, b0};
#ifndef NO_GR
            for (int rep_ = 0; rep_ < PROBE_P6; ++rep_)
            pg8::gemm_phase<EpiRes<false>, pg8::StaticOrder, PG8_ALIGN, PG8_SP2>(lds, g, So, E, wave);
#endif
        }
        GSYNC();
        for (int rep_ = 0; rep_ < PROBE_ROWS; ++rep_) { FETCH(); rows_norm_mod((const bf16*)(ws + WS_X1), (bf16*)(ws + WS_H), ap->g_ffn, mod, 3, 4, S, b0, gw, NGW, lane); }
        GSYNC();
        {   FETCH();
            pg8::StaticOrder So; So.init(CT, 2 * FFH, G, bx);
            pg8::Gemm g{(const pg8::bf16_t*)(ws + WS_H), (const pg8::bf16_t*)(ws + WS_WGU), CT, 2 * FFH, 1024};
            EpiGU E{(bf16*)(ws + WS_ACT)};
#ifndef NO_GU
            for (int rep_ = 0; rep_ < PROBE_GU; ++rep_)
            pg8::gemm_phase<EpiGU, pg8::StaticOrder, PG8_ALIGN, PG8_SP2>(lds, g, So, E, wave);
#endif
        }
        GSYNC();
        {   FETCH();
            pg8::StaticOrder So; So.init(CT, 1024, G, bx);
            pg8::Gemm g{(const pg8::bf16_t*)(ws + WS_ACT), (const pg8::bf16_t*)(ws + WS_WDN), CT, 1024, FFH};
            EpiRes<true> E{(const bf16*)(ws + WS_X1), (bf16*)(ws + WS_X2), mod, 5, S, b0};
#ifndef NO_GR
            for (int rep_ = 0; rep_ < PROBE_P9; ++rep_)
            pg8::gemm_phase<EpiRes<true>, pg8::StaticOrder, PG8_ALIGN, PG8_SP2>(lds, g, So, E, wave);
#endif
        }
        GSYNC();
        { FETCH(); rows_final_norm((const bf16*)(ws + WS_X2), OUTC(), ap->g_final, gw, NGW, lane); }
    }
}

extern "C" void kernel_launch(void* const* d_in, const int* in_sizes, int n_in, void* d_out, int out_size, void* d_ws, size_t ws_size, hipStream_t stream) {
    static int grid = 0;
    if (grid == 0) {
        if (n_in != 20 || ws_size < WS_END) { fprintf(stderr, "kernel_launch: unexpected n_in %d / ws_size %zu (need %zu)\n", n_in, ws_size, (size_t)WS_END); grid = -1; return; }
        int dev = 0, cus = 0, per_cu = 0;
        hipGetDevice(&dev); hipDeviceGetAttribute(&cus, hipDeviceAttributeMultiprocessorCount, dev);
        if (hipFuncSetAttribute((const void*)fwd_megakernel, hipFuncAttributeMaxDynamicSharedMemorySize, LDS_BYTES) != hipSuccess) { fprintf(stderr, "kernel_launch: hipFuncSetAttribute failed\n"); grid = -1; return; }
        if (hipOccupancyMaxActiveBlocksPerMultiprocessor(&per_cu, (const void*)fwd_megakernel, NWAVES * 64, LDS_BYTES) != hipSuccess || per_cu < 1) { fprintf(stderr, "kernel_launch: occupancy query says %d\n", per_cu); per_cu = 1; }
        (void)hipGetLastError();
        grid = cus * 1;
        fprintf(stderr, "kernel_launch: grid %d (cus %d, per_cu %d)\n", grid, cus, per_cu);
    }
    if (grid < 0) return;
    Args a{};
    a.x_prompt = (const float*)d_in[0]; a.x_sample = (const float*)d_in[1]; a.c_prompt = (const float*)d_in[2]; a.c_sample = (const float*)d_in[3];
    a.w_ada = (const float*)d_in[4]; a.b_ada = (const float*)d_in[5]; a.g_mix = (const float*)d_in[6]; a.w_in = (const float*)d_in[7];
    a.lq1 = (const float*)d_in[8]; a.lk1 = (const float*)d_in[9]; a.lq2 = (const float*)d_in[10]; a.lk2 = (const float*)d_in[11]; a.g_subln = (const float*)d_in[12];
    a.w_a = (const float*)d_in[13]; a.w_b = (const float*)d_in[14]; a.w_out = (const float*)d_in[15]; a.g_ffn = (const float*)d_in[16]; a.w_gu = (const float*)d_in[17];
    a.w_down = (const float*)d_in[18]; a.g_final = (const float*)d_in[19];
    a.out = (float*)d_out; a.ws = (unsigned char*)d_ws;
    if (hipMemsetAsync(d_ws, 0, 16384, stream) != hipSuccess) { fprintf(stderr, "kernel_launch: memset failed\n"); return; }
    void* args[] = {&a};
    hipError_t e = hipLaunchCooperativeKernel((const void*)fwd_megakernel, dim3(grid), dim3(NWAVES * 64), args, LDS_BYTES, stream);
    if (e != hipSuccess) fprintf(stderr, "kernel_launch: cooperative launch failed: %s (grid %d)\n", hipGetErrorString(e), grid);
}
```

```cpp
#include <hip/hip_runtime.h>
#include <hip/hip_bf16.h>
#include <hip/hip_cooperative_groups.h>
#include <cstdio>
#include <cstdint>
namespace cg = cooperative_groups;
namespace pg8 {
#define PG8_LAS __attribute__((address_space(3)))
typedef unsigned short bf16_t;
typedef short bf16x8 __attribute__((ext_vector_type(8)));
typedef float f32x4 __attribute__((ext_vector_type(4)));
typedef unsigned u32x4 __attribute__((ext_vector_type(4)));
constexpr int BM = 256, BK = 64, HALF = 128, HTB = HALF * BK * 2  , STAGE_BYTES = 8 * HTB, NXCD = 8, WGM = 8;

__host__ __device__ __forceinline__ int lds_byte(int r, int c) { const int st = (r >> 4) * 2 + (c >> 5), rr = r & 15, cc = c & 31, ob = rr * 64 + cc * 2; return st * 1024 + (ob ^ (((ob >> 9) & 1) << 5)); }
__host__ __device__ __forceinline__ void stage_rc(int b, int& R, int& C) { const int st = b / 1024, sb = b % 1024, swz = sb ^ (((sb >> 9) & 1) << 5); R = (st >> 1) * 16 + swz / 64; C = (st & 1) * 32 + (swz % 64) / 2; }
__host__ __device__ __forceinline__ int perm32(int rho) { const int n = rho >> 4, i = rho & 15; return 8 * (i >> 2) + 4 * n + (i & 3); }

struct Unit { int pm, pn; };
struct Gemm { const bf16_t* A; const bf16_t* Bt; int M, N, K; };

struct StaticOrder {
    int nM, nN, nwg, G, c;
    __host__ __device__ void init(int M, int N, int G_, int c_) { nM = M / BM; nN = N / BM; nwg = nM * nN; G = G_; c = c_; }
    __host__ __device__ bool next(int i, Unit& u) const {
        const long L = (long)i * G + c; if (L >= nwg) return false;
        int wgid = (int)L; { const int q = nwg / NXCD, r = nwg % NXCD, xcd = wgid % NXCD, off = wgid / NXCD; wgid = (xcd < r ? xcd * (q + 1) : r * (q + 1) + (xcd - r) * q) + off; }
        const int nig = WGM * nN, gid = wgid / nig, fm = gid * WGM, gsz = (nM - fm) < WGM ? (nM - fm) : WGM;
        u.pm = fm + ((wgid % nig) % gsz); u.pn = (wgid % nig) / gsz; return true;
    }
    __device__ __forceinline__ void a_ready(const Unit&) const {}
    __device__ __forceinline__ void done(const Unit&) const {}
};

__device__ __forceinline__ unsigned cvt_pk_bf16(float lo, float hi) { unsigned r; asm volatile("v_cvt_pk_bf16_f32 %0, %1, %2" : "=v"(r) : "v"(lo), "v"(hi)); return r; }
typedef float f32x2 __attribute__((ext_vector_type(2)));
template <class Epi, class Sched, bool ALIGN_EPI = false, bool SP2 = false>
__device__ __forceinline__ void gemm_phase(PG8_LAS unsigned char* lds, const Gemm g, const Sched& S, const Epi& E, const int wave_) {
    int tid_ = wave_ * 64 + (int)__builtin_amdgcn_mbcnt_hi(~0u, __builtin_amdgcn_mbcnt_lo(~0u, 0u)); asm volatile("" : "+v"(tid_));
    const int tid = tid_, wid = __builtin_amdgcn_readfirstlane(tid >> 6), lane = tid & 63, wr = wid >> 2, wc = wid & 3, fr = lane & 15, fq = lane >> 4;
    const int K = g.K, nt = K / BK;
    unsigned voffA[2], voffB[2];
#pragma unroll
    for (int i = 0; i < 2; ++i) { int R, C; stage_rc(tid * 16 + i * 8192, R, C); const int Rb = Epi::PERM ? ((R & ~31) + perm32(R & 31)) : R;
        voffA[i] = (unsigned)(R * K + C) * 2u; voffB[i] = (unsigned)(Rb * K + C) * 2u; }
    const size_t kstep = (size_t)(BK * 2);
    const size_t hstep = (size_t)HALF * K * 2;
    const size_t tstep = 2 * hstep;
    const unsigned ldsw = (unsigned)wid * 1024u;
    const int aoff = lds_byte(wr * 64 + fr, fq * 8), boff = lds_byte(wc * 32 + fr, fq * 8);
#define PG8_SA(b, h) (((b) * 2 + (h)) * HTB)
#define PG8_SB(b, h) ((4 + (b) * 2 + (h)) * HTB)
#define PG8_STAGE(bufoff, gbase, voff) do { _Pragma("unroll") for (int _i = 0; _i < 2; ++_i) \
        __builtin_amdgcn_global_load_lds((const unsigned*)((const char*)(gbase) + (voff)[_i]), (PG8_LAS unsigned*)(lds + (bufoff) + ldsw + _i * 8192), 16, 0, 0); } while (0)
#define PG8_LDA(dst, b, h) do { _Pragma("unroll") for (int m = 0; m < 4; ++m) _Pragma("unroll") for (int k = 0; k < 2; ++k) dst[m][k] = *(const PG8_LAS bf16x8*)(lds + PG8_SA(b, h) + aoff + m * 2048 + k * 1024); } while (0)
#define PG8_LDB(dst, b, h) do { _Pragma("unroll") for (int n = 0; n < 2; ++n) _Pragma("unroll") for (int k = 0; k < 2; ++k) dst[n][k] = *(const PG8_LAS bf16x8*)(lds + PG8_SB(b, h) + boff + n * 2048 + k * 1024); } while (0)
#define PG8_MMA(ai, bj, At, Bt) do { __builtin_amdgcn_s_setprio(1); _Pragma("unroll") for (int m = 0; m < 4; ++m) _Pragma("unroll") for (int n = 0; n < 2; ++n) _Pragma("unroll") for (int k = 0; k < 2; ++k) \
        acc[ai][bj][m][n] = __builtin_amdgcn_mfma_f32_16x16x32_bf16(Bt[n][k], At[m][k], acc[ai][bj][m][n], 0, 0, 0); __builtin_amdgcn_s_setprio(0); } while (0)
#define PG8_WAIT_V(n) asm volatile("s_waitcnt vmcnt(" #n ")" ::: "memory")
#define PG8_WAIT_L(n) asm volatile("s_waitcnt lgkmcnt(" #n ")" ::: "memory")
#define PG8_BAR __builtin_amdgcn_s_barrier()
#define PG8_SCHED __builtin_amdgcn_sched_barrier(0)
    Unit cur, nxt; int ui = 0;
    if (!S.next(0, cur)) return;
    f32x4 acc[2][2][4][2];
#pragma unroll
    for (int a = 0; a < 2; ++a)
#pragma unroll
        for (int b = 0; b < 2; ++b)
#pragma unroll
            for (int m = 0; m < 4; ++m)
#pragma unroll
                for (int n = 0; n < 2; ++n) acc[a][b][m][n] = (f32x4){0.f, 0.f, 0.f, 0.f};
    bf16x8 At[4][2], B0[2][2], B1[2][2];
    const char* cA = (const char*)g.A + (size_t)cur.pm * tstep; const char* cB = (const char*)g.Bt + (size_t)cur.pn * tstep;
    S.a_ready(cur);
    if constexpr (SP2) {
        PG8_STAGE(PG8_SB(0, 0), cB, voffB); PG8_STAGE(PG8_SB(0, 1), cB + hstep, voffB); PG8_STAGE(PG8_SA(0, 0), cA, voffA); PG8_STAGE(PG8_SA(0, 1), cA + hstep, voffA);
        if (wr == 1) PG8_BAR;
        PG8_WAIT_V(2); PG8_BAR;
        PG8_STAGE(PG8_SB(1, 0), cB + kstep, voffB); PG8_STAGE(PG8_SA(1, 0), cA + kstep, voffA); PG8_STAGE(PG8_SB(1, 1), cB + hstep + kstep, voffB);
        PG8_WAIT_V(6); PG8_BAR;
    } else {
        PG8_STAGE(PG8_SB(0, 0), cB, voffB); PG8_STAGE(PG8_SA(0, 0), cA, voffA); PG8_STAGE(PG8_SB(0, 1), cB + hstep, voffB); PG8_STAGE(PG8_SA(0, 1), cA + hstep, voffA);
        if (wr == 1) PG8_BAR;
        PG8_WAIT_V(4); PG8_BAR;
        PG8_STAGE(PG8_SB(1, 0), cB + kstep, voffB); PG8_STAGE(PG8_SA(1, 0), cA + kstep, voffA); PG8_STAGE(PG8_SB(1, 1), cB + hstep + kstep, voffB);
        PG8_WAIT_V(6); PG8_BAR;
    }
    for (;;) {
        const bool has_next = S.next(ui + 1, nxt);
        const char* nA = has_next ? (const char*)g.A + (size_t)nxt.pm * tstep : cA; const char* nB = has_next ? (const char*)g.Bt + (size_t)nxt.pn * tstep : cB;
        for (int t = 0; t < nt; t += 2) {
            const bool last = (t == nt - 2);
            const char* a1 = cA + (size_t)(t + 1) * kstep;
            const char* a2 = last ? nA : cA + (size_t)(t + 2) * kstep; const char* b2 = last ? nB : cB + (size_t)(t + 2) * kstep;
            const char* a3 = a2 + kstep; const char* b3 = b2 + kstep;
            if (last && has_next) S.a_ready(nxt);
            if constexpr (SP2) {
            PG8_LDB(B0, 0, 0); PG8_LDB(B1, 0, 1); PG8_SCHED; PG8_LDA(At, 0, 0); PG8_STAGE(PG8_SA(1, 1), a1 + hstep, voffA);
            PG8_WAIT_V(8); PG8_WAIT_L(0); PG8_BAR; PG8_MMA(0, 0, At, B0); PG8_MMA(0, 1, At, B1); PG8_BAR; PG8_SCHED;
            PG8_LDA(At, 0, 1); PG8_STAGE(PG8_SB(0, 0), b2, voffB); PG8_STAGE(PG8_SB(0, 1), b2 + hstep, voffB); PG8_STAGE(PG8_SA(0, 0), a2, voffA);
            PG8_WAIT_V(8); PG8_WAIT_L(0); PG8_BAR; PG8_MMA(1, 0, At, B0); PG8_MMA(1, 1, At, B1); PG8_BAR; PG8_SCHED;
            PG8_LDB(B0, 1, 0); PG8_LDB(B1, 1, 1); PG8_SCHED; PG8_LDA(At, 1, 0); PG8_STAGE(PG8_SA(0, 1), a2 + hstep, voffA);
            PG8_WAIT_V(8); PG8_WAIT_L(0); PG8_BAR; PG8_MMA(0, 0, At, B0); PG8_MMA(0, 1, At, B1); PG8_BAR; PG8_SCHED;
            PG8_LDA(At, 1, 1); PG8_STAGE(PG8_SB(1, 0), b3, voffB); PG8_STAGE(PG8_SB(1, 1), b3 + hstep, voffB); PG8_STAGE(PG8_SA(1, 0), a3, voffA);
            PG8_WAIT_V(8); PG8_WAIT_L(0); PG8_BAR; PG8_MMA(1, 0, At, B0); PG8_MMA(1, 1, At, B1); PG8_BAR; PG8_SCHED;
            } else {
            PG8_LDB(B0, 0, 0); PG8_SCHED; PG8_LDA(At, 0, 0); PG8_STAGE(PG8_SA(1, 1), a1 + hstep, voffA);
            PG8_WAIT_L(8); PG8_BAR; PG8_WAIT_L(0); PG8_MMA(0, 0, At, B0); PG8_BAR; PG8_SCHED;
            PG8_LDB(B1, 0, 1); PG8_STAGE(PG8_SB(0, 0), b2, voffB);
            PG8_BAR; PG8_WAIT_L(0); PG8_MMA(0, 1, At, B1); PG8_BAR;
            PG8_LDA(At, 0, 1); PG8_STAGE(PG8_SA(0, 0), a2, voffA);
            PG8_BAR; PG8_WAIT_L(0); PG8_MMA(1, 0, At, B0); PG8_BAR; PG8_SCHED;
            PG8_STAGE(PG8_SB(0, 1), b2 + hstep, voffB);
            PG8_WAIT_V(6); PG8_BAR; PG8_MMA(1, 1, At, B1); PG8_BAR;
            PG8_LDB(B0, 1, 0); PG8_SCHED; PG8_LDA(At, 1, 0); PG8_STAGE(PG8_SA(0, 1), a2 + hstep, voffA);
            PG8_WAIT_L(8); PG8_BAR; PG8_WAIT_L(0); PG8_MMA(0, 0, At, B0); PG8_BAR; PG8_SCHED;
            PG8_LDB(B1, 1, 1); PG8_STAGE(PG8_SB(1, 0), b3, voffB);
            PG8_BAR; PG8_WAIT_L(0); PG8_MMA(0, 1, At, B1); PG8_BAR;
            PG8_LDA(At, 1, 1); PG8_STAGE(PG8_SA(1, 0), a3, voffA);
            PG8_BAR; PG8_WAIT_L(0); PG8_MMA(1, 0, At, B0); PG8_BAR; PG8_SCHED;
            PG8_STAGE(PG8_SB(1, 1), b3 + hstep, voffB);
            PG8_WAIT_V(6); PG8_BAR; PG8_MMA(1, 1, At, B1); PG8_BAR;
            }
        }
        if constexpr (ALIGN_EPI) { if (wr == 0) PG8_BAR; }
        if constexpr (!Epi::AFTER_DRAIN) { E(acc, cur, wr, wc, fr, fq); S.done(cur); }
        if (!has_next) break;
#pragma unroll
        for (int a = 0; a < 2; ++a)
#pragma unroll
            for (int b = 0; b < 2; ++b)
#pragma unroll
                for (int m = 0; m < 4; ++m)
#pragma unroll
                    for (int n = 0; n < 2; ++n) acc[a][b][m][n] = (f32x4){0.f, 0.f, 0.f, 0.f};
        cur = nxt; cA = nA; cB = nB; ++ui;
        if constexpr (ALIGN_EPI) { if (wr == 1) PG8_BAR; }
    }
    PG8_WAIT_V(0);
    if constexpr (!ALIGN_EPI) { if (wr == 0) PG8_BAR; }
    PG8_BAR;
    if constexpr (Epi::AFTER_DRAIN) { E.fused(acc, cur, wr, wc, fr, fq, lds, wid, lane); S.done(cur); }
#undef PG8_SA
#undef PG8_SB
#undef PG8_STAGE
#undef PG8_LDA
#undef PG8_LDB
#undef PG8_MMA
#undef PG8_WAIT_V
#undef PG8_WAIT_L
#undef PG8_BAR
#undef PG8_SCHED
}
}
#ifndef PG8_SP2
#define PG8_SP2 true
#endif
#ifndef PG8_ALIGN
#define PG8_ALIGN true
#endif
#include <hip/hip_bf16.h>
#include <cmath>
namespace attn_body {
using bf16=__hip_bfloat16;
using bf16x8=__attribute__((ext_vector_type(8)))short;
using s16x4=__attribute__((ext_vector_type(4)))short;
using f32x16=__attribute__((ext_vector_type(16)))float;
using u32x4=__attribute__((ext_vector_type(4)))unsigned;
constexpr int D=64,DM=1024;
constexpr int NW=8,QBLK=32,QB=QBLK*NW,KVBLK=64;
__device__ __forceinline__ int crow(int r,int hi){return (r&3)+8*(r>>2)+4*hi;}
#define SBAR() __builtin_amdgcn_sched_barrier(0)
constexpr int NSLOT=3, SLOTB=8192;
constexpr int LDS_K=0, LDS_V=NSLOT*SLOTB, LDS_WS=3*NSLOT*SLOTB, LDS_OST=LDS_WS+NW*64*4, LDS_BYTES=LDS_OST+NW*8192;
constexpr float C2=0.125f*1.4426950408889634f;
__device__ __forceinline__ void glds16(const void*gsrc,unsigned lds_dst){unsigned keep;
  asm volatile("s_mov_b32 %0, m0\n\ts_mov_b32 m0, %2\n\ts_nop 0\n\tglobal_load_lds_dwordx4 %1, off\n\ts_mov_b32 m0, %0":"=&s"(keep):"v"(gsrc),"s"(lds_dst):"memory");}
__device__ __forceinline__ float max3f(float a,float b,float c){float r;asm("v_max3_f32 %0, %1, %2, %3":"=v"(r):"v"(a),"v"(b),"v"(c));return r;}
__device__ __forceinline__ float max2f(float a,float b){float r;asm("v_max_f32_e32 %0, %1, %2":"=v"(r):"v"(a),"v"(b));return r;}
__device__ __forceinline__ float fadd_s(float a,float b){float r;asm("v_add_f32_e32 %0, %1, %2":"=v"(r):"v"(a),"v"(b));return r;}
__device__ __forceinline__ float fsub_s(float a,float b){float r;asm("v_sub_f32_e32 %0, %1, %2":"=v"(r):"v"(a),"v"(b));return r;}
typedef float f32x2_t __attribute__((ext_vector_type(2))); typedef __bf16 bf16x2_t __attribute__((ext_vector_type(2)));
__device__ __forceinline__ unsigned cvtpk_s(float lo,float hi){f32x2_t v={lo,hi};bf16x2_t b=__builtin_convertvector(v,bf16x2_t);return __builtin_bit_cast(unsigned,b);}
#define WAIT_BAR(N) asm volatile("s_waitcnt vmcnt(" #N ") lgkmcnt(0)\n\ts_barrier":::"memory")

__device__ __forceinline__ void qkt(f32x16&p0,f32x16&p1,const char*Kslot,const bf16x8*qr,int r32,int hi){ const f32x16 negm=f32x16{};
  const char*kb=Kslot+hi*1024+r32*16;
  #pragma unroll
  for(int d0=0;d0<4;++d0){
    const bf16x8 b0=*reinterpret_cast<const bf16x8*>(kb+d0*2048);
    const bf16x8 b1=*reinterpret_cast<const bf16x8*>(kb+d0*2048+512);
    if(d0==0){p0=__builtin_amdgcn_mfma_f32_32x32x16_bf16(b0,qr[0],negm,0,0,0);p1=__builtin_amdgcn_mfma_f32_32x32x16_bf16(b1,qr[0],negm,0,0,0);}
    else{p0=__builtin_amdgcn_mfma_f32_32x32x16_bf16(b0,qr[d0],p0,0,0,0);p1=__builtin_amdgcn_mfma_f32_32x32x16_bf16(b1,qr[d0],p1,0,0,0);}}
}
typedef __attribute__((address_space(3))) const char* lds_cptr;
typedef short v4i16_t __attribute__((ext_vector_type(4)));
__device__ __forceinline__ void kload8(bf16x8*kf,lds_cptr kp){
  kf[0]=*(const __attribute__((address_space(3))) bf16x8*)(kp);      kf[1]=*(const __attribute__((address_space(3))) bf16x8*)(kp+512);
  kf[2]=*(const __attribute__((address_space(3))) bf16x8*)(kp+2048); kf[3]=*(const __attribute__((address_space(3))) bf16x8*)(kp+2560);
  kf[4]=*(const __attribute__((address_space(3))) bf16x8*)(kp+4096); kf[5]=*(const __attribute__((address_space(3))) bf16x8*)(kp+4608);
  kf[6]=*(const __attribute__((address_space(3))) bf16x8*)(kp+6144); kf[7]=*(const __attribute__((address_space(3))) bf16x8*)(kp+6656);
}
__device__ __forceinline__ void kload2(bf16x8*kf,lds_cptr kp,int j){ kf[2*j]=*(const __attribute__((address_space(3))) bf16x8*)(kp+j*2048); kf[2*j+1]=*(const __attribute__((address_space(3))) bf16x8*)(kp+j*2048+512); }
__device__ __forceinline__ s16x4 vtr(lds_cptr p){ return __builtin_bit_cast(s16x4,__builtin_amdgcn_ds_read_tr16_b64_v4i16((__attribute__((address_space(3))) v4i16_t*)p)); }
__device__ __forceinline__ float rowmax(const f32x16&p0,const f32x16&p1){
  float a=max3f(p0[0],p0[1],p1[0]),b=max3f(p0[2],p0[3],p1[1]);a=max3f(a,p1[2],p1[3]);
  #pragma unroll
  for(int r=4;r<16;r+=4){a=max3f(a,p0[r],p0[r+1]);b=max3f(b,p0[r+2],p0[r+3]);a=max3f(a,p1[r],p1[r+1]);b=max3f(b,p1[r+2],p1[r+3]);}
  const float m=max2f(a,b);
  auto rr=__builtin_amdgcn_permlane32_swap(__float_as_uint(m),__float_as_uint(m),false,false);
  return max2f(__uint_as_float(rr[0]),__uint_as_float(rr[1]));
}
__device__ __forceinline__ void pv(f32x16*o,int vb,bf16x8 pa0,bf16x8 pa1,bf16x8 pa2,bf16x8 pa3){
  #pragma unroll
  for(int d0=0;d0<4;++d0){s16x4 lo[4],hi[4];
    #pragma unroll
    for(int ks=0;ks<4;++ks){
      asm volatile("ds_read_b64_tr_b16 %0,%1 offset:%c2":"=&v"(lo[ks]):"v"(vb),"i"(d0*4096+ks*1024):"memory");
      asm volatile("ds_read_b64_tr_b16 %0,%1 offset:%c2":"=&v"(hi[ks]):"v"(vb),"i"(d0*4096+ks*1024+512):"memory");}
    asm volatile("s_waitcnt lgkmcnt(0)":::"memory");SBAR();
    #define PK(k) (bf16x8){lo[k][0],lo[k][1],lo[k][2],lo[k][3],hi[k][0],hi[k][1],hi[k][2],hi[k][3]}
    o[d0]=__builtin_amdgcn_mfma_f32_32x32x16_bf16(pa0,PK(0),o[d0],0,0,0);
    o[d0]=__builtin_amdgcn_mfma_f32_32x32x16_bf16(pa1,PK(1),o[d0],0,0,0);
    o[d0]=__builtin_amdgcn_mfma_f32_32x32x16_bf16(pa2,PK(2),o[d0],0,0,0);
    o[d0]=__builtin_amdgcn_mfma_f32_32x32x16_bf16(pa3,PK(3),o[d0],0,0,0);
    #undef PK
  }
}

#ifndef ATTN_STORE16
#define ATTN_STORE16(p,v) (*(u32x4*)(p)=(v))
#endif
template<int THRL,int MODE> __device__ __forceinline__ void attn_unit(const bf16*Qp,const bf16*__restrict__ Kh,const bf16*__restrict__ Vh,bf16*Op,const int q0,const int NT,char*shm,const float lam,const __attribute__((address_space(3))) float*gsub,const int wave_){
  int tid_=wave_*64+(int)__builtin_amdgcn_mbcnt_hi(~0u,__builtin_amdgcn_mbcnt_lo(~0u,0u)); asm volatile("":"+v"(tid_));
  const int tid=tid_,lane=tid&63,r32=lane&31,hi=lane>>5; const int wid=__builtin_amdgcn_readfirstlane(tid>>6);
  const bf16*Qw=Qp+(long)(q0+wid*QBLK)*DM;
  const unsigned lds0=(unsigned)(uintptr_t)shm;
  float*wsf=(float*)(shm+LDS_WS)+wid*64;
  const bf16*ksrc=Kh+(long)lane*DM+wid*8;
  const bf16*vsrc=Vh+(long)(16*(wid&3)+(lane>>2))*DM+(wid>>2)*32+(lane&3)*8;
  const unsigned kdst=lds0+LDS_K+wid*1024, vdst=lds0+LDS_V+wid*1024;
  #define DMA_K(t,slot) glds16(ksrc+(long)(t)*KVBLK*DM,(unsigned)__builtin_amdgcn_readfirstlane(kdst+(slot)))
  #define DMA_V(t,slot) do{ glds16(vsrc+(long)(t)*KVBLK*DM,(unsigned)__builtin_amdgcn_readfirstlane(vdst+2*(slot))); glds16(vsrc+(long)(t)*KVBLK*DM+64,(unsigned)__builtin_amdgcn_readfirstlane(vdst+2*(slot)+8192)); }while(0)
  const int vb0=(int)(lds0+LDS_V)+((lane>>4)&1)*32+(lane&3)*8+(4*hi+((lane&15)>>2))*64;
  const char*Kbase=shm+LDS_K; bf16x8 kf[8];
  const lds_cptr shm3=(lds_cptr)shm; const lds_cptr kp0=shm3+LDS_K+hi*1024+r32*16; const lds_cptr vp0=shm3+LDS_V+((lane>>4)&1)*32+(lane&3)*8+(4*hi+((lane&15)>>2))*64;
  DMA_K(0,0);DMA_V(0,0);DMA_K(1,SLOTB);
  bf16x8 qr[4];
  #pragma unroll
  for(int d0=0;d0<4;++d0)qr[d0]=*reinterpret_cast<const bf16x8*>(&Qw[(long)r32*DM+d0*16+hi*8]);
  float mhat=0.f,l_reg=0.f;f32x16 o[4];o[0]=f32x16{};o[1]=f32x16{};o[2]=f32x16{};o[3]=f32x16{};
  #define CMASK(P0,P1,t) do{}while(0)
  bool resc=false;
  #define START(P0,P1) do{ const float rm=rowmax(P0,P1); resc=false; \
    { const float dl=rm; mhat=fadd_s(mhat,dl); \
      _Pragma("unroll") for(int r=0;r<16;++r){P0[r]=fsub_s(P0[r],dl);P1[r]=fsub_s(P1[r],dl);} } \
    _Pragma("unroll") for(int r=0;r<16;++r)P0[r]=__builtin_amdgcn_exp2f(P0[r]); }while(0)
  #define RESC() do{ if(resc){ asm volatile("s_waitcnt lgkmcnt(0)":::"memory"); \
      _Pragma("unroll") for(int d_=0;d_<4;++d_) _Pragma("unroll") for(int r=0;r<16;++r)o[d_][r]*=wsf[crow(r,hi)]; } }while(0)
  f32x16 pA0,pA1,pB0,pB1;
  int sl_prev=0,sl_cur=0,sl_next=SLOTB;
  #define ROT() do{sl_prev=sl_cur;sl_cur=sl_next;sl_next=(sl_next==(NSLOT-1)*SLOTB)?0:sl_next+SLOTB;}while(0)
  DMA_K(2,2*SLOTB);
  WAIT_BAR(4);
  qkt(pA0,pA1,Kbase,qr,r32,hi);asm volatile("s_nop 15\n\ts_nop 7":"+v"(pA0),"+v"(pA1));CMASK(pA0,pA1,0);
  START(pA0,pA1);
  _Pragma("unroll") for(int r=0;r<16;++r)pA1[r]=__builtin_amdgcn_exp2f(pA1[r]);
  WAIT_BAR(0);
  DMA_K(3,0);DMA_V(1,SLOTB);
  ROT();
  kload8(kf,kp0+sl_cur);
  WAIT_BAR(3);
  s16x4 vlo[8],vhi[8]; u32x4 pw0,pw1,pw2,pw3;
  #define PKW(P,B) cvtpk_s(P[B],P[B+1])
  #define PAF(k) __builtin_bit_cast(bf16x8,pw##k)
  #define VFR(i) (bf16x8){vlo[i][0],vlo[i][1],vlo[i][2],vlo[i][3],vhi[i][0],vhi[i][1],vhi[i][2],vhi[i][3]}
  #define PIN(x) asm volatile("":"+v"(x))
  #define MX3(a,b,c) __builtin_fmaxf(__builtin_fmaxf((a),(b)),(c))
  #define GAPA(MF,A0,A1,A2,A3,W0,W1,PW) do{ MF; sacc+=A0; sacc+=A1; sacc+=A2; sacc+=A3; PIN(sacc); W0; W1; PIN(PW); SBAR(); }while(0)
  #define EX(v) __builtin_amdgcn_exp2f(v)
  #define GAPB(MF,X,B) do{ MF; X[B]=EX(X[B]-mhat); X[B+1]=EX(X[B+1]-mhat); PIN(X); SBAR(); }while(0)
  #define VRD2(i) do{ vlo[i]=vtr(vp_+(8192+((i)>>2)*4096+((i)&3)*1024)); vhi[i]=vtr(vp_+(8192+((i)>>2)*4096+((i)&3)*1024+512)); SBAR(); }while(0)
  #define VRD(i) do{ vlo[i]=vtr(vp_+(((i)>>2)*4096+((i)&3)*1024)); vhi[i]=vtr(vp_+(((i)>>2)*4096+((i)&3)*1024+512)); }while(0)
  #define KRD(G,j) do{ if(G){ kload2(kf,kp0+sl_next,j); SBAR(); } }while(0)
  #define STEP(C0,C1,P0,P1,t,GK,GV,GL) do{ SBAR(); \
    const lds_cptr vp_=vp0+2*sl_prev; \
    VRD(0); SBAR(); float sacc=(P0[0]+P0[1]); \
    GAPA(C0=__builtin_amdgcn_mfma_f32_32x32x16_bf16(kf[0],qr[0],f32x16{},0,0,0), P0[2],P0[3],P0[4],P0[5],     pw0[0]=PKW(P0,0), pw0[1]=PKW(P0,2), pw0); \
    VRD(4); SBAR(); GAPA(C1=__builtin_amdgcn_mfma_f32_32x32x16_bf16(kf[1],qr[0],f32x16{},0,0,0), P0[6],P0[7],P0[8],P0[9],     pw0[2]=PKW(P0,4), pw0[3]=PKW(P0,6), pw0); \
    VRD(1); SBAR(); GAPA(C0=__builtin_amdgcn_mfma_f32_32x32x16_bf16(kf[2],qr[1],C0,0,0,0),   P0[10],P0[11],P0[12],P0[13], pw1[0]=PKW(P0,8), pw1[1]=PKW(P0,10), pw1); \
    VRD(5); SBAR(); GAPA(C1=__builtin_amdgcn_mfma_f32_32x32x16_bf16(kf[3],qr[1],C1,0,0,0),   P0[14],P0[15],P1[0],P1[1],   pw1[2]=PKW(P0,12),pw1[3]=PKW(P0,14), pw1); \
    VRD(2); SBAR(); GAPA(C0=__builtin_amdgcn_mfma_f32_32x32x16_bf16(kf[4],qr[2],C0,0,0,0),   P1[2],P1[3],P1[4],P1[5],     pw2[0]=PKW(P1,0), pw2[1]=PKW(P1,2), pw2); \
    VRD(6); SBAR(); GAPA(C1=__builtin_amdgcn_mfma_f32_32x32x16_bf16(kf[5],qr[2],C1,0,0,0),   P1[6],P1[7],P1[8],P1[9],     pw2[2]=PKW(P1,4), pw2[3]=PKW(P1,6), pw2); \
    VRD(3); SBAR(); GAPA(C0=__builtin_amdgcn_mfma_f32_32x32x16_bf16(kf[6],qr[3],C0,0,0,0),   P1[10],P1[11],P1[12],P1[13], pw3[0]=PKW(P1,8), pw3[1]=PKW(P1,10), pw3); \
    VRD(7); SBAR(); GAPA(C1=__builtin_amdgcn_mfma_f32_32x32x16_bf16(kf[7],qr[3],C1,0,0,0),   P1[14],P1[15],0.f,0.f,       pw3[2]=PKW(P1,12),pw3[3]=PKW(P1,14), pw3); \
    l_reg+=sacc; \
    if(GK){DMA_K((t)+3,sl_cur);} if(GV){DMA_V((t)+1,sl_next);} \
    CMASK(C0,C1,t); \
    { float a=MX3(C0[0],C0[1],C1[0]),b=MX3(C0[2],C0[3],C1[1]); a=MX3(a,C1[2],C1[3]); \
      _Pragma("unroll") for(int r=4;r<16;r+=4){a=MX3(a,C0[r],C0[r+1]);b=MX3(b,C0[r+2],C0[r+3]);a=MX3(a,C1[r],C1[r+1]);b=MX3(b,C1[r+2],C1[r+3]);} \
      float rm=__builtin_fmaxf(a,b); { auto rr=__builtin_amdgcn_permlane32_swap(__float_as_uint(rm),__float_as_uint(rm),false,false); rm=__builtin_fmaxf(__uint_as_float(rr[0]),__uint_as_float(rr[1])); } \
      resc=false; \
      rm-=mhat; \
      if(__builtin_expect(__any(rm>(float)THRL),0)){ const float dl=__builtin_fmaxf(rm,0.f); mhat+=dl; \
        const float f=__builtin_amdgcn_exp2f(-dl); l_reg*=f; if(hi==0)wsf[r32]=f; resc=true; } } \
    SBAR(); \
    GAPB(o[0]=__builtin_amdgcn_mfma_f32_32x32x16_bf16(PAF(0),VFR(0),o[0],0,0,0), C0,0);  VRD2(0); \
    GAPB(o[1]=__builtin_amdgcn_mfma_f32_32x32x16_bf16(PAF(0),VFR(4),o[1],0,0,0), C0,2);  VRD2(4); \
    KRD(GL,0); GAPB(o[0]=__builtin_amdgcn_mfma_f32_32x32x16_bf16(PAF(1),VFR(1),o[0],0,0,0), C0,4);  VRD2(1); \
    KRD(GL,1); GAPB(o[1]=__builtin_amdgcn_mfma_f32_32x32x16_bf16(PAF(1),VFR(5),o[1],0,0,0), C0,6);  VRD2(5); \
    KRD(GL,2); GAPB(o[0]=__builtin_amdgcn_mfma_f32_32x32x16_bf16(PAF(2),VFR(2),o[0],0,0,0), C0,8);  VRD2(2); \
    KRD(GL,3); GAPB(o[1]=__builtin_amdgcn_mfma_f32_32x32x16_bf16(PAF(2),VFR(6),o[1],0,0,0), C0,10); VRD2(6); \
    GAPB(o[0]=__builtin_amdgcn_mfma_f32_32x32x16_bf16(PAF(3),VFR(3),o[0],0,0,0), C0,12); VRD2(3); \
    GAPB(o[1]=__builtin_amdgcn_mfma_f32_32x32x16_bf16(PAF(3),VFR(7),o[1],0,0,0), C0,14); VRD2(7); \
    GAPB(o[2]=__builtin_amdgcn_mfma_f32_32x32x16_bf16(PAF(0),VFR(0),o[2],0,0,0), C1,0); \
    GAPB(o[3]=__builtin_amdgcn_mfma_f32_32x32x16_bf16(PAF(0),VFR(4),o[3],0,0,0), C1,2); \
    GAPB(o[2]=__builtin_amdgcn_mfma_f32_32x32x16_bf16(PAF(1),VFR(1),o[2],0,0,0), C1,4); \
    GAPB(o[3]=__builtin_amdgcn_mfma_f32_32x32x16_bf16(PAF(1),VFR(5),o[3],0,0,0), C1,6); \
    GAPB(o[2]=__builtin_amdgcn_mfma_f32_32x32x16_bf16(PAF(2),VFR(2),o[2],0,0,0), C1,8); \
    GAPB(o[3]=__builtin_amdgcn_mfma_f32_32x32x16_bf16(PAF(2),VFR(6),o[3],0,0,0), C1,10); \
    GAPB(o[2]=__builtin_amdgcn_mfma_f32_32x32x16_bf16(PAF(3),VFR(3),o[2],0,0,0), C1,12); \
    GAPB(o[3]=__builtin_amdgcn_mfma_f32_32x32x16_bf16(PAF(3),VFR(7),o[3],0,0,0), C1,14); \
    }while(0)
  int t=1;
  #undef CMASK
  #define CMASK(P0,P1,t) do{}while(0)
  for(;t+5<NT;t+=2){
    STEP(pB0,pB1,pA0,pA1,t,true,true,true);     WAIT_BAR(3); RESC(); ROT();
    STEP(pA0,pA1,pB0,pB1,t+1,true,true,true);   WAIT_BAR(3); RESC(); ROT();
  }
  #undef CMASK
  #define CMASK(P0,P1,t) do{}while(0)
  #define ENDW(tt) do{ if((tt)+3<NT){WAIT_BAR(3);} else if((tt)+2<NT){WAIT_BAR(2);} else {WAIT_BAR(0);} }while(0)
  for(;t+1<NT;t+=2){
    STEP(pB0,pB1,pA0,pA1,t,(t+3<NT),(t+1<NT),(t+1<NT));       ENDW(t);   RESC(); ROT();
    STEP(pA0,pA1,pB0,pB1,t+1,(t+4<NT),(t+2<NT),(t+2<NT));     ENDW(t+1); RESC(); ROT();
  }
  STEP(pB0,pB1,pA0,pA1,NT-1,false,false,false); RESC();
  { float sacc=pB0[0]+pB0[1]; _Pragma("unroll") for(int r=2;r<16;++r)sacc+=pB0[r]; _Pragma("unroll") for(int r=0;r<16;++r)sacc+=pB1[r]; l_reg+=sacc;
    pw0=(u32x4){PKW(pB0,0),PKW(pB0,2),PKW(pB0,4),PKW(pB0,6)};pw1=(u32x4){PKW(pB0,8),PKW(pB0,10),PKW(pB0,12),PKW(pB0,14)};pw2=(u32x4){PKW(pB1,0),PKW(pB1,2),PKW(pB1,4),PKW(pB1,6)};pw3=(u32x4){PKW(pB1,8),PKW(pB1,10),PKW(pB1,12),PKW(pB1,14)};
    SBAR(); pv(o,vb0+2*sl_cur,PAF(0),PAF(1),PAF(2),PAF(3)); }
  #undef PKW
  #undef PAF
  #undef VFR
  #undef PIN
  #undef MX3
  #undef GAPA
  #undef GAPB
  #undef EX
  #undef VRD
  #undef VRD2
  #undef KRD
  #undef STEP
  #undef ENDW
  {auto rr=__builtin_amdgcn_permlane32_swap(__float_as_uint(l_reg),__float_as_uint(l_reg),false,false);l_reg=__uint_as_float(rr[0])+__uint_as_float(rr[1]);}
  if(hi==0)wsf[32+r32]=l_reg;asm volatile("s_waitcnt lgkmcnt(0)":::"memory");
  float rli[16];
  #pragma unroll
  for(int r=0;r<16;++r)rli[r]=__builtin_amdgcn_rcpf(wsf[32+crow(r,hi)]);
  bf16*Ow=Op+(long)(q0+wid*QBLK)*DM;
  { bf16*stg=(bf16*)(shm+LDS_OST)+wid*4096;
    if constexpr(MODE==1){
      #pragma unroll
      for(int r=0;r<16;++r){const int orow=crow(r,hi);
        #pragma unroll
        for(int d0=0;d0<4;++d0)stg[orow*128+d0*32+r32]=__float2bfloat16(o[d0][r]*rli[r]);}
    } else {
      float ss[16];
      #pragma unroll
      for(int r=0;r<16;++r){const int orow=crow(r,hi); float s=0.f;
        #pragma unroll
        for(int d0=0;d0<4;++d0){const float dd=__bfloat162float(stg[orow*128+d0*32+r32])-lam*(o[d0][r]*rli[r]); o[d0][r]=dd; s+=dd*dd;}
        ss[r]=s;}
      #pragma unroll
      for(int r=0;r<16;++r){float s=ss[r]; s+=__shfl_xor(s,1); s+=__shfl_xor(s,2); s+=__shfl_xor(s,4); s+=__shfl_xor(s,8); s+=__shfl_xor(s,16); ss[r]=1.f/sqrtf(s*(1.f/128.f)+1e-6f);}
      float gg[4];
      #pragma unroll
      for(int d0=0;d0<4;++d0)gg[d0]=gsub[d0*32+r32];
      #pragma unroll
      for(int r=0;r<16;++r){const int orow=crow(r,hi);
        #pragma unroll
        for(int d0=0;d0<4;++d0)stg[orow*128+d0*32+r32]=__float2bfloat16(o[d0][r]*ss[r]*gg[d0]);}
      asm volatile("s_waitcnt lgkmcnt(0)":::"memory");
      #pragma unroll
      for(int i=0;i<8;++i){const int row=i*4+(lane>>4),ch=lane&15; const u32x4 v=*(const u32x4*)(stg+row*128+ch*8); ATTN_STORE16(Ow+(long)row*DM+ch*8,v);}
    } }
  asm volatile("s_waitcnt lgkmcnt(0)\n\ts_barrier":::"memory");
  #undef DMA_K
  #undef DMA_V
  #undef CMASK
  #undef START
  #undef RESC
  #undef ROT
}
constexpr int ATTN_LDS_BYTES=LDS_BYTES;
#undef SBAR
#undef WAIT_BAR
}

#define GAS __attribute__((address_space(1)))
#define LAS __attribute__((address_space(3)))
typedef unsigned short bf16;
typedef unsigned v4u __attribute__((ext_vector_type(4)));
typedef unsigned v2u __attribute__((ext_vector_type(2)));
typedef float f32x4 __attribute__((ext_vector_type(4)));
typedef float f32x16 __attribute__((ext_vector_type(16)));
typedef short bf16x8 __attribute__((ext_vector_type(8)));
typedef short s16x4 __attribute__((ext_vector_type(4)));
#define LDS_WAIT() asm volatile("s_waitcnt lgkmcnt(0)" ::: "memory")

constexpr int DMODEL = 1024, NIN = 9728, FFH = 2816;
constexpr int S_P = 4096, S_S = 2048;
constexpr int CT = 32768, NCHUNK = 3;
constexpr float EPS = 1e-6f;
constexpr float C2 = 0.18033688011112042f;
constexpr int LDS_BYTES = 147456;
constexpr int NWAVES = 8;

constexpr size_t MiB = 1u << 20;
constexpr size_t WS_MOD = 1 * MiB, WS_ROPE = 2 * MiB;
constexpr size_t WS_WIN = 4 * MiB, WS_WA = 23 * MiB, WS_WB = 25 * MiB, WS_WOUT = 26 * MiB, WS_WGU = 28 * MiB, WS_WDN = 39 * MiB;
constexpr int TT = 98304;
constexpr size_t WS_OA = 48 * MiB;
constexpr size_t WS_OB = 240 * MiB;
constexpr size_t WS_H = 336 * MiB;
constexpr size_t WS_QA = 400 * MiB, WS_KA = 464 * MiB, WS_VA = 528 * MiB, WS_G0 = 592 * MiB  ;
constexpr size_t WS_OG = 880 * MiB  , WS_LSE = 976 * MiB  , WS_END = 980 * MiB;
constexpr size_t DO_G1 = 0, DO_G2 = 192 * MiB, DO_X1 = 0;
constexpr size_t WS_MRG = 336 * MiB  , WS_H2 = 48 * MiB  , WS_ACT = 240 * MiB  , WS_X2 = 768 * MiB  ;
static_assert(WS_ACT + (size_t)TT * 2816 * 2 <= WS_X2 && WS_X2 + (size_t)TT * 2048 <= WS_END && WS_H2 + (size_t)TT * 2048 <= WS_ACT, "post-phase map");
__host__ __device__ __forceinline__ int batch_of_row(int row) { return row < 65536 ? (row >> 12) : 16 + ((row - 65536) >> 11); }

struct Args {
    const float *x_prompt, *x_sample, *c_prompt, *c_sample, *w_ada, *b_ada, *g_mix, *w_in, *lq1, *lk1, *lq2, *lk2, *g_subln, *w_a, *w_b, *w_out, *g_ffn, *w_gu, *w_down, *g_final;
    float* out; unsigned char* ws;
};

typedef const __attribute__((address_space(4))) Args* CArgs;
__device__ __forceinline__ CArgs argp() { CArgs p = (CArgs)__builtin_amdgcn_kernarg_segment_ptr(); asm volatile("" : "+s"(p)); return p; }

__device__ __forceinline__ float wave_sum(float v) {
#pragma unroll
    for (int o = 1; o < 64; o <<= 1) v += __shfl_xor(v, o);
    return v;
}
__device__ __forceinline__ unsigned f2bf(float f) { unsigned u = __builtin_bit_cast(unsigned, f); return (u + 0x7fffu + ((u >> 16) & 1u)) >> 16; }
__device__ __forceinline__ unsigned pk2(float lo, float hi) { return f2bf(lo) | (f2bf(hi) << 16); }
__device__ __forceinline__ float bflo(unsigned w) { return __builtin_bit_cast(float, w << 16); }
__device__ __forceinline__ float bfhi(unsigned w) { return __builtin_bit_cast(float, w & 0xffff0000u); }

__device__ __forceinline__ int maprow(int mode, int n) {
    if (mode == 1) {
        const bool qk = (n < 2048) || (n >= 3072 && n < 7680 && ((n - 3072) % 1536) < 1024);
        const int i = n & 63;
        if (qk && i < 16) return n - i + ((i < 8) ? 2 * i : 2 * (i - 8) + 1);
        return n;
    }
    if (mode == 2) {
        const bool up = n >= FFH; const int j = up ? n - FFH : n;
        return 8 * (j >> 2) + (j & 3) + (up ? 4 : 0);
    }
    return n;
}
__device__ __forceinline__ void p0_transpose_item(const float* W, int K, int N, bf16* WT, int mode, LAS float* scr, int item, int lane) {
    const int nblk = N / 32, kb = item / nblk, nb = item % nblk, k0 = 64 * kb, n0 = 32 * nb;
#pragma unroll 8
    for (int i = 0; i < 32; ++i) { const int kk = 2 * i + (lane >> 5); scr[kk * 33 + (lane & 31)] = W[(size_t)(k0 + kk) * N + n0 + (lane & 31)]; }
    LDS_WAIT(); asm volatile("" ::: "memory");
    const int c = lane & 7;
#pragma unroll
    for (int j = 0; j < 4; ++j) { const int n = (lane >> 3) + 8 * j; const LAS float* s = scr + (8 * c) * 33 + n;
        v4u o; o.x = pk2(s[0 * 33], s[1 * 33]); o.y = pk2(s[2 * 33], s[3 * 33]); o.z = pk2(s[4 * 33], s[5 * 33]); o.w = pk2(s[6 * 33], s[7 * 33]);
        *(GAS v4u*)(WT + (size_t)maprow(mode, n0 + n) * K + k0 + 8 * c) = o; }
    LDS_WAIT(); asm volatile("" ::: "memory");
}
__constant__ double ROPE_INVREV[8] = {0.15915494309189535, 0.03086376340470123, 0.005985185712713705, 0.001160663641240061,
                                      0.00022507907903927653, 4.364795279280289e-05, 8.464330808241401e-06, 1.6414262627950345e-06};

__device__ __forceinline__ void p0_prologue(LAS unsigned char* lds, int tid, int lane, int wave, int vcu, int G) {
    CArgs ap = argp(); unsigned char* ws = ap->ws;
    LAS float* scr = (LAS float*)(lds + wave * 16384);
    const int gw = vcu * NWAVES + wave, NGW = G * NWAVES;
    constexpr int I_IN = 16 * (NIN / 32), I_A = 16 * 32, I_B = 8 * 32, I_O = 16 * 32, I_GU = 16 * (2 * FFH / 32), I_DN = (FFH / 64) * 32;
    constexpr int NITEMS = I_IN + I_A + I_B + I_O + I_GU + I_DN;
    for (int it = gw; it < NITEMS; it += NGW) {
        int r = it;
        if (r < I_IN) { p0_transpose_item(ap->w_in, 1024, NIN, (bf16*)(ws + WS_WIN), 1, scr, r, lane); continue; } r -= I_IN;
        if (r < I_A) { p0_transpose_item(ap->w_a, 1024, 1024, (bf16*)(ws + WS_WA), 0, scr, r, lane); continue; } r -= I_A;
        if (r < I_B) { p0_transpose_item(ap->w_b, 512, 1024, (bf16*)(ws + WS_WB), 0, scr, r, lane); continue; } r -= I_B;
        if (r < I_O) { p0_transpose_item(ap->w_out, 1024, 1024, (bf16*)(ws + WS_WOUT), 0, scr, r, lane); continue; } r -= I_O;
        if (r < I_GU) { p0_transpose_item(ap->w_gu, 1024, 2 * FFH, (bf16*)(ws + WS_WGU), 2, scr, r, lane); continue; } r -= I_GU;
        p0_transpose_item(ap->w_down, FFH, 1024, (bf16*)(ws + WS_WDN), 0, scr, r, lane);
    }
    for (int idx = blockIdx.x * 512 + tid; idx < 4096 * 8; idx += G * 512) {
        const int pos = idx >> 3, i = idx & 7;
        const double rev = (double)pos * ROPE_INVREV[i]; const float fr = (float)(rev - __builtin_floor(rev));
        float2 cs; cs.x = __builtin_amdgcn_cosf(fr); cs.y = __builtin_amdgcn_sinf(fr);
        ((float2*)(ws + WS_ROPE))[idx] = cs;
    }
    __syncthreads();
    const int bx = blockIdx.x;
    if (bx < 192) {
        const int n0 = bx * 32, b = lane & 31, h = lane >> 5;
        const float* crow_ = (b < 16) ? ap->c_prompt + (size_t)b * 1024 : ap->c_sample + (size_t)(b - 16) * 1024;
        f32x16 acc = {};
#pragma unroll 4
        for (int i = 0; i < 16; ++i) {
            const int k = 128 * wave + 8 * i + 4 * h;
            const f32x4 c4 = *(const f32x4*)(crow_ + k);
#pragma unroll
            for (int e = 0; e < 4; ++e) {
                const float cv = c4[e], sv = cv / (1.f + __expf(-cv));
                const float wv = ap->w_ada[(size_t)(k + e) * 6144 + n0 + (lane & 31)];
                acc = __builtin_amdgcn_mfma_f32_32x32x2f32(sv, wv, acc, 0, 0, 0);
            }
        }
        LAS float* red = (LAS float*)lds;
#pragma unroll
        for (int r = 0; r < 16; ++r) red[(wave * 16 + r) * 64 + lane] = acc[r];
        __syncthreads();
#pragma unroll
        for (int j = 0; j < 2; ++j) {
            const int o = tid + 512 * j, nn = o & 31, bb = o >> 5;
            const int hh = (bb >> 2) & 1, r = (bb & 3) + 4 * (bb >> 3), ln = nn + 32 * hh;
            float s = ap->b_ada[n0 + nn];
#pragma unroll
            for (int w = 0; w < 8; ++w) s += red[(w * 16 + r) * 64 + ln];
            ((float*)(ws + WS_MOD))[(size_t)bb * 6144 + n0 + nn] = s;
        }
    }
    __syncthreads();
}

__device__ __forceinline__ f32x4 ld4(const float* p) { return *(const GAS f32x4*)p; }
__device__ __forceinline__ f32x4 ld4(const bf16* p) { const v2u w = *(const GAS v2u*)p; return (f32x4){bflo(w.x), bfhi(w.x), bflo(w.y), bfhi(w.y)}; }
template <class T> __device__ __forceinline__ void rows_norm_mod(const T* xsrc, bf16* dst, const float* gain, const float* mod, int sh_idx, int sc_idx, int nrows, int grow0, int gw, int NGW, int lane) {
    constexpr int RB = 4;
    for (int row0 = gw; row0 < nrows; row0 += RB * NGW) {
        f32x4 v[RB][4]; float ss[RB];
#pragma unroll
        for (int q = 0; q < RB; ++q) { const int row = row0 + q * NGW; const T* xr = xsrc + (size_t)(row < nrows ? row : row0) * 1024 + 4 * lane;
#pragma unroll
            for (int j = 0; j < 4; ++j) v[q][j] = ld4(xr + 256 * j); }
#pragma unroll
        for (int q = 0; q < RB; ++q) { float s = 0.f;
#pragma unroll
            for (int j = 0; j < 4; ++j) s += (v[q][j].x * v[q][j].x + v[q][j].y * v[q][j].y) + (v[q][j].z * v[q][j].z + v[q][j].w * v[q][j].w);
            ss[q] = s; }
#pragma unroll
        for (int o = 1; o < 64; o <<= 1)
#pragma unroll
            for (int q = 0; q < RB; ++q) ss[q] += __shfl_xor(ss[q], o);
#pragma unroll
        for (int q = 0; q < RB; ++q) { const int row = row0 + q * NGW; if (row < nrows) {
            const float rstd = 1.f / sqrtf(ss[q] * (1.f / 1024.f) + EPS);
            const float* mb = mod + (size_t)batch_of_row(grow0 + row) * 6144;
            GAS unsigned long long* o8 = (GAS unsigned long long*)(dst + (size_t)row * 1024) + lane;
#pragma unroll
            for (int j = 0; j < 4; ++j) {
                const f32x4 g = *(const f32x4*)(gain + 4 * lane + 256 * j);
                const f32x4 sc = *(const f32x4*)(mb + sc_idx * 1024 + 4 * lane + 256 * j), sh = *(const f32x4*)(mb + sh_idx * 1024 + 4 * lane + 256 * j);
                const f32x4 h = v[q][j] * rstd * g * (1.f + sc) + sh;
                o8[64 * j] = (unsigned long long)pk2(h.x, h.y) | ((unsigned long long)pk2(h.z, h.w) << 32);
            } } }
    }
}
__device__ __forceinline__ void rows_final_norm(const bf16* x2, float* out, const float* gain, int gw, int NGW, int lane) {
    constexpr int RB = 4;
    f32x4 g[4];
#pragma unroll
    for (int j = 0; j < 4; ++j) g[j] = *(const f32x4*)(gain + 4 * lane + 256 * j);
    for (int row0 = gw; row0 < TT; row0 += RB * NGW) {
        f32x4 v[RB][4]; float ss[RB];
#pragma unroll
        for (int q = 0; q < RB; ++q) { const int row = row0 + q * NGW; const bf16* xr = x2 + (size_t)(row < TT ? row : row0) * 1024 + 4 * lane;
#pragma unroll
            for (int j = 0; j < 4; ++j) v[q][j] = ld4(xr + 256 * j); }
#pragma unroll
        for (int q = 0; q < RB; ++q) { float s = 0.f;
#pragma unroll
            for (int j = 0; j < 4; ++j) s += (v[q][j].x * v[q][j].x + v[q][j].y * v[q][j].y) + (v[q][j].z * v[q][j].z + v[q][j].w * v[q][j].w);
            ss[q] = s; }
#pragma unroll
        for (int o = 1; o < 64; o <<= 1)
#pragma unroll
            for (int q = 0; q < RB; ++q) ss[q] += __shfl_xor(ss[q], o);
#pragma unroll
        for (int q = 0; q < RB; ++q) { const int row = row0 + q * NGW; if (row < TT) {
            const float rstd = 1.f / sqrtf(ss[q] * (1.f / 1024.f) + EPS);
            GAS f32x4* orow = (GAS f32x4*)(out + (size_t)row * 1024) + lane;
#pragma unroll
            for (int j = 0; j < 4; ++j) orow[64 * j] = v[q][j] * rstd * g[j];
        } }
    }
}
__device__ __forceinline__ void rows_combine(int c, int gw, int NGW, int lane) {
    CArgs ap = argp(); unsigned char* ws = ap->ws;
    const bf16* OG = (const bf16*)(ws + WS_OG); const float* LSE = (const float*)(ws + WS_LSE); bf16* OB = (bf16*)(ws + WS_OB) + (size_t)c * CT * 512;
    constexpr int RB = 4;
    const int hd = lane >> 3;
    for (int row0 = gw; row0 < CT; row0 += RB * NGW) {
        float l[RB][3]; v4u g[RB][3];
#pragma unroll
        for (int q = 0; q < RB; ++q) { const int row = (row0 + q * NGW < CT) ? row0 + q * NGW : row0;
#pragma unroll
            for (int k = 0; k < 3; ++k) { l[q][k] = LSE[((size_t)k * CT + row) * 8 + hd]; g[q][k] = *(const v4u*)(OG + ((size_t)k * CT + row) * 512 + 8 * lane); } }
#pragma unroll
        for (int q = 0; q < RB; ++q) { const int row = row0 + q * NGW; if (row < CT) {
            const float mx = fmaxf(l[q][0], fmaxf(l[q][1], l[q][2]));
            float w0 = __builtin_amdgcn_exp2f(l[q][0] - mx), w1 = __builtin_amdgcn_exp2f(l[q][1] - mx), w2 = __builtin_amdgcn_exp2f(l[q][2] - mx);
            const float inv = 1.f / (w0 + w1 + w2); w0 *= inv; w1 *= inv; w2 *= inv;
            v4u ob;
#pragma unroll
            for (int i = 0; i < 4; ++i) ob[i] = pk2(w0 * bflo(g[q][0][i]) + w1 * bflo(g[q][1][i]) + w2 * bflo(g[q][2][i]), w0 * bfhi(g[q][0][i]) + w1 * bfhi(g[q][1][i]) + w2 * bfhi(g[q][2][i]));
            *(v4u*)(OB + (size_t)row * 512 + 8 * lane) = ob;
        } }
    }
}

using pg8::Unit;
typedef pg8::f32x4 pf4;
__device__ __forceinline__ v4u pack8(const pf4 v0, const pf4 v1) { v4u w; w.x = pg8::cvt_pk_bf16(v0[0], v0[1]); w.y = pg8::cvt_pk_bf16(v0[2], v0[3]); w.z = pg8::cvt_pk_bf16(v1[0], v1[1]); w.w = pg8::cvt_pk_bf16(v1[2], v1[3]); return w; }
__device__ __forceinline__ float sigm(float x) { return __builtin_amdgcn_rcpf(1.f + __expf(-x)); }

struct EpiIn {
    static constexpr bool PERM = true, AFTER_DRAIN = false;
    unsigned char* ws; int S; unsigned char* gates;
    __device__ __forceinline__ void operator()(const pf4 (&acc)[2][2][4][2], const Unit& u, int wr, int wc, int fr, int fq) const {
        int pm_ = u.pm, pn_ = u.pn; asm volatile("" : "+s"(pm_), "+s"(pn_)); const Unit uu{pm_, pn_};
        const int pn = uu.pn; int kind, ldc = 1024, ct; size_t base;
        if (pn < 4) { kind = 1; base = WS_QA; ct = pn; }
        else if (pn < 8) { kind = 2; base = WS_KA; ct = pn - 4; }
        else if (pn < 12) { kind = 0; base = WS_VA; ct = pn - 8; }
        else if (pn < 30) { const int q = pn - 12, g = q / 6, r = q % 6, part = r >> 1; ct = r & 1; ldc = 512; base = WS_G0 + (size_t)(g * 3 + part) * 32 * MiB; kind = part == 0 ? 1 : (part == 1 ? 2 : 0); }
        else if (pn < 34) { kind = 3; base = DO_G1; ct = pn - 30; }
        else { kind = 3; base = DO_G2; ct = pn - 34; }
        bf16* O = (bf16*)((kind == 3 ? gates : ws) + base);
        const int row0 = uu.pm * 256 + wr * 64 + fr, col0 = ct * 256 + wc * 32 + 8 * fq;
        const bool ropew = (kind == 1 || kind == 2) && ((wc & 1) == 0); const bool ropel = fq < 2;
        const float sc = kind == 1 ? C2 : 1.f;
        const float* rope = (const float*)(ws + WS_ROPE);
        if (ropew) {
#pragma unroll
            for (int ai = 0; ai < 2; ++ai) {
            pf4 cs0[4], cs1[4];
#pragma unroll
            for (int q = 0; q < 4; ++q) { const int row = row0 + ai * 128 + q * 16; const float* rp = rope + ((size_t)(row % S) * 8 + 4 * (fq & 1)) * 2; cs0[q] = *(const pf4*)rp; cs1[q] = *(const pf4*)(rp + 4); }
            asm volatile("" ::: "memory");
#pragma unroll
            for (int q = 0; q < 4; ++q) {
                const int m = q, row = row0 + ai * 128 + m * 16;
                bf16* rowp = O + (size_t)row * ldc + col0;
#pragma unroll
                for (int bj = 0; bj < 2; ++bj) {
                    pf4 v0 = acc[ai][bj][m][0], v1 = acc[ai][bj][m][1];
                    pf4 r0, r1;
                    r0[0] = v0[0] * cs0[q][0] - v0[1] * cs0[q][1]; r0[1] = v0[1] * cs0[q][0] + v0[0] * cs0[q][1];
                    r0[2] = v0[2] * cs0[q][2] - v0[3] * cs0[q][3]; r0[3] = v0[3] * cs0[q][2] + v0[2] * cs0[q][3];
                    r1[0] = v1[0] * cs1[q][0] - v1[1] * cs1[q][1]; r1[1] = v1[1] * cs1[q][0] + v1[0] * cs1[q][1];
                    r1[2] = v1[2] * cs1[q][2] - v1[3] * cs1[q][3]; r1[3] = v1[3] * cs1[q][2] + v1[2] * cs1[q][3];
                    if (ropel) { v0 = r0; v1 = r1; }
                    v0 = v0 * sc; v1 = v1 * sc;
                    *(v4u*)(rowp + bj * 128) = pack8(v0, v1);
                }
            }
            asm volatile("" ::: "memory");
            }
        } else {
#pragma unroll
            for (int ai = 0; ai < 2; ++ai)
#pragma unroll
                for (int m = 0; m < 4; ++m) {
                    const int row = row0 + ai * 128 + m * 16;
                    bf16* rowp = O + (size_t)row * ldc + col0;
#pragma unroll
                    for (int bj = 0; bj < 2; ++bj) {
                        pf4 v0 = acc[ai][bj][m][0], v1 = acc[ai][bj][m][1];
                        if (kind == 3) {
#pragma unroll
                            for (int e = 0; e < 4; ++e) { v0[e] = sigm(v0[e]); v1[e] = sigm(v1[e]); }
                        }
                        v0 = v0 * sc; v1 = v1 * sc;
                        *(v4u*)(rowp + bj * 128) = pack8(v0, v1);
                    }
                }
        }
    }
};
struct EpiGate {
    static constexpr bool PERM = true, AFTER_DRAIN = false;
    const bf16* gate; bf16* O; int mode;
    __device__ __forceinline__ void operator()(const pf4 (&acc)[2][2][4][2], const Unit& u, int wr, int wc, int fr, int fq) const {
        int pm_ = u.pm, pn_ = u.pn; asm volatile("" : "+s"(pm_), "+s"(pn_)); const Unit uu{pm_, pn_};
        const int row0 = uu.pm * 256 + wr * 64 + fr, col0 = uu.pn * 256 + wc * 32 + 8 * fq;
#pragma unroll
        for (int ai = 0; ai < 2; ++ai) {
            v4u gv[4][2], pv[4][2];
#pragma unroll
            for (int m = 0; m < 4; ++m)
#pragma unroll
                for (int bj = 0; bj < 2; ++bj) { const size_t off = (size_t)(row0 + ai * 128 + m * 16) * 1024 + col0 + bj * 128;
                    gv[m][bj] = *(const v4u*)(gate + off); pv[m][bj] = mode ? *(const v4u*)(O + off) : (v4u){0u, 0u, 0u, 0u}; }
            asm volatile("" ::: "memory");
#pragma unroll
            for (int m = 0; m < 4; ++m)
#pragma unroll
                for (int bj = 0; bj < 2; ++bj) { const size_t off = (size_t)(row0 + ai * 128 + m * 16) * 1024 + col0 + bj * 128;
                    const v4u g = gv[m][bj], p = pv[m][bj];
                    pf4 v0 = acc[ai][bj][m][0], v1 = acc[ai][bj][m][1];
                    v0[0] = v0[0] * bflo(g.x) + bflo(p.x); v0[1] = v0[1] * bfhi(g.x) + bfhi(p.x); v0[2] = v0[2] * bflo(g.y) + bflo(p.y); v0[3] = v0[3] * bfhi(g.y) + bfhi(p.y);
                    v1[0] = v1[0] * bflo(g.z) + bflo(p.z); v1[1] = v1[1] * bfhi(g.z) + bfhi(p.z); v1[2] = v1[2] * bflo(g.w) + bflo(p.w); v1[3] = v1[3] * bfhi(g.w) + bfhi(p.w);
                    *(v4u*)(O + off) = pack8(v0, v1); }
            asm volatile("" ::: "memory");
        }
    }
};
template <bool IN_BF16> struct EpiRes {
    static constexpr bool PERM = true, AFTER_DRAIN = false;
    const void* base; const void* base_s; bf16* out; const float* mod; int gidx;
    __device__ __forceinline__ void operator()(const pf4 (&acc)[2][2][4][2], const Unit& u, int wr, int wc, int fr, int fq) const {
        int pm_ = u.pm, pn_ = u.pn; asm volatile("" : "+s"(pm_), "+s"(pn_)); const Unit uu{pm_, pn_};
        const int row0 = uu.pm * 256 + wr * 64 + fr, col0 = uu.pn * 256 + wc * 32 + 8 * fq;
        const float* gp = mod + (size_t)batch_of_row(uu.pm * 256) * 6144 + gidx * 1024 + col0;
        const float* xf = (uu.pm < 256) ? (const float*)base : (const float*)base_s - (size_t)65536 * 1024;
        pf4 gt[2][2];
#pragma unroll
        for (int bj = 0; bj < 2; ++bj) { gt[bj][0] = *(const pf4*)(gp + bj * 128); gt[bj][1] = *(const pf4*)(gp + bj * 128 + 4); }
#pragma unroll
        for (int q = 0; q < 4; ++q) {
            pf4 xb[2][2][2];
#pragma unroll
            for (int mm = 0; mm < 2; ++mm)
#pragma unroll
                for (int bj = 0; bj < 2; ++bj) { const size_t off = (size_t)(row0 + (q >> 1) * 128 + ((q & 1) * 2 + mm) * 16) * 1024 + col0 + bj * 128;
                    if (IN_BF16) { const v4u w = *(const v4u*)((const bf16*)base + off);
                        xb[mm][bj][0] = (pf4){bflo(w.x), bfhi(w.x), bflo(w.y), bfhi(w.y)}; xb[mm][bj][1] = (pf4){bflo(w.z), bfhi(w.z), bflo(w.w), bfhi(w.w)}; }
                    else { xb[mm][bj][0] = *(const pf4*)(xf + off); xb[mm][bj][1] = *(const pf4*)(xf + off + 4); } }
            asm volatile("" ::: "memory");
#pragma unroll
            for (int mm = 0; mm < 2; ++mm)
#pragma unroll
                for (int bj = 0; bj < 2; ++bj) { const int ai = q >> 1, m = (q & 1) * 2 + mm; const size_t off = (size_t)(row0 + ai * 128 + m * 16) * 1024 + col0 + bj * 128;
                    *(v4u*)(out + off) = pack8(xb[mm][bj][0] + gt[bj][0] * acc[ai][bj][m][0], xb[mm][bj][1] + gt[bj][1] * acc[ai][bj][m][1]); }
            asm volatile("" ::: "memory");
        }
    }
};
struct EpiGU {
    static constexpr bool PERM = true, AFTER_DRAIN = false;
    bf16* act;
    __device__ __forceinline__ void operator()(const pf4 (&acc)[2][2][4][2], const Unit& u, int wr, int wc, int fr, int fq) const {
        int pm_ = u.pm, pn_ = u.pn; asm volatile("" : "+s"(pm_), "+s"(pn_)); const Unit uu{pm_, pn_};
        const int row0 = uu.pm * 256 + wr * 64 + fr, col0 = uu.pn * 128 + wc * 16 + 4 * fq;
#pragma unroll
        for (int ai = 0; ai < 2; ++ai)
#pragma unroll
            for (int m = 0; m < 4; ++m) {
                bf16* rowp = act + (size_t)(row0 + ai * 128 + m * 16) * FFH + col0;
#pragma unroll
                for (int bj = 0; bj < 2; ++bj) {
                    const pf4 g = acc[ai][bj][m][0], up = acc[ai][bj][m][1]; pf4 r;
#pragma unroll
                    for (int e = 0; e < 4; ++e) r[e] = g[e] * sigm(g[e]) * up[e];
                    v2u w; w.x = pg8::cvt_pk_bf16(r[0], r[1]); w.y = pg8::cvt_pk_bf16(r[2], r[3]);
                    *(v2u*)(rowp + bj * 64) = w;
                }
                asm volatile("" ::: "memory");
            }
    }
};

__device__ __forceinline__ float halfmax(float m) { auto rr = __builtin_amdgcn_permlane32_swap(__float_as_uint(m), __float_as_uint(m), false, false); return fmaxf(__uint_as_float(rr[0]), __uint_as_float(rr[1])); }
__device__ __forceinline__ float halfsum(float m) { auto rr = __builtin_amdgcn_permlane32_swap(__float_as_uint(m), __float_as_uint(m), false, false); return __uint_as_float(rr[0]) + __uint_as_float(rr[1]); }
typedef short v4i16_t __attribute__((ext_vector_type(4)));
__device__ __forceinline__ s16x4 trrd(LAS unsigned char* p) { return __builtin_bit_cast(s16x4, __builtin_amdgcn_ds_read_tr16_b64_v4i16((LAS v4i16_t*)p)); }
__device__ __forceinline__ void dil_unit(const bf16* Qg, const bf16* Kg, const bf16* Vg, bf16* Og, float* Lg, int r, int n, int dil, int T, LAS unsigned char* wl, int lane) {
    const int r32 = lane & 31, hi = lane >> 5;
    LAS unsigned char* vimg = wl;
    LAS bf16* stg = (LAS bf16*)(wl + 4096);
    LAS float* wsf = (LAS float*)(wl + 8192);
    const int vwr = ((lane & 7) >> 2) * 2048 + (lane >> 3) * 64 + (lane & 3) * 16;
    const int vrd = ((lane >> 4) & 1) * 32 + (lane & 3) * 8 + (4 * hi + ((lane & 15) >> 2)) * 64;
    for (int qi = 0; qi < 2; ++qi) {
        const int tq0 = 64 * n + 32 * qi;
        const bf16* qp = Qg + (size_t)(r + dil * (tq0 + r32)) * 512 + 8 * hi;
        bf16x8 qf[4];
#pragma unroll
        for (int d0 = 0; d0 < 4; ++d0) qf[d0] = *(const bf16x8*)(qp + 16 * d0);
        bf16x8 kf[5][4];
#pragma unroll
        for (int kb = 0; kb < 5; ++kb) {
            int tk = tq0 - 64 + 32 * kb + r32; tk = tk < 0 ? 0 : (tk >= T ? T - 1 : tk);
            const bf16* kp = Kg + (size_t)(r + dil * tk) * 512 + 8 * hi;
#pragma unroll
            for (int d0 = 0; d0 < 4; ++d0) kf[kb][d0] = *(const bf16x8*)(kp + 16 * d0);
        }
        f32x16 s[5];
#pragma unroll
        for (int kb = 0; kb < 5; ++kb) {
            f32x16 acc = {};
#pragma unroll
            for (int d0 = 0; d0 < 4; ++d0) acc = __builtin_amdgcn_mfma_f32_32x32x16_bf16(kf[kb][d0], qf[d0], acc, 0, 0, 0);
            s[kb] = acc;
        }
        bf16x8 vv[5][4];
#pragma unroll
        for (int kb = 0; kb < 5; ++kb)
#pragma unroll
            for (int j = 0; j < 4; ++j) { int tk = tq0 - 64 + 32 * kb + 8 * j + (lane >> 3); tk = tk < 0 ? 0 : (tk >= T ? T - 1 : tk);
                vv[kb][j] = *(const bf16x8*)(Vg + (size_t)(r + dil * tk) * 512 + 8 * (lane & 7)); }
#pragma unroll
        for (int kb = 0; kb < 5; ++kb) {
            const int tk0 = tq0 - 64 + 32 * kb;
#pragma unroll
            for (int rr = 0; rr < 16; ++rr) {
                const int cr = (rr & 3) + 8 * (rr >> 2) + 4 * hi; const int rel = -64 + 32 * kb + cr - r32; const int kt = tk0 + cr;
                const bool ok = (rel >= -64) && (rel <= 64) && (kt >= 0) && (kt < T);
                s[kb][rr] = ok ? s[kb][rr] : -INFINITY;
            }
        }
        float mx = -INFINITY;
#pragma unroll
        for (int kb = 0; kb < 5; ++kb)
#pragma unroll
            for (int rr = 0; rr < 16; ++rr) mx = fmaxf(mx, s[kb][rr]);
        mx = halfmax(mx);
        float lsum = 0.f;
#pragma unroll
        for (int kb = 0; kb < 5; ++kb)
#pragma unroll
            for (int rr = 0; rr < 16; ++rr) { const float p = __builtin_amdgcn_exp2f(s[kb][rr] - mx); s[kb][rr] = p; lsum += p; }
        lsum = halfsum(lsum);
        f32x16 o[2]; o[0] = f32x16{}; o[1] = f32x16{};
#pragma unroll
        for (int kb = 0; kb < 5; ++kb) {
#pragma unroll
            for (int j = 0; j < 4; ++j) *(LAS bf16x8*)(vimg + vwr + j * 512) = vv[kb][j];
#pragma unroll
            for (int ks = 0; ks < 2; ++ks) {
                v4u pw;
#pragma unroll
                for (int e = 0; e < 4; ++e) pw[e] = pg8::cvt_pk_bf16(s[kb][8 * ks + 2 * e], s[kb][8 * ks + 2 * e + 1]);
                const bf16x8 pa = __builtin_bit_cast(bf16x8, pw);
#pragma unroll
                for (int d0 = 0; d0 < 2; ++d0) {
                    const s16x4 lo = trrd(vimg + vrd + d0 * 2048 + ks * 1024), hh = trrd(vimg + vrd + d0 * 2048 + ks * 1024 + 512);
                    const bf16x8 vb = (bf16x8){lo[0], lo[1], lo[2], lo[3], hh[0], hh[1], hh[2], hh[3]};
                    o[d0] = __builtin_amdgcn_mfma_f32_32x32x16_bf16(pa, vb, o[d0], 0, 0, 0);
                }
            }
        }
        if (hi == 0) wsf[r32] = lsum;
#pragma unroll
        for (int rr = 0; rr < 16; ++rr) {
            const int orow = (rr & 3) + 8 * (rr >> 2) + 4 * hi; const float rl = __builtin_amdgcn_rcpf(wsf[orow]);
#pragma unroll
            for (int d0 = 0; d0 < 2; ++d0) stg[orow * 64 + d0 * 32 + r32] = (bf16)f2bf(o[d0][rr] * rl);
        }
#pragma unroll
        for (int i = 0; i < 4; ++i) { const int row = i * 8 + (lane >> 3), ch = lane & 7; const v4u v = *(const LAS v4u*)(stg + row * 64 + ch * 8);
            *(v4u*)(Og + (size_t)(r + dil * (tq0 + row)) * 512 + ch * 8) = v; }
        if (hi == 0) Lg[(size_t)(r + dil * (tq0 + r32)) * 8] = mx + __builtin_amdgcn_logf(lsum);
    }
}

#define XB_TMO      128
#define XB_XCNT(j)  (256  + 64 * (j))
#define XB_XSUB(j)  (1280 + 64 * (j))
#define XB_XGEN(j)  (2304 + 64 * (j))
#define XB_TOP      3328
#define XB_TOPGEN   3392
#define XCD_BAR_WORDS 3456
#define XB_SPIN_CAP (1u << 18)

__device__ __forceinline__ unsigned xb_ld(unsigned* p)              { return __hip_atomic_load(p, __ATOMIC_RELAXED, __HIP_MEMORY_SCOPE_AGENT); }
__device__ __forceinline__ unsigned xb_add(unsigned* p, unsigned v) { return __hip_atomic_fetch_add(p, v, __ATOMIC_RELAXED, __HIP_MEMORY_SCOPE_AGENT); }
__device__ __forceinline__ unsigned xb_xcc_id() { return (unsigned)__builtin_amdgcn_s_getreg((3 << 11) | 20) & 0xFu; }
#define XB_SPIN(cond, bar) do { unsigned _sp = 0; while (cond) { __builtin_amdgcn_s_sleep(1); \
    if ((++_sp & 255u) == 0u) { if (xb_ld(&(bar)[XB_TMO])) break; if (_sp > XB_SPIN_CAP) { atomicAdd(&(bar)[XB_TMO], 1u); break; } } } } while (0)

struct XcdBarrier {
    unsigned* bar; unsigned x;
    volatile LAS unsigned* st;
};

__device__ __forceinline__ XcdBarrier xcd_barrier_post(unsigned* bar, volatile LAS unsigned* st, const bool lead) {
    XcdBarrier b; b.bar = bar; b.x = xb_xcc_id(); b.st = st;
    if (lead) (void)xb_add(&bar[XB_XCNT(b.x)], 1u);
    return b;
}
__device__ __forceinline__ void xcd_barrier_complete(unsigned* bar, unsigned x, unsigned& nloc, unsigned& nx) {
    const unsigned G = gridDim.x * gridDim.y * gridDim.z;
    unsigned sum, cnt, mine, sp = 0u;
    for (;;) {
        sum = 0u; cnt = 0u; mine = 0u;
#pragma unroll
        for (unsigned j = 0; j < 16; ++j) { const unsigned c = xb_ld(&bar[XB_XCNT(j)]); sum += c; cnt += (c > 0u) ? 1u : 0u; mine = (j == x) ? c : mine; }
        if (sum == G) break;
        __builtin_amdgcn_s_sleep(1);
        if ((++sp & 255u) == 0u) { if (xb_ld(&bar[XB_TMO])) break; if (sp > XB_SPIN_CAP) { atomicAdd(&bar[XB_TMO], 1u); break; } }
    }
    nloc = mine > 0u ? mine : 1u; nx = cnt > 0u ? cnt : 1u;
}

__device__ __forceinline__ void xcd_barrier(const XcdBarrier& b, const bool lead) {
    asm volatile("s_waitcnt vmcnt(0)" ::: "memory");
    __syncthreads();
    if (lead) {
        unsigned* bar = b.bar;
        __builtin_amdgcn_s_waitcnt(0);
        unsigned nloc = b.st[0], nx = b.st[1];
        if (nloc == 0u) { xcd_barrier_complete(bar, b.x, nloc, nx); b.st[0] = nloc; b.st[1] = nx; }
        const unsigned old = xb_add(&bar[XB_XSUB(b.x)], 1u);
        const unsigned gen = old / nloc;
        if (old + 1u == (gen + 1u) * nloc) {
            __builtin_amdgcn_fence(__ATOMIC_RELEASE, "agent");
            asm volatile("s_waitcnt vmcnt(0)" ::: "memory");
            const unsigned og = xb_add(&bar[XB_TOP], 1u);
            const unsigned tg = og / nx;
            if (og + 1u == (tg + 1u) * nx) xb_add(&bar[XB_TOPGEN], 1u);
            else XB_SPIN(xb_ld(&bar[XB_TOPGEN]) == tg, bar);
            __builtin_amdgcn_fence(__ATOMIC_ACQUIRE, "agent");
            xb_add(&bar[XB_XGEN(b.x)], 1u);
            asm volatile("s_waitcnt vmcnt(0)" ::: "memory");
        } else {
            XB_SPIN(xb_ld(&bar[XB_XGEN(b.x)]) == gen, bar);
            __builtin_amdgcn_fence(__ATOMIC_ACQUIRE, "agent");
            asm volatile("s_waitcnt vmcnt(0)" ::: "memory");
        }
    }
    __syncthreads();
}

#ifndef PROBE_GIN
#define PROBE_GIN 1
#endif
#ifndef PROBE_GU
#define PROBE_GU 1
#endif
#ifndef PROBE_P9
#define PROBE_P9 1
#endif
#ifndef PROBE_P6
#define PROBE_P6 1
#endif
#ifndef PROBE_P5
#define PROBE_P5 1
#endif
#ifndef PROBE_P0
#define PROBE_P0 1
#endif
#ifndef PROBE_DIL
#define PROBE_DIL 1
#endif
#ifndef PROBE_ATT
#define PROBE_ATT 1
#endif
#ifndef PROBE_ROWS
#define PROBE_ROWS 1
#endif
#ifndef PROBE_SYNC
#define PROBE_SYNC 1
#endif
#define GSYNC() do { MKLANE(); for (int s_ = 0; s_ < PROBE_SYNC; ++s_) xcd_barrier(bar, tid == 0); } while (0)
__global__ void __launch_bounds__(NWAVES * 64, 2) fwd_megakernel(Args a) {
    extern __shared__ __attribute__((aligned(16))) unsigned char lds_raw[];
    cg::grid_group grid = cg::this_grid();
    LAS unsigned char* lds = (LAS unsigned char*)lds_raw;
    const int wave = __builtin_amdgcn_readfirstlane((int)threadIdx.x >> 6);
#define MKLANE() int lane = (int)__builtin_amdgcn_mbcnt_hi(~0u, __builtin_amdgcn_mbcnt_lo(~0u, 0u)); asm volatile("" : "+v"(lane)); const int tid = wave * 64 + lane; (void)tid
#define MKIDS() int G = gridDim.x, bx = blockIdx.x; asm volatile("" : "+s"(G), "+s"(bx)); const int vcu = (G % 8 == 0) ? (bx % 8) * (G / 8) + bx / 8 : bx; const int gw = vcu * NWAVES + wave, NGW = G * NWAVES; (void)gw; (void)NGW; (void)vcu

#ifndef NO_P0
    volatile LAS unsigned* MISC = (volatile LAS unsigned*)(lds + LDS_BYTES - 256);
    { MKLANE(); if (tid < 32) MISC[tid] = 0u; }
    __syncthreads();
    XcdBarrier bar; { MKLANE(); bar = xcd_barrier_post((unsigned*)argp()->ws, MISC + 8, tid == 0); }
    for (int rep_ = 0; rep_ < PROBE_P0; ++rep_) { MKIDS(); MKLANE(); p0_prologue(lds, tid, lane, wave, vcu, G); }
#endif
    grid.sync();

#define FETCH() MKIDS(); MKLANE(); CArgs ap = argp(); unsigned char* ws = ap->ws; const float* mod = (const float*)(ws + WS_MOD); (void)mod
    for (int c = 0; c < NCHUNK; ++c) {
        const int S = (c < 2) ? S_P : S_S, nseq = CT / S;
#define XC() ((c < 2) ? ap->x_prompt + (size_t)c * CT * 1024 : ap->x_sample)
        for (int rep_ = 0; rep_ < PROBE_ROWS; ++rep_) { FETCH(); rows_norm_mod(XC(), (bf16*)(ws + WS_H), ap->g_mix, mod, 0, 1, CT, c * CT, gw, NGW, lane); }
        GSYNC();
        {   FETCH();
            pg8::Gemm g{(const pg8::bf16_t*)(ws + WS_H), (const pg8::bf16_t*)(ws + WS_WIN), CT, NIN, 1024}; pg8::StaticOrder So; So.init(CT, NIN, G, bx);
            EpiIn E{ws, S, (unsigned char*)ap->out + (size_t)c * CT * 2048};
#ifndef NO_GIN
            for (int rep_ = 0; rep_ < PROBE_GIN; ++rep_)
            pg8::gemm_phase<EpiIn, pg8::StaticOrder, PG8_ALIGN, PG8_SP2>(lds, g, So, E, wave);
#endif
        }
        GSYNC();
        {   FETCH();
            const int NQB = S / 256, NT = S / 64, nunits = nseq * 8 * NQB;
            const float lam_v = __expf(wave_sum(ap->lq1[lane] * ap->lk1[lane])) - __expf(wave_sum(ap->lq2[lane] * ap->lk2[lane])) + 0.2f;
            const float lam = __builtin_bit_cast(float, __builtin_amdgcn_readfirstlane(__builtin_bit_cast(int, lam_v)));
            LAS float* gsl = (LAS float*)(lds + LDS_BYTES - 1024);
            if (tid < 128) gsl[tid] = ap->g_subln[tid] * 0.8f;
            __syncthreads();
            for (int id = vcu; id < nunits; id += G) {
                const int qb = id % NQB; int t = id / NQB; const int h8 = t & 7, seq = t >> 3;
                const size_t rb = (size_t)seq * S * 1024;
                const attn_body::bf16* Qp = (const attn_body::bf16*)(ws + WS_QA) + rb + h8 * 128;
                const attn_body::bf16* Kp = (const attn_body::bf16*)(ws + WS_KA) + rb + h8 * 128;
                const attn_body::bf16* Vp = (const attn_body::bf16*)(ws + WS_VA) + rb + h8 * 128;
                attn_body::bf16* Op = (attn_body::bf16*)(ws + WS_OA) + (size_t)c * CT * 1024 + rb + h8 * 128;
#ifndef NO_ATT
                attn_body::attn_unit<8, 1>(Qp, Kp, Vp, Op, qb * 256, NT, (char*)lds_raw, lam, gsl, wave);
                attn_body::attn_unit<8, 2>(Qp + 64, Kp + 64, Vp, Op, qb * 256, NT, (char*)lds_raw, lam, gsl, wave);
#endif
            }
            __syncthreads();
            const int nb64 = S / 64, ndu = 3 * nseq * nb64;
            for (int rep_ = 0; rep_ < PROBE_DIL; ++rep_)
            for (int id = vcu; id < ndu; id += G) {
                const int rn = id % nb64; int t = id / nb64; const int seq = t % nseq, g = t / nseq;
                const int dil = (g == 0) ? 1 : (g == 1 ? 4 : 16), T = S / dil, nb = T / 64, r = rn / nb, n = rn % nb;
                const size_t rb = (size_t)seq * S * 512 + wave * 64;
                const bf16* Qg = (const bf16*)(ws + WS_G0 + (size_t)(g * 3 + 0) * 32 * MiB) + rb;
                const bf16* Kg = (const bf16*)(ws + WS_G0 + (size_t)(g * 3 + 1) * 32 * MiB) + rb;
                const bf16* Vg = (const bf16*)(ws + WS_G0 + (size_t)(g * 3 + 2) * 32 * MiB) + rb;
                bf16* Og = (bf16*)(ws + WS_OG + (size_t)g * 32 * MiB) + rb;
                float* Lg = (float*)(ws + WS_LSE) + ((size_t)g * CT + (size_t)seq * S) * 8 + wave;
#ifndef NO_DIL
                dil_unit(Qg, Kg, Vg, Og, Lg, r, n, dil, T, lds + wave * 8704, lane);
#endif
            }
        }
        GSYNC();
#ifndef NO_COMB
        for (int rep_ = 0; rep_ < PROBE_ROWS; ++rep_) { MKIDS(); MKLANE(); rows_combine(c, gw, NGW, lane); }
#endif
        GSYNC();
    }
    {   FETCH();
        for (int rep_ = 0; rep_ < PROBE_P5; ++rep_) {
        pg8::StaticOrder So; So.init(TT, 1024, G, bx);
        pg8::Gemm ga{(const pg8::bf16_t*)(ws + WS_OA), (const pg8::bf16_t*)(ws + WS_WA), TT, 1024, 1024};
        EpiGate Ea{(const bf16*)((unsigned char*)ap->out + DO_G1), (bf16*)(ws + WS_MRG), 0};
#ifndef NO_GG
        pg8::gemm_phase<EpiGate, pg8::StaticOrder, PG8_ALIGN, PG8_SP2>(lds, ga, So, Ea, wave);
#endif
        pg8::Gemm gb{(const pg8::bf16_t*)(ws + WS_OB), (const pg8::bf16_t*)(ws + WS_WB), TT, 1024, 512};
        EpiGate Eb{(const bf16*)((unsigned char*)ap->out + DO_G2), (bf16*)(ws + WS_MRG), 1};
#ifndef NO_GG
        pg8::gemm_phase<EpiGate, pg8::StaticOrder, PG8_ALIGN, PG8_SP2>(lds, gb, So, Eb, wave);
#endif
        }
    }
    GSYNC();
    {   FETCH();
        pg8::StaticOrder So; So.init(TT, 1024, G, bx);
        pg8::Gemm g{(const pg8::bf16_t*)(ws + WS_MRG), (const pg8::bf16_t*)(ws + WS_WOUT), TT, 1024, 1024};
        EpiRes<false> E{ap->x_prompt, ap->x_sample, (bf16*)((unsigned char*)ap->out + DO_X1), mod, 2};
#ifndef NO_GR
        for (int rep_ = 0; rep_ < PROBE_P6; ++rep_)
        pg8::gemm_phase<EpiRes<false>, pg8::StaticOrder, PG8_ALIGN, PG8_SP2>(lds, g, So, E, wave);
#endif
    }
    GSYNC();
    for (int rep_ = 0; rep_ < PROBE_ROWS; ++rep_) { FETCH(); rows_norm_mod((const bf16*)((unsigned char*)ap->out + DO_X1), (bf16*)(ws + WS_H2), ap->g_ffn, mod, 3, 4, TT, 0, gw, NGW, lane); }
    GSYNC();
    {   FETCH();
        pg8::StaticOrder So; So.init(TT, 2 * FFH, G, bx);
        pg8::Gemm g{(const pg8::bf16_t*)(ws + WS_H2), (const pg8::bf16_t*)(ws + WS_WGU), TT, 2 * FFH, 1024};
        EpiGU E{(bf16*)(ws + WS_ACT)};
#ifndef NO_GU
        for (int rep_ = 0; rep_ < PROBE_GU; ++rep_)
        pg8::gemm_phase<EpiGU, pg8::StaticOrder, PG8_ALIGN, PG8_SP2>(lds, g, So, E, wave);
#endif
    }
    GSYNC();
    {   FETCH();
        pg8::StaticOrder So; So.init(TT, 1024, G, bx);
        pg8::Gemm g{(const pg8::bf16_t*)(ws + WS_ACT), (const pg8::bf16_t*)(ws + WS_WDN), TT, 1024, FFH};
        EpiRes<true> E{(const bf16*)((unsigned char*)ap->out + DO_X1), nullptr, (bf16*)(ws + WS_X2), mod, 5};
#ifndef NO_GR
        for (int rep_ = 0; rep_ < PROBE_P9; ++rep_)
        pg8::gemm_phase<EpiRes<true>, pg8::StaticOrder, PG8_ALIGN, PG8_SP2>(lds, g, So, E, wave);
#endif
    }
    GSYNC();
    { FETCH(); rows_final_norm((const bf16*)(ws + WS_X2), ap->out, ap->g_final, gw, NGW, lane); }
}

extern "C" void kernel_launch(void* const* d_in, const int* in_sizes, int n_in, void* d_out, int out_size, void* d_ws, size_t ws_size, hipStream_t stream) {
    static int grid = 0;
    if (grid == 0) {
        if (n_in != 20 || ws_size < WS_END) { fprintf(stderr, "kernel_launch: unexpected n_in %d / ws_size %zu (need %zu)\n", n_in, ws_size, (size_t)WS_END); grid = -1; return; }
        int dev = 0, cus = 0, per_cu = 0;
        hipGetDevice(&dev); hipDeviceGetAttribute(&cus, hipDeviceAttributeMultiprocessorCount, dev);
        if (hipFuncSetAttribute((const void*)fwd_megakernel, hipFuncAttributeMaxDynamicSharedMemorySize, LDS_BYTES) != hipSuccess) { fprintf(stderr, "kernel_launch: hipFuncSetAttribute failed\n"); grid = -1; return; }
        if (hipOccupancyMaxActiveBlocksPerMultiprocessor(&per_cu, (const void*)fwd_megakernel, NWAVES * 64, LDS_BYTES) != hipSuccess || per_cu < 1) { fprintf(stderr, "kernel_launch: occupancy query says %d\n", per_cu); per_cu = 1; }
        (void)hipGetLastError();
        grid = cus * 1;
        fprintf(stderr, "kernel_launch: grid %d (cus %d, per_cu %d)\n", grid, cus, per_cu);
    }
    if (grid < 0) return;
    Args a{};
    a.x_prompt = (const float*)d_in[0]; a.x_sample = (const float*)d_in[1]; a.c_prompt = (const float*)d_in[2]; a.c_sample = (const float*)d_in[3];
    a.w_ada = (const float*)d_in[4]; a.b_ada = (const float*)d_in[5]; a.g_mix = (const float*)d_in[6]; a.w_in = (const float*)d_in[7];
    a.lq1 = (const float*)d_in[8]; a.lk1 = (const float*)d_in[9]; a.lq2 = (const float*)d_in[10]; a.lk2 = (const float*)d_in[11]; a.g_subln = (const float*)d_in[12];
    a.w_a = (const float*)d_in[13]; a.w_b = (const float*)d_in[14]; a.w_out = (const float*)d_in[15]; a.g_ffn = (const float*)d_in[16]; a.w_gu = (const float*)d_in[17];
    a.w_down = (const float*)d_in[18]; a.g_final = (const float*)d_in[19];
    a.out = (float*)d_out; a.ws = (unsigned char*)d_ws;
    if (hipMemsetAsync(d_ws, 0, 16384, stream) != hipSuccess) { fprintf(stderr, "kernel_launch: memset failed\n"); return; }
    void* args[] = {&a};
    hipError_t e = hipLaunchCooperativeKernel((const void*)fwd_megakernel, dim3(grid), dim3(NWAVES * 64), args, LDS_BYTES, stream);
    if (e != hipSuccess) fprintf(stderr, "kernel_launch: cooperative launch failed: %s (grid %d)\n", hipGetErrorString(e), grid);
}
```
